# Optimizing an MI355X kernel written in HIP

```python
import math
import jax
import jax.numpy as jnp
from jax import lax
import numpy as np

D_MODEL = 1024
BATCH = 4
SEQ = 8192
DEPTH = 2

Q_BLOCK = 128
RMS_EPS = 1e-6
N_BRANCHES = 4

DA_HEADS = 4
DA_QK_DIM = 64
DA_V_DIM = 2 * DA_QK_DIM
ROPE_THETA = 500000.0
ROPE_DIM = DA_QK_DIM // 4
DA_LAMBDA_INIT_BASE = 0.8
DA_LAMBDA_INIT_SCALE = 0.6
DA_LAMBDA_INIT_RATE = 0.3

SB_HEADS = 4
SB_HEAD_DIM = 64

HG_HEADS = 4
HG_KEY_DIM = 64
HG_VAL_DIM = 64
HG_CHUNK = 64

S5_GROUPS = 16
S5_GROUP_CH = 16
S5_STATE = 64
S5_WIDTH = S5_GROUPS * S5_GROUP_CH
S5_STEP_MIN = 1e-3
S5_STEP_MAX = 1e-1
S5_EIG_CLIP = -1e-4

N_GROUPS = 4
EXPERTS_PER_GROUP = 4
N_EXPERTS = N_GROUPS * EXPERTS_PER_GROUP
TOP_K = 2
D_EXPERT = 384

DA_QK_COLS = DA_HEADS * 2 * DA_QK_DIM
DA_V_COLS = DA_HEADS * DA_V_DIM
SB_COLS = SB_HEADS * SB_HEAD_DIM
HG_K_COLS = HG_HEADS * HG_KEY_DIM
HG_V_COLS = HG_HEADS * HG_VAL_DIM
GATE_COLS = N_BRANCHES * D_MODEL
SPLIT_SIZES = (DA_QK_COLS, DA_QK_COLS, DA_V_COLS, SB_COLS, SB_COLS, SB_COLS,
               HG_K_COLS, HG_V_COLS, HG_K_COLS, HG_V_COLS, S5_WIDTH, GATE_COLS)
IN_COLS = sum(SPLIT_SIZES)
SPLIT_POINTS = tuple(int(v) for v in np.cumsum(SPLIT_SIZES)[:-1])

kernel_name = 'hybrid_gated_diffattn_stickbreak_hgrn2_s5_hmoe'

F32 = jnp.float32


def rms_norm(t, gain):
    tf = t.astype(F32)
    y = tf * lax.rsqrt(jnp.mean(tf * tf, axis=-1, keepdims=True) + RMS_EPS)
    return (y * gain.astype(F32)).astype(t.dtype)


def partial_rope(t, positions):
    half = ROPE_DIM // 2
    inv_freq = jnp.exp(-math.log(ROPE_THETA) * jnp.arange(half, dtype=F32) * (2.0 / ROPE_DIM))
    ang = positions.astype(F32)[:, :, None] * inv_freq
    cos = jnp.cos(ang)[:, :, None, :]
    sin = jnp.sin(ang)[:, :, None, :]
    tf = t.astype(F32)
    t1 = tf[..., :half]
    t2 = tf[..., half:ROPE_DIM]
    out = jnp.concatenate([t1 * cos - t2 * sin, t2 * cos + t1 * sin, tf[..., ROPE_DIM:]], axis=-1)
    return out.astype(t.dtype)


def differential_attention(q, k, v, positions, q_gain, k_gain, lq1, lk1, lq2, lk2,
                           subln_gain, lambda_init):
    bsz, seq, _ = q.shape
    q = partial_rope(rms_norm(q.reshape(bsz, seq, 2 * DA_HEADS, DA_QK_DIM), q_gain), positions)
    k = partial_rope(rms_norm(k.reshape(bsz, seq, 2 * DA_HEADS, DA_QK_DIM), k_gain), positions)
    q = q.reshape(bsz, seq, DA_HEADS, 2, DA_QK_DIM).transpose(3, 0, 2, 1, 4)
    k = k.reshape(bsz, seq, DA_HEADS, 2, DA_QK_DIM).transpose(3, 0, 2, 1, 4)
    v = v.reshape(bsz, seq, DA_HEADS, DA_V_DIM).transpose(0, 2, 1, 3).astype(F32)
    lam = (jnp.exp(jnp.sum(lq1.astype(F32) * lk1.astype(F32)))
           - jnp.exp(jnp.sum(lq2.astype(F32) * lk2.astype(F32))) + lambda_init)
    n_blk = seq // Q_BLOCK
    q_blocks = q.reshape(2, bsz, DA_HEADS, n_blk, Q_BLOCK, DA_QK_DIM).transpose(3, 0, 1, 2, 4, 5)
    scale = DA_QK_DIM ** -0.5
    key_pos = jnp.arange(seq)

    def block(args):
        q_blk, blk = args
        s = jnp.einsum('cbhqd,cbhkd->cbhqk', q_blk, k).astype(F32) * scale
        q_pos = blk * Q_BLOCK + jnp.arange(Q_BLOCK)
        causal = key_pos[None, :] <= q_pos[:, None]
        p = jax.nn.softmax(jnp.where(causal, s, -jnp.inf), axis=-1)
        w = p[0] - lam * p[1]
        return jnp.einsum('bhqk,bhkd->bhqd', w, v)

    o = lax.map(block, (q_blocks, jnp.arange(n_blk)))
    o = o.transpose(1, 0, 3, 2, 4).reshape(bsz, seq, DA_HEADS, DA_V_DIM)
    o = rms_norm(o, subln_gain) * (1.0 - lambda_init)
    return o.reshape(bsz, seq, DA_V_COLS)


def stick_breaking_attention(q, k, v):
    bsz, seq, _ = q.shape
    q = q.reshape(bsz, seq, SB_HEADS, SB_HEAD_DIM).transpose(0, 2, 1, 3)
    k = k.reshape(bsz, seq, SB_HEADS, SB_HEAD_DIM).transpose(0, 2, 1, 3)
    v = v.reshape(bsz, seq, SB_HEADS, SB_HEAD_DIM).transpose(0, 2, 1, 3).astype(F32)
    n_blk = seq // Q_BLOCK
    q_blocks = q.reshape(bsz, SB_HEADS, n_blk, Q_BLOCK, SB_HEAD_DIM).transpose(2, 0, 1, 3, 4)
    scale = SB_HEAD_DIM ** -0.5
    key_pos = jnp.arange(seq)

    def block(args):
        q_blk, blk = args
        z = jnp.einsum('bhqd,bhkd->bhqk', q_blk, k).astype(F32) * scale
        q_pos = blk * Q_BLOCK + jnp.arange(Q_BLOCK)
        strict = key_pos[None, :] < q_pos[:, None]
        log_keep = jnp.where(strict, jax.nn.log_sigmoid(-z), 0.0)
        log_later = lax.cumsum(log_keep, axis=3, reverse=True) - log_keep
        w = jnp.where(strict, jnp.exp(jax.nn.log_sigmoid(z) + log_later), 0.0)
        return jnp.einsum('bhqk,bhkd->bhqd', w, v)

    o = lax.map(block, (q_blocks, jnp.arange(n_blk)))
    return o.transpose(1, 0, 3, 2, 4).reshape(bsz, seq, SB_COLS)


def hgrn2(f_logit, i_val, q, g, lower_bound, out_gain):
    bsz, seq, _ = f_logit.shape

    def heads(t, d):
        return t.astype(F32).reshape(bsz, seq, HG_HEADS, d).transpose(0, 2, 1, 3)

    z = heads(f_logit, HG_KEY_DIM)
    v = heads(i_val, HG_VAL_DIM)
    qh = heads(q, HG_KEY_DIM)
    lb = lower_bound.astype(F32).reshape(1, HG_HEADS, 1, HG_KEY_DIM)
    log_f = jnp.logaddexp(jnp.log(lb), jnp.log1p(-lb) + jax.nn.log_sigmoid(z))
    key = (1.0 - lb) * jax.nn.sigmoid(-z)
    n_chunk = seq // HG_CHUNK

    def chunks(t):
        return t.reshape(bsz, HG_HEADS, n_chunk, HG_CHUNK, t.shape[-1]).transpose(2, 0, 1, 3, 4)

    causal = jnp.tril(jnp.ones((HG_CHUNK, HG_CHUNK), dtype=bool))

    def step(state, inp):
        qc, kc, vc, gc = inp
        b = jnp.cumsum(gc, axis=2)
        decay = jnp.exp(jnp.where(causal[:, :, None], b[:, :, :, None, :] - b[:, :, None, :, :], -jnp.inf))
        scores = jnp.einsum('bhtk,bhsk,bhtsk->bhts', qc, kc, decay)
        o = (jnp.einsum('bhts,bhsv->bhtv', scores, vc)
             + jnp.einsum('bhtk,bhkv->bhtv', qc * jnp.exp(b), state))
        b_end = b[:, :, -1:, :]
        state = (jnp.exp(b_end[:, :, 0, :, None]) * state
                 + jnp.einsum('bhsk,bhsv->bhkv', kc * jnp.exp(b_end - b), vc))
        return state, o

    s0 = jnp.zeros((bsz, HG_HEADS, HG_KEY_DIM, HG_VAL_DIM), F32)
    _, o = lax.scan(step, s0, (chunks(qh), chunks(key), chunks(v), chunks(log_f)))
    o = o.transpose(1, 0, 3, 2, 4).reshape(bsz, seq, HG_HEADS, HG_VAL_DIM)
    gate = jax.nn.silu(g.astype(F32)).reshape(bsz, seq, HG_HEADS, HG_VAL_DIM)
    return (rms_norm(o, out_gain) * gate).reshape(bsz, seq, HG_V_COLS)


def s5_layer(u, lam_re, lam_im, log_step, b_re, b_im, c_re, c_im, d_skip, glu_w, glu_b):
    bsz, seq, _ = u.shape
    uf = u.astype(F32)
    ug = uf.reshape(bsz, seq, S5_GROUPS, S5_GROUP_CH)
    lam_re = jnp.minimum(lam_re.astype(F32), S5_EIG_CLIP)
    lam_im = lam_im.astype(F32)
    step = jnp.exp(log_step.astype(F32))[:, None]
    mag = jnp.exp(lam_re * step)
    phase = lam_im * step
    a_re = mag * jnp.cos(phase)
    a_im = mag * jnp.sin(phase)
    denom = lam_re * lam_re + lam_im * lam_im
    num_re = a_re - 1.0
    gam_re = (num_re * lam_re + a_im * lam_im) / denom
    gam_im = (a_im * lam_re - num_re * lam_im) / denom
    b_re = b_re.astype(F32)
    b_im = b_im.astype(F32)
    bb_re = gam_re[..., None] * b_re - gam_im[..., None] * b_im
    bb_im = gam_re[..., None] * b_im + gam_im[..., None] * b_re
    bu_re = jnp.einsum('gnc,blgc->blgn', bb_re, ug)
    bu_im = jnp.einsum('gnc,blgc->blgn', bb_im, ug)
    a_re_t = jnp.broadcast_to(a_re, (1, seq, S5_GROUPS, S5_STATE))
    a_im_t = jnp.broadcast_to(a_im, (1, seq, S5_GROUPS, S5_STATE))

    def combine(e1, e2):
        a1r, a1i, b1r, b1i = e1
        a2r, a2i, b2r, b2i = e2
        return (a2r * a1r - a2i * a1i,
                a2r * a1i + a2i * a1r,
                a2r * b1r - a2i * b1i + b2r,
                a2r * b1i + a2i * b1r + b2i)

    _, _, x_re, x_im = lax.associative_scan(combine, (a_re_t, a_im_t, bu_re, bu_im), axis=1)
    y = (jnp.einsum('gcn,blgn->blgc', c_re.astype(F32), x_re)
         - jnp.einsum('gcn,blgn->blgc', c_im.astype(F32), x_im))
    y = y.reshape(bsz, seq, S5_WIDTH) + d_skip.astype(F32) * uf
    y = jax.nn.gelu(y)
    return y * jax.nn.sigmoid(y @ glu_w.astype(F32) + glu_b.astype(F32))


def hierarchical_moe(h, wg, bg, we, be, w_gate, w_up, w_down):
    bsz, seq, dm = h.shape
    t = h.reshape(-1, dm)
    g_prob = jax.nn.softmax((t @ wg).astype(F32) + bg.astype(F32), axis=-1)
    g_val, g_idx = lax.top_k(g_prob, 1)
    e_logits = ((t @ we).astype(F32) + be.astype(F32)).reshape(-1, N_GROUPS, EXPERTS_PER_GROUP)
    e_sel = jnp.einsum('ng,nge->ne', jax.nn.one_hot(g_idx[:, 0], N_GROUPS, dtype=F32), e_logits)
    e_prob = jax.nn.softmax(e_sel, axis=-1)
    e_val, e_idx = lax.top_k(e_prob, TOP_K)
    e_val = e_val / jnp.sum(e_val, axis=-1, keepdims=True)
    weights = g_val * e_val
    expert_id = g_idx * EXPERTS_PER_GROUP + e_idx
    combine_w = jnp.sum(jax.nn.one_hot(expert_id, N_EXPERTS, dtype=F32) * weights[..., None], axis=1)
    combine_w = combine_w.astype(t.dtype)
    y = jnp.zeros_like(t)
    for e in range(N_EXPERTS):
        hid = jax.nn.silu(t @ w_gate[e]) * (t @ w_up[e])
        y = y + combine_w[:, e:e + 1] * (hid @ w_down[e])
    return y.reshape(bsz, seq, dm)


def setup_inputs(seed: int = 0) -> dict:
    key = jax.random.key(seed)
    ks = jax.random.split(key, 40)

    def nrm(i, shape, scale):
        return jax.random.normal(ks[i], shape, F32) * scale

    def gain(i, shape):
        return 1.0 + nrm(i, shape, 0.02)

    offsets = jax.random.randint(ks[1], (BATCH, 1), 0, 4096, dtype=jnp.int32)
    positions = offsets + jnp.arange(SEQ, dtype=jnp.int32)[None, :]
    gs = (DEPTH, S5_GROUPS, S5_STATE)
    return {
        'x': nrm(0, (BATCH, SEQ, D_MODEL), 1.0),
        'positions': positions,
        'norm_mix': gain(2, (DEPTH, D_MODEL)),
        'w_in': nrm(3, (DEPTH, D_MODEL, IN_COLS), D_MODEL ** -0.5),
        'da_q_gain': gain(4, (DEPTH, DA_QK_DIM)),
        'da_k_gain': gain(5, (DEPTH, DA_QK_DIM)),
        'da_lambda_q1': nrm(6, (DEPTH, DA_QK_DIM), 0.1),
        'da_lambda_k1': nrm(7, (DEPTH, DA_QK_DIM), 0.1),
        'da_lambda_q2': nrm(8, (DEPTH, DA_QK_DIM), 0.1),
        'da_lambda_k2': nrm(9, (DEPTH, DA_QK_DIM), 0.1),
        'da_subln_gain': gain(10, (DEPTH, DA_V_DIM)),
        'hg_lower_bounds': nrm(11, (DEPTH, HG_K_COLS), 0.1),
        'hg_out_gain': gain(12, (DEPTH, HG_VAL_DIM)),
        's5_lambda_re': -0.5 + nrm(13, gs, 0.01),
        's5_lambda_im': math.pi * jnp.arange(S5_STATE, dtype=F32) + nrm(14, gs, 0.01),
        's5_log_step': jax.random.uniform(ks[15], (DEPTH, S5_GROUPS), F32,
                                          math.log(S5_STEP_MIN), math.log(S5_STEP_MAX)),
        's5_b_re': nrm(16, (DEPTH, S5_GROUPS, S5_STATE, S5_GROUP_CH), (2 * S5_GROUP_CH) ** -0.5),
        's5_b_im': nrm(17, (DEPTH, S5_GROUPS, S5_STATE, S5_GROUP_CH), (2 * S5_GROUP_CH) ** -0.5),
        's5_c_re': nrm(18, (DEPTH, S5_GROUPS, S5_GROUP_CH, S5_STATE), (2 * S5_STATE) ** -0.5),
        's5_c_im': nrm(19, (DEPTH, S5_GROUPS, S5_GROUP_CH, S5_STATE), (2 * S5_STATE) ** -0.5),
        's5_d': nrm(20, (DEPTH, S5_WIDTH), 1.0),
        's5_glu_w': nrm(21, (DEPTH, S5_WIDTH, S5_WIDTH), S5_WIDTH ** -0.5),
        's5_glu_b': nrm(22, (DEPTH, S5_WIDTH), 0.01),
        'w_branch_attn': nrm(23, (DEPTH, DA_V_COLS, D_MODEL), DA_V_COLS ** -0.5),
        'w_branch_sb': nrm(24, (DEPTH, SB_COLS, D_MODEL), SB_COLS ** -0.5),
        'w_branch_hgrn': nrm(25, (DEPTH, HG_V_COLS, D_MODEL), HG_V_COLS ** -0.5),
        'w_branch_s5': nrm(26, (DEPTH, S5_WIDTH, D_MODEL), S5_WIDTH ** -0.5),
        'w_out': nrm(27, (DEPTH, D_MODEL, D_MODEL), D_MODEL ** -0.5),
        'norm_ffn': gain(28, (DEPTH, D_MODEL)),
        'router_group_w': nrm(29, (DEPTH, D_MODEL, N_GROUPS), D_MODEL ** -0.5),
        'router_group_b': nrm(30, (DEPTH, N_GROUPS), 0.01),
        'router_expert_w': nrm(31, (DEPTH, D_MODEL, N_EXPERTS), D_MODEL ** -0.5),
        'router_expert_b': nrm(32, (DEPTH, N_EXPERTS), 0.01),
        'expert_w_gate': nrm(33, (DEPTH, N_EXPERTS, D_MODEL, D_EXPERT), D_MODEL ** -0.5),
        'expert_w_up': nrm(34, (DEPTH, N_EXPERTS, D_MODEL, D_EXPERT), D_MODEL ** -0.5),
        'expert_w_down': nrm(35, (DEPTH, N_EXPERTS, D_EXPERT, D_MODEL), D_EXPERT ** -0.5),
    }


def reference(x, positions, norm_mix, w_in, da_q_gain, da_k_gain, da_lambda_q1, da_lambda_k1,
              da_lambda_q2, da_lambda_k2, da_subln_gain, hg_lower_bounds, hg_out_gain,
              s5_lambda_re, s5_lambda_im, s5_log_step, s5_b_re, s5_b_im, s5_c_re, s5_c_im,
              s5_d, s5_glu_w, s5_glu_b, w_branch_attn, w_branch_sb, w_branch_hgrn, w_branch_s5,
              w_out, norm_ffn, router_group_w, router_group_b, router_expert_w, router_expert_b,
              expert_w_gate, expert_w_up, expert_w_down):
    bsz, seq, _ = x.shape
    lb_all = jnp.cumsum(jax.nn.softmax(hg_lower_bounds.astype(F32), axis=0), axis=0)
    lb_all = lb_all - lb_all[0:1]
    for l in range(DEPTH):
        h = rms_norm(x, norm_mix[l])
        proj = h @ w_in[l]
        (da_q, da_k, da_v, sb_q, sb_k, sb_v, hg_f, hg_i, hg_q, hg_g, s5_u,
         gate_logits) = jnp.split(proj, SPLIT_POINTS, axis=-1)
        lambda_init = DA_LAMBDA_INIT_BASE - DA_LAMBDA_INIT_SCALE * math.exp(-DA_LAMBDA_INIT_RATE * l)
        y_a = differential_attention(da_q, da_k, da_v, positions, da_q_gain[l], da_k_gain[l],
                                     da_lambda_q1[l], da_lambda_k1[l], da_lambda_q2[l],
                                     da_lambda_k2[l], da_subln_gain[l], lambda_init)
        y_b = stick_breaking_attention(sb_q, sb_k, sb_v)
        y_c = hgrn2(hg_f, hg_i, hg_q, hg_g, lb_all[l], hg_out_gain[l])
        y_d = s5_layer(s5_u, s5_lambda_re[l], s5_lambda_im[l], s5_log_step[l], s5_b_re[l],
                       s5_b_im[l], s5_c_re[l], s5_c_im[l], s5_d[l], s5_glu_w[l], s5_glu_b[l])
        gates = jax.nn.sigmoid(gate_logits.astype(F32)).reshape(bsz, seq, N_BRANCHES, D_MODEL)
        gates = gates.astype(x.dtype)
        merged = (gates[:, :, 0] * (y_a.astype(x.dtype) @ w_branch_attn[l])
                  + gates[:, :, 1] * (y_b.astype(x.dtype) @ w_branch_sb[l])
                  + gates[:, :, 2] * (y_c.astype(x.dtype) @ w_branch_hgrn[l])
                  + gates[:, :, 3] * (y_d.astype(x.dtype) @ w_branch_s5[l]))
        x = x + merged @ w_out[l]
        x = x + hierarchical_moe(rms_norm(x, norm_ffn[l]), router_group_w[l], router_group_b[l],
                                 router_expert_w[l], router_expert_b[l], expert_w_gate[l],
                                 expert_w_up[l], expert_w_down[l])
    return x
```

```cpp
#include <hip/hip_runtime.h>
#include <cstdio>
#include <cstdint>
#include <cmath>

typedef unsigned short bf16_t;
typedef float f32x4 __attribute__((ext_vector_type(4)));
typedef unsigned u32x4 __attribute__((ext_vector_type(4)));
typedef unsigned u32x2 __attribute__((ext_vector_type(2)));
#define GAS __attribute__((address_space(1)))
#define LAS __attribute__((address_space(3)))
#define CAS __attribute__((address_space(4)))

constexpr int NB = 4, SEQ = 8192, NTOK = NB * SEQ, DM = 1024, DEPTH = 2, IN_COLS = 7680;
constexpr int C_GATE = 3584;
constexpr int NMIX = 3584;
constexpr float RMS_EPS = 1e-6f;
constexpr float QSCALE = 0.125f * 1.4426950408889634f;
constexpr int NEXP = 16, DEXP = 384, NBUCKET = 24, MPAD = NTOK + NBUCKET * 256;
constexpr int YC_LD = 1280, YC_Q = 0, YC_SB = 512, YC_HG = 768, YC_YD = 1024;

constexpr size_t MiB = 1u << 20;
constexpr size_t WS_CTL = 0;
constexpr size_t WS_SMALL = 1 * MiB;
constexpr size_t WS_XN = 2 * MiB;
constexpr size_t WS_O = 66 * MiB;
constexpr size_t WS_YCAT = 130 * MiB;
constexpr size_t WS_K = 210 * MiB;
constexpr size_t WS_V = 242 * MiB;
constexpr size_t WS_SBK = 274 * MiB, WS_SBV = 290 * MiB, WS_HGF = 306 * MiB, WS_HGI = 322 * MiB;
constexpr size_t WS_GATE = 210 * MiB;
constexpr size_t WS_HGG = 338 * MiB, WS_S5U = 354 * MiB  , WS_YG = 374 * MiB;
constexpr size_t WS_HGST = 390 * MiB, WS_S5ST = 422 * MiB  , WS_WTS = 432 * MiB, WS_END = 512 * MiB;
constexpr size_t WS_XS = 130 * MiB;
constexpr size_t WS_HID = 210 * MiB;
constexpr size_t WT_IN = 0, WT_P = 15 * MiB, WT_OUT = 18 * MiB, WT_GLU = 20 * MiB, WT_E1 = 21 * MiB, WT_E2 = 45 * MiB, WT_S5A = 57 * MiB  , WT_S5B = 61 * MiB  ;
constexpr size_t WT_KTAB = 75 * MiB  ;
constexpr size_t WT_APOW = 72 * MiB  , WT_BB = 73 * MiB  , WT_HGDEC = 74 * MiB  ;
constexpr int S5_LD = 640;
constexpr size_t SM_BUCKET = 0;
constexpr size_t SM_RANK = 131072;
constexpr size_t SM_TW = 262144;
constexpr size_t SM_SLOTTOK = 524288;
constexpr size_t SM_SLOTW = 524288 + 163840;
constexpr size_t SM_DUMMY = 1040384;
constexpr int CW_CNT = 8192, CNT_LSTRIDE = 2048;
constexpr int CW_BAR = 4096;

__device__ __forceinline__ float bf2f(bf16_t v) { return __uint_as_float((unsigned)v << 16); }
__device__ __forceinline__ bf16_t f2bf(float f) { unsigned u = __float_as_uint(f); return (bf16_t)((u + 0x7fffu + ((u >> 16) & 1u)) >> 16); }
__device__ __forceinline__ unsigned pk2(float lo, float hi) { return (unsigned)f2bf(lo) | ((unsigned)f2bf(hi) << 16); }
__device__ __forceinline__ float shx(float v, int m, int lane) { return __int_as_float(__builtin_amdgcn_ds_bpermute((lane ^ m) << 2, __float_as_int(v))); }
__device__ __forceinline__ float shl_(float v, int src) { return __int_as_float(__builtin_amdgcn_ds_bpermute(src << 2, __float_as_int(v))); }
__device__ __forceinline__ int shl_i(int v, int src) { return __builtin_amdgcn_ds_bpermute(src << 2, v); }
__device__ __forceinline__ float wave_sum_dpp(float v) {
    v += __int_as_float(__builtin_amdgcn_update_dpp(0, __float_as_int(v), 0xb1, 0xf, 0xf, true));
    v += __int_as_float(__builtin_amdgcn_update_dpp(0, __float_as_int(v), 0x4e, 0xf, 0xf, true));
    v += __int_as_float(__builtin_amdgcn_update_dpp(0, __float_as_int(v), 0x114, 0xf, 0xf, true));
    v += __int_as_float(__builtin_amdgcn_update_dpp(0, __float_as_int(v), 0x118, 0xf, 0xf, true));
    v += __int_as_float(__builtin_amdgcn_update_dpp(0, __float_as_int(v), 0x142, 0xa, 0xf, true));
    v += __int_as_float(__builtin_amdgcn_update_dpp(0, __float_as_int(v), 0x143, 0xc, 0xf, true));
    return __int_as_float(__builtin_amdgcn_readlane(__float_as_int(v), 63));
}
__device__ __forceinline__ float wave_sum(float v, int lane) {
#pragma unroll
    for (int o = 1; o < 64; o <<= 1) v += shx(v, o, lane);
    return v;
}
__device__ __forceinline__ float sigmoidf_(float x) { return 1.f / (1.f + __expf(-x)); }
__device__ __forceinline__ float softplusf_(float x) { return fmaxf(x, 0.f) + log1pf(__expf(-fabsf(x))); }

namespace pg8 {
#define PG8_LAS __attribute__((address_space(3)))
typedef short bf16x8 __attribute__((ext_vector_type(8)));
constexpr int BM = 256, BK = 64, HALF = 128, HTB = HALF * BK * 2  , STAGE_BYTES = 8 * HTB, NXCD = 8, WGM = 8;

__host__ __device__ __forceinline__ int lds_byte(int r, int c) { const int st = (r >> 4) * 2 + (c >> 5), rr = r & 15, cc = c & 31, ob = rr * 64 + cc * 2; return st * 1024 + (ob ^ (((ob >> 9) & 1) << 5)); }
__host__ __device__ __forceinline__ void stage_rc(int b, int& R, int& C) { const int st = b / 1024, sb = b % 1024, swz = sb ^ (((sb >> 9) & 1) << 5); R = (st >> 1) * 16 + swz / 64; C = (st & 1) * 32 + (swz % 64) / 2; }
__host__ __device__ __forceinline__ int perm32(int rho) { const int n = rho >> 4, i = rho & 15; return 8 * (i >> 2) + 4 * n + (i & 3); }

struct Unit { unsigned aoff, boff; int nt, pm, pn, aux; };
struct Gemm { const bf16_t* A; const bf16_t* Bt; int lda, ldb; };

struct TileOrder {
    int nM, nN, nwg, G, c;
    __device__ __forceinline__ void init(int nM_, int nN_, int G_, int c_) { nM = nM_; nN = nN_; nwg = nM * nN; G = G_; c = c_; }
    __device__ __forceinline__ bool tile(int i, int& pm, int& pn) const {
        const int L = i * G + c; if (L >= nwg) return false;
        int wgid = L; { const int q = nwg / NXCD, r = nwg % NXCD, xcd = wgid % NXCD, off = wgid / NXCD; wgid = (xcd < r ? xcd * (q + 1) : r * (q + 1) + (xcd - r) * q) + off; }
        const int nig = WGM * nN, gid = wgid / nig, fm = gid * WGM, gsz = (nM - fm) < WGM ? (nM - fm) : WGM;
        pm = fm + ((wgid % nig) % gsz); pn = (wgid % nig) / gsz; return true;
    }
};
struct PlainSched {
    TileOrder o; int lda, ldb, nt, pn0;
    __device__ __forceinline__ bool next(int i, Unit& u) const { int pm, pn; if (!o.tile(i, pm, pn)) return false;
        u.aoff = (unsigned)pm * 256u * lda * 2u; u.boff = (unsigned)(pn0 + pn) * 256u * ldb * 2u; u.nt = nt; u.pm = pm; u.pn = pn; u.aux = 0; return true; }
    __device__ __forceinline__ void a_ready(const Unit&) const {}
    __device__ __forceinline__ void done(const Unit&) const {}
};
struct BranchSched {
    TileOrder o;
    __device__ __forceinline__ bool next(int i, Unit& u) const { int pm, pn; if (!o.tile(i, pm, pn)) return false;
        u.aoff = (unsigned)pm * 256u * YC_LD * 2u; u.boff = (unsigned)pn * 256u * YC_LD * 2u; u.nt = 20; u.pm = pm; u.pn = pn; u.aux = 0; return true; }
    __device__ __forceinline__ void a_ready(const Unit&) const {}
    __device__ __forceinline__ void done(const Unit&) const {}
};
__device__ __forceinline__ void pair_experts(int b, int& e0, int& e1) { const int g = b / 6, p = b % 6; const int lo = p < 3 ? 0 : (p < 5 ? 1 : 2), hi = p < 3 ? p + 1 : (p < 5 ? p - 1 : 3); e0 = g * 4 + lo; e1 = g * 4 + hi; }
constexpr int MOE_TBL_TOT = MPAD / 256;
__device__ __forceinline__ void moe_table(PG8_LAS int* tbl, const unsigned* cnt) {
    int t = threadIdx.x; asm volatile("" : "+v"(t));
    if (t <= MOE_TBL_TOT) { int tot = 0, bsel = NBUCKET - 1, found = 0;
#pragma nounroll
        for (int b = 0; b < NBUCKET; ++b) { const int tb = (int)((__hip_atomic_load(cnt + 64 * b, __ATOMIC_RELAXED, __HIP_MEMORY_SCOPE_AGENT) + 255u) >> 8); if (!found && t < tot + tb) { bsel = b; found = 1; } tot += tb; }
        tbl[t] = t == MOE_TBL_TOT ? tot : bsel; }
    __syncthreads();
}
template <int PHASE> struct MoeSched {
    const PG8_LAS int* tbl; int G, c;
    __device__ __forceinline__ bool next(int i, Unit& u) const {
        constexpr int NT = PHASE == 1 ? 6 : 4;
        const int L = i * G + c, pm = L / NT, pn = L % NT;
        if (pm >= __builtin_amdgcn_readfirstlane(tbl[MOE_TBL_TOT])) return false;
        const int bsel = __builtin_amdgcn_readfirstlane(tbl[pm]);
        int e0, e1; pair_experts(bsel, e0, e1);
        u.pm = pm; u.pn = pn; u.aux = 0;
        if (PHASE == 1) { const int sel = pn / 3, jt = pn % 3, e = sel ? e1 : e0;
            u.aoff = (unsigned)pm * 256u * DM * 2u; u.boff = (unsigned)(e * 3 + jt) * 256u * DM * 2u; u.nt = 16; }
        else { u.aoff = (unsigned)pm * 256u * 768u * 2u; u.boff = ((unsigned)bsel * 1024u + (unsigned)pn * 256u) * 768u * 2u; u.nt = 12; }
        return true;
    }
    __device__ __forceinline__ void a_ready(const Unit&) const {}
    __device__ __forceinline__ void done(const Unit&) const {}
};

__device__ __forceinline__ unsigned cvt_pk_bf16(float lo, float hi) { unsigned r; asm volatile("v_cvt_pk_bf16_f32 %0, %1, %2" : "=v"(r) : "v"(lo), "v"(hi)); return r; }
__device__ __forceinline__ u32x4 pack8(const f32x4 a, const f32x4 b) { u32x4 w; w.x = cvt_pk_bf16(a[0], a[1]); w.y = cvt_pk_bf16(a[2], a[3]); w.z = cvt_pk_bf16(b[0], b[1]); w.w = cvt_pk_bf16(b[2], b[3]); return w; }
__device__ __forceinline__ float fsig(float x) { return __builtin_amdgcn_rcpf(1.f + __builtin_amdgcn_exp2f(-1.4426950408889634f * x)); }
#define PG8_EPI_LOOP for (int ai = 0; ai < 2; ++ai) _Pragma("unroll") for (int m = 0; m < 4; ++m) _Pragma("unroll") for (int bj = 0; bj < 3; ++bj) if (bj == 2) { asm volatile("" ::: "memory"); } else

struct EpiInMix {
    static constexpr bool PERM = true, AFTER_DRAIN = false, MID = false; unsigned char* ws;
    __device__ __forceinline__ void operator()(const f32x4 (&acc)[2][2][4][2], const Unit& u, int wr, int wc, int fr, int fq) const {
        const int pn = u.pn; bf16_t* base; int ld;
        if (pn < 2) { base = (bf16_t*)(ws + WS_YCAT) + YC_Q + pn * 256; ld = YC_LD; }
        else if (pn < 4) { base = (bf16_t*)(ws + WS_K) + (pn - 2) * 256; ld = 512; }
        else if (pn < 6) { base = (bf16_t*)(ws + WS_V) + (pn - 4) * 256; ld = 512; }
        else if (pn == 6) { base = (bf16_t*)(ws + WS_YCAT) + YC_SB; ld = YC_LD; }
        else if (pn == 7) { base = (bf16_t*)(ws + WS_SBK); ld = 256; }
        else if (pn == 8) { base = (bf16_t*)(ws + WS_SBV); ld = 256; }
        else if (pn == 9) { base = (bf16_t*)(ws + WS_HGF); ld = 256; }
        else if (pn == 10) { base = (bf16_t*)(ws + WS_HGI); ld = 256; }
        else if (pn == 11) { base = (bf16_t*)(ws + WS_YCAT) + YC_HG; ld = YC_LD; }
        else if (pn == 12) { base = (bf16_t*)(ws + WS_HGG); ld = 256; }
        else { base = (bf16_t*)(ws + WS_S5U); ld = 16; }
        const int row0 = u.pm * BM + wr * 64 + fr, col0 = wc * 32 + 8 * fq;
#pragma unroll
        PG8_EPI_LOOP { const int row = row0 + ai * HALF + m * 16, col = col0 + bj * HALF; const u32x4 w = pack8(acc[ai][bj][m][0], acc[ai][bj][m][1]);
            if (pn == 13) *(u32x4*)(base + ((size_t)(col >> 4) * 1024 + (row >> 5)) * S5_LD + (row & 31) * 16 + (col & 15)) = w;
            else *(u32x4*)(base + (size_t)row * ld + col) = w; }
    }
};
struct EpiGateU8 {
    static constexpr bool PERM = true, AFTER_DRAIN = false, MID = false; unsigned char* G;
    __device__ __forceinline__ void operator()(const f32x4 (&acc)[2][2][4][2], const Unit& u, int wr, int wc, int fr, int fq) const {
        const int row0 = u.pm * BM + wr * 64 + fr, col0 = u.pn * BM + wc * 32 + 8 * fq;
#pragma unroll
        PG8_EPI_LOOP { const f32x4 a = acc[ai][bj][m][0], b = acc[ai][bj][m][1]; unsigned q[8];
#pragma unroll
            for (int i = 0; i < 4; ++i) { q[i] = (unsigned)(fsig(a[i]) * 255.f + 0.5f); q[4 + i] = (unsigned)(fsig(b[i]) * 255.f + 0.5f); }
            u32x2 w; w.x = q[0] | (q[1] << 8) | (q[2] << 16) | (q[3] << 24); w.y = q[4] | (q[5] << 8) | (q[6] << 16) | (q[7] << 24);
            *(u32x2*)(G + (size_t)(row0 + ai * HALF + m * 16) * 4096 + col0 + bj * HALF) = w; }
    }
};
struct EpiBranch {
    static constexpr bool PERM = true, AFTER_DRAIN = false, MID = true; const unsigned char* G; bf16_t* Mg;
    __device__ __forceinline__ void mid(f32x4 (&acc)[2][2][4][2], const Unit& u, int t, int, int, int, int) const {
        int tid = threadIdx.x; asm volatile("" : "+v"(tid));
        const int wid = __builtin_amdgcn_readfirstlane(tid >> 6), wr = wid >> 2, wc = wid & 3, fr = tid & 15, fq = (tid & 63) >> 4;
        const int row0 = u.pm * BM + wr * 64 + fr, col0 = u.pn * BM + wc * 32 + 8 * fq, sh = 2 * t - 16;
#pragma unroll
        PG8_EPI_LOOP { const unsigned char* gp = G + (size_t)(row0 + ai * HALF + m * 16) * 4096 + (col0 + bj * HALF) * 4; const u32x4 g0 = *(const u32x4*)gp, g1 = *(const u32x4*)(gp + 16);
#pragma unroll
            for (int i = 0; i < 4; ++i) { acc[ai][bj][m][0][i] *= fmaxf((float)((g0[i] >> sh) & 255u), 0.5f) * __builtin_amdgcn_rcpf(fmaxf((float)((g0[i] >> (sh + 8)) & 255u), 0.5f));
                                          acc[ai][bj][m][1][i] *= fmaxf((float)((g1[i] >> sh) & 255u), 0.5f) * __builtin_amdgcn_rcpf(fmaxf((float)((g1[i] >> (sh + 8)) & 255u), 0.5f)); } }
    }
    __device__ __forceinline__ void operator()(const f32x4 (&acc)[2][2][4][2], const Unit& u, int, int, int, int) const {
        int tid = threadIdx.x; asm volatile("" : "+v"(tid));
        const int wid = __builtin_amdgcn_readfirstlane(tid >> 6), wr = wid >> 2, wc = wid & 3, fr = tid & 15, fq = (tid & 63) >> 4;
        const int row0 = u.pm * BM + wr * 64 + fr, col0 = u.pn * BM + wc * 32 + 8 * fq;
#pragma unroll
        PG8_EPI_LOOP { const int row = row0 + ai * HALF + m * 16, col = col0 + bj * HALF;
            const unsigned char* gp = G + (size_t)row * 4096 + col * 4; const u32x4 g0 = *(const u32x4*)gp, g1 = *(const u32x4*)(gp + 16);
            f32x4 a = acc[ai][bj][m][0], b = acc[ai][bj][m][1];
#pragma unroll
            for (int i = 0; i < 4; ++i) { a[i] *= fmaxf((float)(g0[i] >> 24), 0.5f) * (1.f / 255.f); b[i] *= fmaxf((float)(g1[i] >> 24), 0.5f) * (1.f / 255.f); }
            *(u32x4*)(Mg + (size_t)row * DM + col) = pack8(a, b); }
    }
};
struct EpiOutRes {
    static constexpr bool PERM = true, AFTER_DRAIN = false, MID = false; const float* xi; float* xo;
    __device__ __forceinline__ void operator()(const f32x4 (&acc)[2][2][4][2], const Unit& u, int wr, int wc, int fr, int fq) const {
        const int row0 = u.pm * BM + wr * 64 + fr, col0 = u.pn * BM + wc * 32 + 8 * fq;
#pragma unroll
        PG8_EPI_LOOP { const size_t off = (size_t)(row0 + ai * HALF + m * 16) * DM + col0 + bj * HALF;
            const f32x4 a = *(const f32x4*)(xi + off), b = *(const f32x4*)(xi + off + 4);
            *(f32x4*)(xo + off) = a + acc[ai][bj][m][0]; *(f32x4*)(xo + off + 4) = b + acc[ai][bj][m][1]; }
    }
};
struct EpiGlu {
    static constexpr bool PERM = true, AFTER_DRAIN = false, MID = false; const bf16_t* yg; const float* bias; bf16_t* yc;
    __device__ __forceinline__ void operator()(const f32x4 (&acc)[2][2][4][2], const Unit& u, int wr, int wc, int fr, int fq) const {
        const int row0 = u.pm * BM + wr * 64 + fr, col0 = wc * 32 + 8 * fq;
#pragma unroll
        PG8_EPI_LOOP { const int row = row0 + ai * HALF + m * 16, col = col0 + bj * HALF;
            const u32x4 p = *(const u32x4*)(yg + (size_t)row * 256 + col); const f32x4 b0 = *(const f32x4*)(bias + col), b1 = *(const f32x4*)(bias + col + 4);
            f32x4 a = acc[ai][bj][m][0] + b0, b = acc[ai][bj][m][1] + b1;
            const float y[8] = {__uint_as_float(p.x << 16), __uint_as_float(p.x & 0xffff0000u), __uint_as_float(p.y << 16), __uint_as_float(p.y & 0xffff0000u),
                                __uint_as_float(p.z << 16), __uint_as_float(p.z & 0xffff0000u), __uint_as_float(p.w << 16), __uint_as_float(p.w & 0xffff0000u)};
#pragma unroll
            for (int i = 0; i < 4; ++i) { a[i] = y[i] * fsig(a[i]); b[i] = y[4 + i] * fsig(b[i]); }
            *(u32x4*)(yc + (size_t)row * YC_LD + YC_YD + col) = pack8(a, b); }
    }
};
struct S5aSched {
    int G, c;
    __device__ __forceinline__ bool next(int i, Unit& u) const { const int L = i * G + c; if (L >= 64) return false; const int g = L >> 2, pm = L & 3;
        u.aoff = ((unsigned)(g * 1024 + pm * 256) * S5_LD) * 2u; u.boff = (unsigned)g * 256u * 512u * 2u; u.nt = 8; u.pm = g * 4 + pm; u.pn = 0; u.aux = 0; return true; }
    __device__ __forceinline__ void a_ready(const Unit&) const {}
    __device__ __forceinline__ void done(const Unit&) const {}
};
struct S5bSched {
    int G, c;
    __device__ __forceinline__ bool next(int i, Unit& u) const { const int L = i * G + c; if (L >= 128) return false; const int g = L >> 3, pm = (L >> 1) & 3, pn = L & 1;
        u.aoff = ((unsigned)(g * 1024 + pm * 256) * S5_LD) * 2u; u.boff = ((unsigned)(g * 512 + pn * 256) * S5_LD) * 2u; u.nt = 10; u.pm = g * 4 + pm; u.pn = pn; u.aux = g; return true; }
    __device__ __forceinline__ void a_ready(const Unit&) const {}
    __device__ __forceinline__ void done(const Unit&) const {}
};
struct EpiS5a {
    static constexpr bool PERM = true, AFTER_DRAIN = false, MID = false; float* st;
    __device__ __forceinline__ void operator()(const f32x4 (&acc)[2][2][4][2], const Unit& u, int wr, int wc, int fr, int fq) const {
        const int row0 = u.pm * BM + wr * 64 + fr, col0 = wc * 32 + 8 * fq;
#pragma unroll
        for (int ai = 0; ai < 2; ++ai)
#pragma unroll
            for (int m = 0; m < 4; ++m) { float* p = st + (size_t)(row0 + ai * HALF + m * 16) * 128 + col0; *(f32x4*)p = acc[ai][0][m][0]; *(f32x4*)(p + 4) = acc[ai][0][m][1]; }
    }
};
struct EpiS5b {
    static constexpr bool PERM = true, AFTER_DRAIN = false, MID = false; const bf16_t* s5u; const float* dsk; bf16_t* yg;
    __device__ __forceinline__ void operator()(const f32x4 (&acc)[2][2][4][2], const Unit& u, int wr, int wc, int fr, int fq) const {
        const int g = u.aux, row0 = u.pm * BM + wr * 64 + fr  , col0 = u.pn * BM + wc * 32 + 8 * fq, c0 = col0 & 15;
        const f32x4 d0 = *(const f32x4*)(dsk + g * 16 + c0), d1 = *(const f32x4*)(dsk + g * 16 + c0 + 4);
#pragma unroll
        PG8_EPI_LOOP { const int row = row0 + ai * HALF + m * 16, col = col0 + bj * HALF, chunk = row - g * 1024, t = col >> 4;
            const u32x4 p = *(const u32x4*)(s5u + (size_t)row * S5_LD + col);
            const float uu[8] = {__uint_as_float(p.x << 16), __uint_as_float(p.x & 0xffff0000u), __uint_as_float(p.y << 16), __uint_as_float(p.y & 0xffff0000u),
                                 __uint_as_float(p.z << 16), __uint_as_float(p.z & 0xffff0000u), __uint_as_float(p.w << 16), __uint_as_float(p.w & 0xffff0000u)};
            f32x4 a = acc[ai][bj][m][0], b = acc[ai][bj][m][1];
#pragma unroll
            for (int i = 0; i < 4; ++i) { float y = a[i] + d0[i] * uu[i]; float z = 0.7978845608028654f * (y + 0.044715f * y * y * y); a[i] = y * fsig(2.f * z);
                y = b[i] + d1[i] * uu[4 + i]; z = 0.7978845608028654f * (y + 0.044715f * y * y * y); b[i] = y * fsig(2.f * z); }
            *(u32x4*)(yg + (size_t)(chunk * 32 + t) * 256 + g * 16 + c0) = pack8(a, b); }
    }
};
struct EpiMoe1 {
    static constexpr bool PERM = true, AFTER_DRAIN = false, MID = false; bf16_t* hid; const float* slot_w;
    __device__ __forceinline__ void operator()(const f32x4 (&acc)[2][2][4][2], const Unit& u, int wr, int wc, int fr, int fq) const {
        const int row0 = u.pm * BM + wr * 64 + fr, sel = u.pn / 3, col0 = sel * DEXP + (u.pn % 3) * 128 + wc * 32 + 8 * fq;
#pragma unroll
        for (int ai = 0; ai < 2; ++ai)
#pragma unroll
            for (int m = 0; m < 4; ++m) { const int row = row0 + ai * HALF + m * 16; const float w = slot_w[2 * row + sel]; f32x4 a, b;
#pragma unroll
                for (int i = 0; i < 4; ++i) { const float g0 = acc[ai][0][m][0][i], g1 = acc[ai][0][m][1][i]; a[i] = g0 * fsig(g0) * acc[ai][1][m][0][i] * w; b[i] = g1 * fsig(g1) * acc[ai][1][m][1][i] * w; }
                *(u32x4*)(hid + (size_t)row * 768 + col0) = pack8(a, b); asm volatile("" ::: "memory"); }
    }
};
struct EpiMoe2 {
    static constexpr bool PERM = true, AFTER_DRAIN = false, MID = false; float* x; const int* slot_tok; float* dummy;
    __device__ __forceinline__ void operator()(const f32x4 (&acc)[2][2][4][2], const Unit& u, int wr, int wc, int fr, int fq) const {
        const int row0 = u.pm * BM + wr * 64 + fr, col0 = u.pn * BM + wc * 32 + 8 * fq;
#pragma unroll
        for (int ai = 0; ai < 2; ++ai)
#pragma unroll
            for (int m = 0; m < 4; ++m) { const int t = slot_tok[row0 + ai * HALF + m * 16]; float* rowp = (t >= 0 ? x + (size_t)t * DM : dummy) + col0;
#pragma unroll
                for (int bj = 0; bj < 2; ++bj) { float* p = rowp + bj * HALF; const f32x4 a = *(const f32x4*)p, b = *(const f32x4*)(p + 4);
                    *(f32x4*)p = a + acc[ai][bj][m][0]; *(f32x4*)(p + 4) = b + acc[ai][bj][m][1]; }
                asm volatile("" ::: "memory"); }
    }
};

template <class Epi, class Sched, bool ALIGN_EPI = false, bool SP2 = false>
__device__ __forceinline__ void gemm_phase(PG8_LAS unsigned char* lds, const Gemm g, const Sched& S, const Epi& E) {
    int tid_ = threadIdx.x; asm volatile("" : "+v"(tid_));
    const int tid = tid_, wid = __builtin_amdgcn_readfirstlane(tid >> 6), lane = tid & 63, wr = wid >> 2, wc = wid & 3, fr = lane & 15, fq = lane >> 4;
    unsigned voffA[2], voffB[2];
#pragma unroll
    for (int i = 0; i < 2; ++i) { int R, C; stage_rc(tid * 16 + i * 8192, R, C); const int Rb = Epi::PERM ? ((R & ~31) + perm32(R & 31)) : R;
        voffA[i] = (unsigned)(R * g.lda + C) * 2u; voffB[i] = (unsigned)(Rb * g.ldb + C) * 2u; }
    const size_t kstep = (size_t)(BK * 2);
    const size_t hstepA = (size_t)HALF * g.lda * 2, hstepB = (size_t)HALF * g.ldb * 2;
    const unsigned ldsw = (unsigned)wid * 1024u;
    const int aoff = lds_byte(wr * 64 + fr, fq * 8), boff = lds_byte(wc * 32 + fr, fq * 8);
#define PG8_SA(b, h) (((b) * 2 + (h)) * HTB)
#define PG8_SB(b, h) ((4 + (b) * 2 + (h)) * HTB)
#define PG8_STAGE(bufoff, gbase, voff) do { _Pragma("unroll") for (int _i = 0; _i < 2; ++_i) \
        __builtin_amdgcn_global_load_lds((const unsigned*)((const char*)(gbase) + (voff)[_i]), (PG8_LAS unsigned*)(lds + (bufoff) + ldsw + _i * 8192), 16, 0, 0); } while (0)
#define PG8_LDA(dst, b, h) do { _Pragma("unroll") for (int m = 0; m < 4; ++m) _Pragma("unroll") for (int k = 0; k < 2; ++k) dst[m][k] = *(const PG8_LAS bf16x8*)(lds + PG8_SA(b, h) + aoff + m * 2048 + k * 1024); } while (0)
#define PG8_LDB(dst, b, h) do { _Pragma("unroll") for (int n = 0; n < 2; ++n) _Pragma("unroll") for (int k = 0; k < 2; ++k) dst[n][k] = *(const PG8_LAS bf16x8*)(lds + PG8_SB(b, h) + boff + n * 2048 + k * 1024); } while (0)
#define PG8_MMA(ai, bj, At, Bt) do { __builtin_amdgcn_s_setprio(1); _Pragma("unroll") for (int m = 0; m < 4; ++m) _Pragma("unroll") for (int n = 0; n < 2; ++n) _Pragma("unroll") for (int k = 0; k < 2; ++k) \
        acc[ai][bj][m][n] = __builtin_amdgcn_mfma_f32_16x16x32_bf16(Bt[n][k], At[m][k], acc[ai][bj][m][n], 0, 0, 0); __builtin_amdgcn_s_setprio(0); } while (0)
#define PG8_WAIT_V(n) asm volatile("s_waitcnt vmcnt(" #n ")" ::: "memory")
#define PG8_WAIT_L(n) asm volatile("s_waitcnt lgkmcnt(" #n ")" ::: "memory")
#define PG8_BAR __builtin_amdgcn_s_barrier()
#define PG8_SCHED __builtin_amdgcn_sched_barrier(0)
    Unit cur; int ui = 0;
    if (!S.next(0, cur)) return;
    f32x4 acc[2][2][4][2];
#pragma unroll
    for (int a = 0; a < 2; ++a)
#pragma unroll
        for (int b = 0; b < 2; ++b)
#pragma unroll
            for (int m = 0; m < 4; ++m)
#pragma unroll
                for (int n = 0; n < 2; ++n) acc[a][b][m][n] = (f32x4){0.f, 0.f, 0.f, 0.f};
    bf16x8 At[4][2], B0[2][2], B1[2][2];
    const char* cA = (const char*)g.A + cur.aoff; const char* cB = (const char*)g.Bt + cur.boff;
    S.a_ready(cur);
    if constexpr (SP2) {
        PG8_STAGE(PG8_SB(0, 0), cB, voffB); PG8_STAGE(PG8_SB(0, 1), cB + hstepB, voffB); PG8_STAGE(PG8_SA(0, 0), cA, voffA); PG8_STAGE(PG8_SA(0, 1), cA + hstepA, voffA);
        if (wr == 1) PG8_BAR;
        PG8_WAIT_V(2); PG8_BAR;
        PG8_STAGE(PG8_SB(1, 0), cB + kstep, voffB); PG8_STAGE(PG8_SA(1, 0), cA + kstep, voffA); PG8_STAGE(PG8_SB(1, 1), cB + hstepB + kstep, voffB);
        PG8_WAIT_V(6); PG8_BAR;
    } else {
        PG8_STAGE(PG8_SB(0, 0), cB, voffB); PG8_STAGE(PG8_SA(0, 0), cA, voffA); PG8_STAGE(PG8_SB(0, 1), cB + hstepB, voffB); PG8_STAGE(PG8_SA(0, 1), cA + hstepA, voffA);
        if (wr == 1) PG8_BAR;
        PG8_WAIT_V(4); PG8_BAR;
        PG8_STAGE(PG8_SB(1, 0), cB + kstep, voffB); PG8_STAGE(PG8_SA(1, 0), cA + kstep, voffA); PG8_STAGE(PG8_SB(1, 1), cB + hstepB + kstep, voffB);
        PG8_WAIT_V(6); PG8_BAR;
    }
    for (;;) {
        Unit nxt; const bool has_next = S.next(ui + 1, nxt);
        const char* nA = has_next ? (const char*)g.A + nxt.aoff : cA; const char* nB = has_next ? (const char*)g.Bt + nxt.boff : cB;
        const int nt = cur.nt;
        for (int t = 0; t < nt; t += 2) {
            const bool last = (t == nt - 2);
            const char* a1 = cA + (size_t)(t + 1) * kstep;
            const char* a2 = last ? nA : cA + (size_t)(t + 2) * kstep; const char* b2 = last ? nB : cB + (size_t)(t + 2) * kstep;
            const char* a3 = a2 + kstep; const char* b3 = b2 + kstep;
            if (last && has_next) S.a_ready(nxt);
            if constexpr (Epi::MID) { if (t == 8 || t == 12 || t == 16) E.mid(acc, cur, t, wr, wc, fr, fq); }
            if constexpr (SP2) {
            PG8_LDB(B0, 0, 0); PG8_LDB(B1, 0, 1); PG8_SCHED; PG8_LDA(At, 0, 0); PG8_STAGE(PG8_SA(1, 1), a1 + hstepA, voffA);
            PG8_WAIT_V(8); PG8_WAIT_L(0); PG8_BAR; PG8_MMA(0, 0, At, B0); PG8_MMA(0, 1, At, B1); PG8_BAR; PG8_SCHED;
            PG8_LDA(At, 0, 1); PG8_STAGE(PG8_SB(0, 0), b2, voffB); PG8_STAGE(PG8_SB(0, 1), b2 + hstepB, voffB); PG8_STAGE(PG8_SA(0, 0), a2, voffA);
            PG8_WAIT_V(8); PG8_WAIT_L(0); PG8_BAR; PG8_MMA(1, 0, At, B0); PG8_MMA(1, 1, At, B1); PG8_BAR; PG8_SCHED;
            PG8_LDB(B0, 1, 0); PG8_LDB(B1, 1, 1); PG8_SCHED; PG8_LDA(At, 1, 0); PG8_STAGE(PG8_SA(0, 1), a2 + hstepA, voffA);
            PG8_WAIT_V(8); PG8_WAIT_L(0); PG8_BAR; PG8_MMA(0, 0, At, B0); PG8_MMA(0, 1, At, B1); PG8_BAR; PG8_SCHED;
            PG8_LDA(At, 1, 1); PG8_STAGE(PG8_SB(1, 0), b3, voffB); PG8_STAGE(PG8_SB(1, 1), b3 + hstepB, voffB); PG8_STAGE(PG8_SA(1, 0), a3, voffA);
            PG8_WAIT_V(8); PG8_WAIT_L(0); PG8_BAR; PG8_MMA(1, 0, At, B0); PG8_MMA(1, 1, At, B1); PG8_BAR; PG8_SCHED;
            } else {
            PG8_LDB(B0, 0, 0); PG8_SCHED; PG8_LDA(At, 0, 0); PG8_STAGE(PG8_SA(1, 1), a1 + hstepA, voffA);
            PG8_WAIT_L(8); PG8_BAR; PG8_WAIT_L(0); PG8_MMA(0, 0, At, B0); PG8_BAR; PG8_SCHED;
            PG8_LDB(B1, 0, 1); PG8_STAGE(PG8_SB(0, 0), b2, voffB);
            PG8_BAR; PG8_WAIT_L(0); PG8_MMA(0, 1, At, B1); PG8_BAR;
            PG8_LDA(At, 0, 1); PG8_STAGE(PG8_SA(0, 0), a2, voffA);
            PG8_BAR; PG8_WAIT_L(0); PG8_MMA(1, 0, At, B0); PG8_BAR; PG8_SCHED;
            PG8_STAGE(PG8_SB(0, 1), b2 + hstepB, voffB);
            PG8_WAIT_V(6); PG8_BAR; PG8_MMA(1, 1, At, B1); PG8_BAR;
            PG8_LDB(B0, 1, 0); PG8_SCHED; PG8_LDA(At, 1, 0); PG8_STAGE(PG8_SA(0, 1), a2 + hstepA, voffA);
            PG8_WAIT_L(8); PG8_BAR; PG8_WAIT_L(0); PG8_MMA(0, 0, At, B0); PG8_BAR; PG8_SCHED;
            PG8_LDB(B1, 1, 1); PG8_STAGE(PG8_SB(1, 0), b3, voffB);
            PG8_BAR; PG8_WAIT_L(0); PG8_MMA(0, 1, At, B1); PG8_BAR;
            PG8_LDA(At, 1, 1); PG8_STAGE(PG8_SA(1, 0), a3, voffA);
            PG8_BAR; PG8_WAIT_L(0); PG8_MMA(1, 0, At, B0); PG8_BAR; PG8_SCHED;
            PG8_STAGE(PG8_SB(1, 1), b3 + hstepB, voffB);
            PG8_WAIT_V(6); PG8_BAR; PG8_MMA(1, 1, At, B1); PG8_BAR;
            }
        }
        if constexpr (ALIGN_EPI) { if (wr == 0) PG8_BAR; }
        if constexpr (!Epi::AFTER_DRAIN) { E(acc, cur, wr, wc, fr, fq); S.done(cur); }
        if (!has_next) break;
#pragma unroll
        for (int a = 0; a < 2; ++a)
#pragma unroll
            for (int b = 0; b < 2; ++b)
#pragma unroll
                for (int m = 0; m < 4; ++m)
#pragma unroll
                    for (int n = 0; n < 2; ++n) acc[a][b][m][n] = (f32x4){0.f, 0.f, 0.f, 0.f};
        cA = nA; cB = nB; ++ui; (void)S.next(ui, cur);
        if constexpr (ALIGN_EPI) { if (wr == 1) PG8_BAR; }
    }
    PG8_WAIT_V(0);
    if constexpr (!ALIGN_EPI) { if (wr == 0) PG8_BAR; }
    PG8_BAR;
    if constexpr (Epi::AFTER_DRAIN) { E.fused(acc, cur, wr, wc, fr, fq, lds, wid, lane); S.done(cur); }
#undef PG8_SA
#undef PG8_SB
#undef PG8_STAGE
#undef PG8_LDA
#undef PG8_LDB
#undef PG8_MMA
#undef PG8_WAIT_V
#undef PG8_WAIT_L
#undef PG8_BAR
#undef PG8_SCHED
}
}

#include <hip/hip_bf16.h>
#include <cmath>
namespace attn_body {
using bf16=__hip_bfloat16;
using bf16x8=__attribute__((ext_vector_type(8)))short;
using s16x4=__attribute__((ext_vector_type(4)))short;
using f32x16=__attribute__((ext_vector_type(16)))float;
using u32x4=__attribute__((ext_vector_type(4)))unsigned;
constexpr int BATCH=4,NHEAD=16,SEQ=8192,D=64;
constexpr int QP=1280,KP=512,VP=512,OP=1024;
constexpr int NW=8,QBLK=32,QB=QBLK*NW,KVBLK=64,NQB=SEQ/QB;
constexpr int ATTN_UNIT_ROWS=QB;
__device__ __forceinline__ int crow(int r,int hi){return (r&3)+8*(r>>2)+4*hi;}
#define SBAR() __builtin_amdgcn_sched_barrier(0)
__device__ __forceinline__ void cmask(f32x16&p0,f32x16&p1,int jb,int qrel,int hi){
  const float NEG=-INFINITY; int kb=64*jb+4*hi;
  #pragma unroll
  for(int r=0;r<16;++r){int kv=kb+(r&3)+8*(r>>2); if(kv>qrel)p0[r]=NEG; if(kv+32>qrel)p1[r]=NEG;}
}

constexpr int NSLOT=3, SLOTB=8192;
constexpr int LDS_K=0, LDS_V=NSLOT*SLOTB, LDS_WS=2*NSLOT*SLOTB, LDS_OST=LDS_WS+NW*64*4, LDS_BYTES=LDS_OST+NW*4096;
constexpr float C2=0.125f*1.4426950408889634f;
__device__ __forceinline__ void glds16(const void*gsrc,unsigned lds_dst){unsigned keep;
  asm volatile("s_mov_b32 %0, m0\n\ts_mov_b32 m0, %2\n\ts_nop 0\n\tglobal_load_lds_dwordx4 %1, off\n\ts_mov_b32 m0, %0":"=&s"(keep):"v"(gsrc),"s"(lds_dst):"memory");}
__device__ __forceinline__ float max3f(float a,float b,float c){float r;asm("v_max3_f32 %0, %1, %2, %3":"=v"(r):"v"(a),"v"(b),"v"(c));return r;}
__device__ __forceinline__ float max2f(float a,float b){float r;asm("v_max_f32_e32 %0, %1, %2":"=v"(r):"v"(a),"v"(b));return r;}
__device__ __forceinline__ float fadd_s(float a,float b){float r;asm("v_add_f32_e32 %0, %1, %2":"=v"(r):"v"(a),"v"(b));return r;}
__device__ __forceinline__ float fsub_s(float a,float b){float r;asm("v_sub_f32_e32 %0, %1, %2":"=v"(r):"v"(a),"v"(b));return r;}
typedef float f32x2_t __attribute__((ext_vector_type(2))); typedef __bf16 bf16x2_t __attribute__((ext_vector_type(2)));
__device__ __forceinline__ unsigned cvtpk_s(float lo,float hi){f32x2_t v={lo,hi};bf16x2_t b=__builtin_convertvector(v,bf16x2_t);return __builtin_bit_cast(unsigned,b);}
#define WAIT_BAR(N) asm volatile("s_waitcnt vmcnt(" #N ") lgkmcnt(0)\n\ts_barrier":::"memory")

__device__ __forceinline__ float rowmax(const f32x16&p0,const f32x16&p1){
  float a=max3f(p0[0],p0[1],p1[0]),b=max3f(p0[2],p0[3],p1[1]);a=max3f(a,p1[2],p1[3]);
  #pragma unroll
  for(int r=4;r<16;r+=4){a=max3f(a,p0[r],p0[r+1]);b=max3f(b,p0[r+2],p0[r+3]);a=max3f(a,p1[r],p1[r+1]);b=max3f(b,p1[r+2],p1[r+3]);}
  const float m=max2f(a,b);
  auto rr=__builtin_amdgcn_permlane32_swap(__float_as_uint(m),__float_as_uint(m),false,false);
  return max2f(__uint_as_float(rr[0]),__uint_as_float(rr[1]));
}

#undef SBAR
#undef WAIT_BAR
}

namespace attn2 {
using attn_body::bf16; using attn_body::bf16x8; using attn_body::s16x4; using attn_body::f32x16; using attn_body::u32x4; using attn_body::crow; using attn_body::cmask; using attn_body::glds16; using attn_body::rowmax; using attn_body::cvtpk_s;
constexpr int SEQ = 8192, QP = 1280, KP = 512, VP = 512, OP = 1024, NW = 8, QBLK = 32, QB = 256, KVBLK = 64, NSLOT = 3, NVSLOT = 4, KSLOT = 8192, VSLOT = 16384;
constexpr int LDS_K = 0, LDS_V = NSLOT * KSLOT, LDS_WS = LDS_V + NVSLOT * VSLOT, LDS_OST = LDS_WS + NW * 64 * 4, LDS_BYTES = LDS_OST + NW * 4096;
typedef __attribute__((address_space(3))) const char* lds_cptr; typedef short v4i16_t __attribute__((ext_vector_type(4)));
__device__ __forceinline__ s16x4 vtr(lds_cptr p) { return __builtin_bit_cast(s16x4, __builtin_amdgcn_ds_read_tr16_b64_v4i16((__attribute__((address_space(3))) v4i16_t*)p)); }
template <int THRL> __device__ __forceinline__ void attn_unit(int b, int hc, int qb, const bf16* Q, const bf16* __restrict__ K, const bf16* __restrict__ V, bf16* O, char* shm) {
    int tid_ = threadIdx.x; asm volatile("" : "+v"(tid_)); const int tid = tid_, lane = tid & 63, r32 = lane & 31, hi = lane >> 5; const int wid = __builtin_amdgcn_readfirstlane(tid >> 6);
    const int qcol = hc * 64, kcol = hc * 64, vcol = (hc >> 1) * 128, ocol = hc * 128;
    const long rowbase = (long)b * SEQ; const int q0 = qb * QB;
    const bf16* Qw = Q + (rowbase + q0 + wid * QBLK) * QP + qcol;
    const bf16 *Kh = K + rowbase * KP + kcol, *Vh = V + rowbase * VP + vcol;
    const unsigned lds0 = (unsigned)(uintptr_t)shm;
    float* wsf = (float*)(shm + LDS_WS) + wid * 64;
    const bf16* ksrc = Kh + (long)lane * KP + wid * 8;
    const bf16* vsrc = Vh + (long)(16 * (wid & 3) + (lane >> 2)) * VP + (wid >> 2) * 32 + (lane & 3) * 8;
    const unsigned kdst = lds0 + LDS_K + wid * 1024, vdst = lds0 + LDS_V + wid * 1024;
    const lds_cptr shm3 = (lds_cptr)shm; const lds_cptr vp0 = shm3 + LDS_V + ((lane >> 4) & 1) * 32 + (lane & 3) * 8 + (4 * hi + ((lane & 15) >> 2)) * 64;
    const int NT = (q0 + QB) / KVBLK;
#define A2_DMAK(t, sl) glds16(ksrc + (long)(t) * KVBLK * KP, (unsigned)__builtin_amdgcn_readfirstlane(kdst + (sl) * KSLOT))
#define A2_DMAV(t, sl) do { glds16(vsrc + (long)(t) * KVBLK * VP, (unsigned)__builtin_amdgcn_readfirstlane(vdst + (sl) * VSLOT)); glds16(vsrc + (long)(t) * KVBLK * VP + 64, (unsigned)__builtin_amdgcn_readfirstlane(vdst + (sl) * VSLOT + 8192)); } while (0)
    A2_DMAK(0, 0); A2_DMAV(0, 0); A2_DMAK(1, 1); A2_DMAV(1, 1);
    bf16x8 qr[4];
#pragma unroll
    for (int d0 = 0; d0 < 4; ++d0) qr[d0] = *reinterpret_cast<const bf16x8*>(&Qw[(long)r32 * QP + d0 * 16 + hi * 8]);
    float mhat = 0.f, l_reg = 0.f; f32x16 o[4]; o[0] = f32x16{}; o[1] = f32x16{}; o[2] = f32x16{}; o[3] = f32x16{};
    const int qrel = wid * QBLK + r32;
    u32x4 pw[4] = {};
    int slot = 0, slot2 = 2;
#define A2_PV(sl) do { const lds_cptr vp_ = vp0 + (sl) * VSLOT; _Pragma("unroll") for (int ks = 0; ks < 4; ++ks) { const bf16x8 pa = __builtin_bit_cast(bf16x8, pw[ks]); \
        _Pragma("unroll") for (int d0 = 0; d0 < 4; ++d0) { const s16x4 lo = vtr(vp_ + d0 * 4096 + ks * 1024), h4 = vtr(vp_ + d0 * 4096 + ks * 1024 + 512); \
            o[d0] = __builtin_amdgcn_mfma_f32_32x32x16_bf16(pa, (bf16x8){lo[0], lo[1], lo[2], lo[3], h4[0], h4[1], h4[2], h4[3]}, o[d0], 0, 0, 0); } } } while (0)
#define A2_VRD(i_) do { const int d0_ = (i_) & 3, ks_ = (i_) >> 2; vlo[(i_) % 3] = vtr(vp_ + d0_ * 4096 + ks_ * 1024); vhi[(i_) % 3] = vtr(vp_ + d0_ * 4096 + ks_ * 1024 + 512); } while (0)
#define A2_PE(P, e_) P[e_] = __builtin_amdgcn_exp2f(P[e_] - mhat)
#define A2_GAP(i_) do { if ((i_) + 2 < 16) A2_VRD((i_) + 2); \
        o[(i_) & 3] = __builtin_amdgcn_mfma_f32_32x32x16_bf16(__builtin_bit_cast(bf16x8, pw[(i_) >> 2]), (bf16x8){vlo[(i_) % 3][0], vlo[(i_) % 3][1], vlo[(i_) % 3][2], vlo[(i_) % 3][3], vhi[(i_) % 3][0], vhi[(i_) % 3][1], vhi[(i_) % 3][2], vhi[(i_) % 3][3]}, o[(i_) & 3], 0, 0, 0); \
        if ((i_) < 8) { A2_PE(p0, 2 * (i_)); A2_PE(p0, 2 * (i_) + 1); asm volatile("" : "+v"(p0)); } else { A2_PE(p1, 2 * (i_) - 16); A2_PE(p1, 2 * (i_) - 15); asm volatile("" : "+v"(p1)); } \
        __builtin_amdgcn_sched_barrier(0); } while (0)
#define A2_STEP(MASKED) do { \
          \
        if (t + 1 < NT) asm volatile("s_waitcnt vmcnt(5) lgkmcnt(0)\n\ts_barrier" ::: "memory"); \
        else asm volatile("s_waitcnt vmcnt(2) lgkmcnt(0)\n\ts_barrier" ::: "memory"); \
        if (t + 2 < NT) { A2_DMAK(t + 2, slot2); A2_DMAV(t + 2, (vslotp + 3) & 3); } \
        __builtin_amdgcn_sched_barrier(0); \
        f32x16 p0 = f32x16{}, p1 = f32x16{}; \
        const char* kb = shm + LDS_K + slot * KSLOT + hi * 1024 + r32 * 16; \
        const lds_cptr vp_ = vp0 + (t == 0 ? 0 : vslotp) * VSLOT; s16x4 vlo[3], vhi[3]; \
        _Pragma("unroll") for (int d0 = 0; d0 < 4; ++d0) { const bf16x8 b0 = *reinterpret_cast<const bf16x8*>(kb + d0 * 2048), b1 = *reinterpret_cast<const bf16x8*>(kb + d0 * 2048 + 512); \
            p0 = __builtin_amdgcn_mfma_f32_32x32x16_bf16(b0, qr[d0], p0, 0, 0, 0); p1 = __builtin_amdgcn_mfma_f32_32x32x16_bf16(b1, qr[d0], p1, 0, 0, 0); } \
        A2_VRD(0); A2_VRD(1); \
        if (MASKED) cmask(p0, p1, t - (NT - 4), qrel, hi); \
        asm volatile("s_nop 15\n\ts_nop 7" : "+v"(p0), "+v"(p1));        \
        const float rm = rowmax(p0, p1) - mhat; \
        resc = __any(rm > (float)THRL); \
        const float dl = resc ? __builtin_fmaxf(rm, 0.f) : 0.f; mhat += dl; \
        fsc = __builtin_amdgcn_exp2f(-dl); \
        __builtin_amdgcn_sched_barrier(0); \
        A2_GAP(0); A2_GAP(1); A2_GAP(2); A2_GAP(3); A2_GAP(4); A2_GAP(5); A2_GAP(6); A2_GAP(7); A2_GAP(8); A2_GAP(9); A2_GAP(10); A2_GAP(11); A2_GAP(12); A2_GAP(13); A2_GAP(14); A2_GAP(15); \
        float sacc = 0.f; \
        _Pragma("unroll") for (int r = 0; r < 16; ++r) sacc += p0[r] + p1[r]; \
        l_reg = l_reg * fsc + sacc; \
        pw[0] = (u32x4){cvtpk_s(p0[0], p0[1]), cvtpk_s(p0[2], p0[3]), cvtpk_s(p0[4], p0[5]), cvtpk_s(p0[6], p0[7])}; pw[1] = (u32x4){cvtpk_s(p0[8], p0[9]), cvtpk_s(p0[10], p0[11]), cvtpk_s(p0[12], p0[13]), cvtpk_s(p0[14], p0[15])}; \
        pw[2] = (u32x4){cvtpk_s(p1[0], p1[1]), cvtpk_s(p1[2], p1[3]), cvtpk_s(p1[4], p1[5]), cvtpk_s(p1[6], p1[7])}; pw[3] = (u32x4){cvtpk_s(p1[8], p1[9]), cvtpk_s(p1[10], p1[11]), cvtpk_s(p1[12], p1[13]), cvtpk_s(p1[14], p1[15])}; \
        if (resc) { if (hi == 0) wsf[r32] = fsc;                   \
            asm volatile("s_waitcnt lgkmcnt(0)" ::: "memory"); \
            _Pragma("unroll") for (int r = 0; r < 16; ++r) { const float fr = wsf[crow(r, hi)]; \
                _Pragma("unroll") for (int d = 0; d < 4; ++d) o[d][r] *= fr; } } \
        slot2 = slot; slot = slot == NSLOT - 1 ? 0 : slot + 1; vslotp = (vslotp + 1) & 3;        \
    } while (0)
    bool resc = false; float fsc = 1.f; int vslotp = 3;
    int t = 0;
    if (wid >= 4) __builtin_amdgcn_s_setprio(1);
    for (; t < NT - 4; ++t) A2_STEP(false);
    for (; t < NT; ++t) A2_STEP(true);
    __builtin_amdgcn_s_setprio(0);
#undef A2_STEP
#undef A2_GAP
#undef A2_PE
#undef A2_VRD
    asm volatile("s_waitcnt vmcnt(0) lgkmcnt(0)\n\ts_barrier" ::: "memory");
    A2_PV(vslotp);
#undef A2_PV
#undef A2_DMAK
#undef A2_DMAV
    { auto rr = __builtin_amdgcn_permlane32_swap(__float_as_uint(l_reg), __float_as_uint(l_reg), false, false); l_reg = __uint_as_float(rr[0]) + __uint_as_float(rr[1]); }
    if (hi == 0) wsf[32 + r32] = l_reg; asm volatile("s_waitcnt lgkmcnt(0)" ::: "memory");
    float rli[16];
#pragma unroll
    for (int r = 0; r < 16; ++r) rli[r] = __builtin_amdgcn_rcpf(wsf[32 + crow(r, hi)]);
    bf16* Ow = O + (rowbase + q0 + wid * QBLK) * OP + ocol;
    bf16* stg = (bf16*)(shm + LDS_OST) + wid * 2048;
#pragma unroll
    for (int pass = 0; pass < 2; ++pass) {
#pragma unroll
        for (int r = 0; r < 16; ++r) { const int orow = crow(r, hi);
#pragma unroll
            for (int d0 = 0; d0 < 2; ++d0) stg[orow * 64 + d0 * 32 + r32] = __float2bfloat16(o[2 * pass + d0][r] * rli[r]); }
        asm volatile("s_waitcnt lgkmcnt(0)" ::: "memory");
#pragma unroll
        for (int i = 0; i < 4; ++i) { const int row = i * 8 + (lane >> 3), ch = lane & 7; const u32x4 v = *(const u32x4*)(stg + row * 64 + ch * 8); *(u32x4*)(Ow + (long)row * OP + pass * 64 + ch * 8) = v; }
        asm volatile("s_waitcnt lgkmcnt(0)" ::: "memory");
    }
    asm volatile("s_waitcnt lgkmcnt(0)\n\ts_barrier" ::: "memory");
}
struct AttnTensors { const bf16* Q; const bf16* K; const bf16* V; bf16* O; };
struct AttnUnit { int bh; int qb; };
struct StaticOrder {
    int vcu, G;
    __device__ __forceinline__ explicit StaticOrder(int grid, int block) : vcu((grid % 8 == 0) ? (block % 8) * (grid / 8) + block / 8 : block), G(grid) {}
    __device__ __forceinline__ bool next(int i, AttnUnit& u) const { const int oct = vcu + (i >> 2) * G; if (oct >= 256) return false; const int s = oct & 7, ii = i & 3; u.bh = oct >> 3; u.qb = (ii == 0) ? s : (ii == 1) ? 15 - s : (ii == 2) ? 16 + s : 31 - s; return true; }
};
template <int THRL = 8> __device__ __forceinline__ void attn_phase(char* lds, const AttnTensors& T, const StaticOrder& S) {
    AttnUnit u;
    for (int i = 0; S.next(i, u); ++i) attn_unit<THRL>(u.bh >> 3, u.bh & 7, u.qb, T.Q, T.K, T.V, T.O, lds);
}
}

namespace tile {
typedef short bf16x8 __attribute__((ext_vector_type(8)));
typedef short s16x4 __attribute__((ext_vector_type(4)));
typedef float f32x16 __attribute__((ext_vector_type(16)));
constexpr int TP = 72;
__device__ __forceinline__ int crow(int r, int hi) { return (r & 3) + 8 * (r >> 2) + 4 * hi; }
__device__ __forceinline__ bf16x8 frag_row(const LAS bf16_t* T, int r0, int k0, int lane) { return *(const LAS bf16x8*)(T + (r0 + (lane & 31)) * TP + k0 + 8 * (lane >> 5)); }
__device__ __forceinline__ bf16x8 frag_tr(const LAS bf16_t* T, int ra, int rb, int c0, int lane) {
    const int hi = lane >> 5, g16 = (lane >> 4) & 1, q = (lane & 15) >> 2, p = lane & 3;
    const LAS bf16_t* a0 = T + (ra + 4 * hi + q) * TP + c0 + 16 * g16 + 4 * p; const LAS bf16_t* a1 = T + (rb + 4 * hi + q) * TP + c0 + 16 * g16 + 4 * p;
    const s16x4 lo = __builtin_bit_cast(s16x4, __builtin_amdgcn_ds_read_tr16_b64_v4i16((LAS s16x4*)a0)), hi4 = __builtin_bit_cast(s16x4, __builtin_amdgcn_ds_read_tr16_b64_v4i16((LAS s16x4*)a1));
    return (bf16x8){lo[0], lo[1], lo[2], lo[3], hi4[0], hi4[1], hi4[2], hi4[3]};
}
__device__ __forceinline__ bf16x8 frag_tr_nat(const LAS bf16_t* T, int k0, int c0, int lane) {
    const int hi = lane >> 5, g16 = (lane >> 4) & 1, q = (lane & 15) >> 2, p = lane & 3;
    const LAS bf16_t* a0 = T + (k0 + 8 * hi + q) * TP + c0 + 16 * g16 + 4 * p;
    const s16x4 lo = __builtin_bit_cast(s16x4, __builtin_amdgcn_ds_read_tr16_b64_v4i16((LAS s16x4*)a0)), hi4 = __builtin_bit_cast(s16x4, __builtin_amdgcn_ds_read_tr16_b64_v4i16((LAS s16x4*)(a0 + 4 * TP)));
    return (bf16x8){lo[0], lo[1], lo[2], lo[3], hi4[0], hi4[1], hi4[2], hi4[3]};
}
__device__ __forceinline__ unsigned cvtpk(float lo, float hi) { typedef float f2 __attribute__((ext_vector_type(2))); typedef __bf16 b2 __attribute__((ext_vector_type(2))); f2 v = {lo, hi}; return __builtin_bit_cast(unsigned, __builtin_convertvector(v, b2)); }
__device__ __forceinline__ bf16x8 acc_frag(const f32x16& x, int s_) { u32x4 w; w.x = cvtpk(x[8 * s_], x[8 * s_ + 1]); w.y = cvtpk(x[8 * s_ + 2], x[8 * s_ + 3]); w.z = cvtpk(x[8 * s_ + 4], x[8 * s_ + 5]); w.w = cvtpk(x[8 * s_ + 6], x[8 * s_ + 7]); return __builtin_bit_cast(bf16x8, w); }
#define MFMA32(a, b, c) __builtin_amdgcn_mfma_f32_32x32x16_bf16((a), (b), (c), 0, 0, 0)
}

__device__ __forceinline__ void sb_phase(LAS unsigned char* lds, bf16_t* QO, int ldq, const bf16_t* __restrict__ Kb, const bf16_t* __restrict__ Vb, int gw, int ngw, int wave, int lane) {
    using namespace tile;
    LAS bf16_t* Kt = (LAS bf16_t*)(lds + wave * 16384); LAS bf16_t* Vt = Kt + 32 * TP; LAS bf16_t* Ot = Vt + 32 * TP;
    const int hi = lane >> 5, ql = lane & 31;
    bf16x8 uf[2];
#pragma unroll
    for (int s_ = 0; s_ < 2; ++s_)
#pragma unroll
        for (int j = 0; j < 8; ++j) uf[s_][j] = (16 * s_ + 8 * (j >> 2) + 4 * hi + (j & 3)) > ql ? (short)0x3F80 : (short)0;
    for (int unit = gw; unit < NTOK * 4 / 32; unit += ngw) {
        const int qb = unit & 255, h = (unit >> 8) & 3, b = unit >> 10, q0 = qb * 32; const size_t rb = (size_t)b * SEQ;
        bf16x8 qf[4];
#pragma unroll
        for (int s_ = 0; s_ < 4; ++s_) qf[s_] = *(const bf16x8*)(QO + (rb + q0 + ql) * ldq + h * 64 + 16 * s_ + 8 * hi);
        f32x16 o0 = {}, o1 = {}; float carry = 0.f;
        u32x4 kp[4], vp[4];
#define SB_LOAD(k0_) do { _Pragma("unroll") for (int i = 0; i < 4; ++i) { const int c = lane + 64 * i, row = c >> 3, c16 = c & 7; \
            kp[i] = *(const u32x4*)(Kb + (rb + (k0_) + row) * 256 + h * 64 + c16 * 8); vp[i] = *(const u32x4*)(Vb + (rb + (k0_) + row) * 256 + h * 64 + c16 * 8); } } while (0)
#define SB_STORE() do { _Pragma("unroll") for (int i = 0; i < 4; ++i) { const int c = lane + 64 * i, row = c >> 3, c16 = c & 7; *(LAS u32x4*)(Kt + row * TP + c16 * 8) = kp[i]; *(LAS u32x4*)(Vt + row * TP + c16 * 8) = vp[i]; } } while (0)
        SB_LOAD(q0);
        for (int k0 = q0; k0 >= 0; k0 -= 32) {
            asm volatile("s_waitcnt lgkmcnt(0)" ::: "memory");
            SB_STORE();
            if (k0 >= 32) SB_LOAD(k0 - 32);
            asm volatile("s_waitcnt lgkmcnt(0)" ::: "memory");
            f32x16 p = {};
#pragma unroll
            for (int s_ = 0; s_ < 4; ++s_) p = MFMA32(frag_row(Kt, 0, 16 * s_, lane), qf[s_], p);
            f32x16 lk, z;
            const bool diag = (k0 == q0);
#pragma unroll
            for (int r = 0; r < 16; ++r) { z[r] = p[r] * 0.125f; const bool valid = !diag || crow(r, hi) < ql; const float az = fabsf(z[r]);
                const float sp = fmaxf(z[r], 0.f) + __logf(1.f + __expf(-az)); lk[r] = valid ? -sp : 0.f; }
            f32x16 lo_;
#pragma unroll
            for (int r = 0; r < 16; ++r) { const float hb = __uint_as_float(__float_as_uint(lk[r]) & 0xffff0000u); lo_[r] = lk[r] - hb; p[r] = hb; }
            f32x16 cs = {};
#pragma unroll
            for (int s_ = 0; s_ < 2; ++s_) { cs = MFMA32(uf[s_], acc_frag(p, s_), cs); cs = MFMA32(uf[s_], acc_frag(lo_, s_), cs); }
            const float tot = shl_(cs[0] + lk[0], ql);
            f32x16 w;
#pragma unroll
            for (int r = 0; r < 16; ++r) { const bool valid = !diag || crow(r, hi) < ql; w[r] = valid ? __expf(z[r] + lk[r] + cs[r] + carry) : 0.f; }
            carry += tot;
#pragma unroll
            for (int s_ = 0; s_ < 2; ++s_) { const bf16x8 wf = acc_frag(w, s_);
                o0 = MFMA32(frag_tr(Vt, 16 * s_, 16 * s_ + 8, 0, lane), wf, o0); o1 = MFMA32(frag_tr(Vt, 16 * s_, 16 * s_ + 8, 32, lane), wf, o1); }
            if (__all(carry < -104.f)) break;
        }
#undef SB_LOAD
#undef SB_STORE
        asm volatile("s_waitcnt lgkmcnt(0)" ::: "memory");
#pragma unroll
        for (int r = 0; r < 16; ++r) { Ot[ql * TP + crow(r, hi)] = f2bf(o0[r]); Ot[ql * TP + 32 + crow(r, hi)] = f2bf(o1[r]); }
        asm volatile("s_waitcnt lgkmcnt(0)" ::: "memory");
#pragma unroll
        for (int i = 0; i < 4; ++i) { const int c = lane + 64 * i, row = c >> 3, c16 = c & 7; *(u32x4*)(QO + (rb + q0 + row) * ldq + h * 64 + c16 * 8) = *(const LAS u32x4*)(Ot + row * TP + c16 * 8); }
    }
}

__device__ __forceinline__ float hg_lb(const float* lbl, int layer, int c) { if (layer == 0) return 0.f; const float a0 = lbl[c], a1 = lbl[256 + c]; return 1.f / (1.f + __expf(a0 - a1)); }
__device__ __forceinline__ float hg_logf(float z, float lb) {
    if (lb == 0.f) return -(fmaxf(-z, 0.f) + __logf(1.f + __expf(-fabsf(z))));
    return __logf(lb + (1.f - lb) * __builtin_amdgcn_rcpf(1.f + __expf(-z)));
}
__device__ __forceinline__ void hg_local(LAS unsigned char* lds, const bf16_t* __restrict__ F, const bf16_t* __restrict__ Iv, const float* lbl, int layer, float* __restrict__ st, float* __restrict__ dec,
                                         int gw, int ngw, int wave, int lane) {
    using namespace tile;
    LAS bf16_t* Zt = (LAS bf16_t*)(lds + wave * 16384); LAS bf16_t* Vt = Zt + 64 * TP;
    const int hi = lane >> 5, ql = lane & 31;
    for (int unit = gw; unit < 2048; unit += ngw) {
        const int chunk = unit & 127, h = (unit >> 7) & 3, b = unit >> 9; const size_t tok0 = (size_t)b * SEQ + chunk * 64;
        const float lb = hg_lb(lbl, layer, h * 64 + lane);
        float lf[64]; float bend = 0.f;
#pragma unroll
        for (int t = 0; t < 64; ++t) { lf[t] = hg_logf(bf2f(F[(tok0 + t) * 256 + h * 64 + lane]), lb); bend += lf[t]; }
        dec[unit * 64 + lane] = __expf(bend);
        asm volatile("s_waitcnt lgkmcnt(0)" ::: "memory");
        { float bb = 0.f;
#pragma unroll
          for (int t = 0; t < 64; ++t) { bb += lf[t]; Zt[t * TP + lane] = f2bf((1.f - __expf(lf[t])) * __expf(bend - bb)); } }
        f32x16 acc[2][2] = {};
#pragma unroll
        for (int half = 0; half < 2; ++half) {
            u32x4 vp[4];
#pragma unroll
            for (int i = 0; i < 4; ++i) { const int c = lane + 64 * i, row = c >> 3, c16 = c & 7; vp[i] = *(const u32x4*)(Iv + (tok0 + half * 32 + row) * 256 + h * 64 + c16 * 8); }
            asm volatile("s_waitcnt lgkmcnt(0)" ::: "memory");
#pragma unroll
            for (int i = 0; i < 4; ++i) { const int c = lane + 64 * i, row = c >> 3, c16 = c & 7; *(LAS u32x4*)(Vt + row * TP + c16 * 8) = vp[i]; }
            asm volatile("s_waitcnt lgkmcnt(0)" ::: "memory");
#pragma unroll
            for (int s2 = 0; s2 < 2; ++s2) { const int t0 = half * 32 + 16 * s2;
                const bf16x8 a0 = frag_tr_nat(Zt, t0, 0, lane), a1 = frag_tr_nat(Zt, t0, 32, lane), b0 = frag_tr_nat(Vt, 16 * s2, 0, lane), b1 = frag_tr_nat(Vt, 16 * s2, 32, lane);
                acc[0][0] = MFMA32(a0, b0, acc[0][0]); acc[0][1] = MFMA32(a0, b1, acc[0][1]); acc[1][0] = MFMA32(a1, b0, acc[1][0]); acc[1][1] = MFMA32(a1, b1, acc[1][1]); }
        }
        float* o = st + (size_t)unit * 4096;
#pragma unroll
        for (int kb = 0; kb < 2; ++kb)
#pragma unroll
            for (int vb = 0; vb < 2; ++vb)
#pragma unroll
                for (int r = 0; r < 16; ++r) o[(kb * 32 + crow(r, hi)) * 64 + vb * 32 + ql] = acc[kb][vb][r];
    }
}
__device__ __forceinline__ void hg_scan(float* st, const float* __restrict__ dec, int gtid, int nthr) {
    for (int e = gtid - 65536; e < 65536; e += nthr) { if (e < 0) continue;
        const int bh = e >> 12, kv = e & 4095, k = kv >> 6; float S = 0.f;
        for (int c0 = 0; c0 < 128; c0 += 16) { float lc[16], dc[16];
#pragma unroll
            for (int j = 0; j < 16; ++j) { lc[j] = st[(size_t)(bh * 128 + c0 + j) * 4096 + kv]; dc[j] = dec[(bh * 128 + c0 + j) * 64 + k]; }
#pragma unroll
            for (int j = 0; j < 16; ++j) { st[(size_t)(bh * 128 + c0 + j) * 4096 + kv] = S; S = dc[j] * S + lc[j]; } }
    }
}
__device__ __forceinline__ void hg_out(LAS unsigned char* lds, const bf16_t* __restrict__ F, const bf16_t* __restrict__ Iv, bf16_t* QY, int ldq, const bf16_t* __restrict__ Gt, const float* lbl, int layer,
                                       const float* __restrict__ og, const float* __restrict__ st, int gw, int ngw, int wave, int lane) {
    using namespace tile;
    LAS bf16_t* bA = (LAS bf16_t*)(lds + wave * 16384); LAS bf16_t* Z = bA + 32 * TP;
    const int hi = lane >> 5, ql = lane & 31;
    for (int unit = gw; unit < 4096; unit += ngw) {
        const int I = unit & 1, cu = unit >> 1, chunk = cu & 127, h = (cu >> 7) & 3, b = cu >> 9; const size_t tok0 = (size_t)b * SEQ + chunk * 64;
        const float lb = hg_lb(lbl, layer, h * 64 + lane);
        const float* S = st + (size_t)cu * 4096;
        {   u32x4 zq[12];
#pragma unroll
            for (int i = 0; i < 4; ++i) { const int c = lane + 64 * i, row = c >> 3, c16 = c & 7; zq[i] = *(const u32x4*)(F + (tok0 + row) * 256 + h * 64 + c16 * 8); zq[8 + i] = *(const u32x4*)(QY + (tok0 + 32 * I + row) * ldq + h * 64 + c16 * 8); }
            if (I) {
#pragma unroll
                for (int i = 0; i < 4; ++i) { const int c = lane + 64 * i, row = c >> 3, c16 = c & 7; zq[4 + i] = *(const u32x4*)(F + (tok0 + 32 + row) * 256 + h * 64 + c16 * 8); } }
            asm volatile("s_waitcnt lgkmcnt(0)" ::: "memory");
#pragma unroll
            for (int i = 0; i < 4; ++i) { const int c = lane + 64 * i, row = c >> 3, c16 = c & 7; *(LAS u32x4*)(Z + row * TP + c16 * 8) = zq[i]; *(LAS u32x4*)(bA + row * TP + c16 * 8) = zq[8 + i]; }
            if (I) {
#pragma unroll
                for (int i = 0; i < 4; ++i) { const int c = lane + 64 * i, row = c >> 3, c16 = c & 7; *(LAS u32x4*)(Z + (32 + row) * TP + c16 * 8) = zq[4 + i]; } }
        }
        asm volatile("s_waitcnt lgkmcnt(0)" ::: "memory");
        float bref = 0.f;
        if (I) { float lfp[32];
#pragma unroll
            for (int t = 0; t < 32; ++t) { lfp[t] = hg_logf(bf2f(Z[t * TP + lane]), lb); bref += lfp[t]; }
            float bb = 0.f;
#pragma unroll
            for (int t = 0; t < 32; ++t) { bb += lfp[t]; Z[t * TP + lane] = f2bf((1.f - __expf(lfp[t])) * __expf(bref - bb)); } }
        { LAS bf16_t* Zb = Z + 32 * I * TP; float bb = 0.f;
#pragma unroll
          for (int t = 0; t < 32; ++t) { const float lf = hg_logf(bf2f(Zb[t * TP + lane]), lb); bb += lf; const float eb = __expf(bb);
              bA[t * TP + lane] = f2bf(bf2f(bA[t * TP + lane]) * eb); Zb[t * TP + lane] = f2bf((1.f - __expf(lf)) * __expf(fminf(-bb, 80.f))); } }
        asm volatile("s_waitcnt lgkmcnt(0)" ::: "memory");
        bf16x8 qf[4];
#pragma unroll
        for (int s4 = 0; s4 < 4; ++s4) qf[s4] = frag_row(bA, 0, 16 * s4, lane);
        f32x16 o0 = {}, o1 = {};
        const float es = __expf(bref);
#pragma unroll
        for (int kh = 0; kh < 2; ++kh) {
            f32x4 sv[8];
#pragma unroll
            for (int i = 0; i < 8; ++i) { const int c = lane + 64 * i, row = c >> 4, c4 = c & 15; sv[i] = *(const f32x4*)(S + (32 * kh + row) * 64 + c4 * 4); }
            asm volatile("s_waitcnt lgkmcnt(0)" ::: "memory");
#pragma unroll
            for (int i = 0; i < 8; ++i) { const int c = lane + 64 * i, row = c >> 4, c4 = c & 15; const float sc = shl_(es, 32 * kh + row);
                u32x2 w; w.x = cvtpk(sv[i][0] * sc, sv[i][1] * sc); w.y = cvtpk(sv[i][2] * sc, sv[i][3] * sc); *(LAS u32x2*)(bA + row * TP + c4 * 4) = w; }
            asm volatile("s_waitcnt lgkmcnt(0)" ::: "memory");
#pragma unroll
            for (int s2 = 0; s2 < 2; ++s2) { const bf16x8 q_ = qf[2 * kh + s2]; o0 = MFMA32(frag_tr_nat(bA, 16 * s2, 0, lane), q_, o0); o1 = MFMA32(frag_tr_nat(bA, 16 * s2, 32, lane), q_, o1); }
        }
        for (int J = 0; J <= I; ++J) {
            u32x4 vp[4];
#pragma unroll
            for (int i = 0; i < 4; ++i) { const int c = lane + 64 * i, row = c >> 3, c16 = c & 7; vp[i] = *(const u32x4*)(Iv + (tok0 + 32 * J + row) * 256 + h * 64 + c16 * 8); }
            asm volatile("s_waitcnt lgkmcnt(0)" ::: "memory");
#pragma unroll
            for (int i = 0; i < 4; ++i) { const int c = lane + 64 * i, row = c >> 3, c16 = c & 7; *(LAS u32x4*)(bA + row * TP + c16 * 8) = vp[i]; }
            asm volatile("s_waitcnt lgkmcnt(0)" ::: "memory");
            f32x16 pt = {};
#pragma unroll
            for (int s4 = 0; s4 < 4; ++s4) pt = MFMA32(frag_row(Z, 32 * J, 16 * s4, lane), qf[s4], pt);
            if (J == I) {
#pragma unroll
                for (int r = 0; r < 16; ++r) pt[r] = crow(r, hi) <= ql ? pt[r] : 0.f; }
#pragma unroll
            for (int s2 = 0; s2 < 2; ++s2) { const bf16x8 pf = acc_frag(pt, s2); o0 = MFMA32(frag_tr(bA, 16 * s2, 16 * s2 + 8, 0, lane), pf, o0); o1 = MFMA32(frag_tr(bA, 16 * s2, 16 * s2 + 8, 32, lane), pf, o1); }
        }
        float ss = 0.f;
#pragma unroll
        for (int r = 0; r < 16; ++r) ss += o0[r] * o0[r] + o1[r] * o1[r];
        ss += shx(ss, 32, lane);
        const float rr = rsqrtf(ss * (1.f / 64.f) + RMS_EPS);
        u32x4 gv[4];
#pragma unroll
        for (int i = 0; i < 4; ++i) { const int c = lane + 64 * i, row = c >> 3, c16 = c & 7; gv[i] = *(const u32x4*)(Gt + (tok0 + 32 * I + row) * 256 + h * 64 + c16 * 8); }
        asm volatile("s_waitcnt lgkmcnt(0)" ::: "memory");
#pragma unroll
        for (int r = 0; r < 16; ++r) { bA[ql * TP + crow(r, hi)] = f2bf(o0[r] * rr); bA[ql * TP + 32 + crow(r, hi)] = f2bf(o1[r] * rr); }
        asm volatile("s_waitcnt lgkmcnt(0)" ::: "memory");
#pragma unroll
        for (int i = 0; i < 4; ++i) { const int c = lane + 64 * i, row = c >> 3, c16 = c & 7; const size_t tok = tok0 + 32 * I + row;
            const u32x4 ov = *(const LAS u32x4*)(bA + row * TP + c16 * 8); const unsigned ow[4] = {ov.x, ov.y, ov.z, ov.w}, gw_[4] = {gv[i].x, gv[i].y, gv[i].z, gv[i].w}; float y[8];
#pragma unroll
            for (int j = 0; j < 4; ++j) { const float g0 = __uint_as_float(gw_[j] << 16), g1 = __uint_as_float(gw_[j] & 0xffff0000u);
                y[2 * j] = __uint_as_float(ow[j] << 16) * og[c16 * 8 + 2 * j] * g0 * __builtin_amdgcn_rcpf(1.f + __expf(-g0)); y[2 * j + 1] = __uint_as_float(ow[j] & 0xffff0000u) * og[c16 * 8 + 2 * j + 1] * g1 * __builtin_amdgcn_rcpf(1.f + __expf(-g1)); }
            u32x4 w; w.x = cvtpk(y[0], y[1]); w.y = cvtpk(y[2], y[3]); w.z = cvtpk(y[4], y[5]); w.w = cvtpk(y[6], y[7]);
            *(u32x4*)(QY + tok * ldq + h * 64 + c16 * 8) = w; }
    }
}

#define XB_TMO      128
#define XB_XCNT(j)  (256  + 64 * (j))
#define XB_XSUB(j)  (1280 + 64 * (j))
#define XB_XGEN(j)  (2304 + 64 * (j))
#define XB_TOP      3328
#define XB_TOPGEN   3392
#define XCD_BAR_WORDS 3456
#define XB_SPIN_CAP (1u << 18)

__device__ __forceinline__ unsigned xb_ld(unsigned* p)              { return __hip_atomic_load(p, __ATOMIC_RELAXED, __HIP_MEMORY_SCOPE_AGENT); }
__device__ __forceinline__ unsigned xb_add(unsigned* p, unsigned v) { return __hip_atomic_fetch_add(p, v, __ATOMIC_RELAXED, __HIP_MEMORY_SCOPE_AGENT); }
__device__ __forceinline__ unsigned xb_xcc_id() { return (unsigned)__builtin_amdgcn_s_getreg((3 << 11) | 20) & 0xFu; }
#define XB_SPIN(cond, bar) do { unsigned _sp = 0; while (cond) { __builtin_amdgcn_s_sleep(1); \
    if ((++_sp & 255u) == 0u) { if (xb_ld(&(bar)[XB_TMO])) break; if (_sp > XB_SPIN_CAP) { atomicAdd(&(bar)[XB_TMO], 1u); break; } } } } while (0)

struct XcdBarrier {
    unsigned* bar; unsigned x;
    volatile LAS unsigned* st;
};

__device__ __forceinline__ XcdBarrier xcd_barrier_post(unsigned* bar, volatile LAS unsigned* st) {
    XcdBarrier b; b.bar = bar; b.x = xb_xcc_id(); b.st = st;
    if (threadIdx.x == 0) (void)xb_add(&bar[XB_XCNT(b.x)], 1u);
    return b;
}
__device__ __forceinline__ void xcd_barrier_complete(unsigned* bar, unsigned x, unsigned& nloc, unsigned& nx) {
    const unsigned G = gridDim.x * gridDim.y * gridDim.z;
    unsigned sum, cnt, mine, sp = 0u;
    for (;;) {
        sum = 0u; cnt = 0u; mine = 0u;
#pragma unroll
        for (unsigned j = 0; j < 16; ++j) { const unsigned c = xb_ld(&bar[XB_XCNT(j)]); sum += c; cnt += (c > 0u) ? 1u : 0u; mine = (j == x) ? c : mine; }
        if (sum == G) break;
        __builtin_amdgcn_s_sleep(1);
        if ((++sp & 255u) == 0u) { if (xb_ld(&bar[XB_TMO])) break; if (sp > XB_SPIN_CAP) { atomicAdd(&bar[XB_TMO], 1u); break; } }
    }
    nloc = mine > 0u ? mine : 1u; nx = cnt > 0u ? cnt : 1u;
}

__device__ __forceinline__ void xcd_barrier(const XcdBarrier& b_) {
    XcdBarrier b = b_; { GAS unsigned* bg_ = (GAS unsigned*)b.bar; asm volatile("" : "+s"(bg_), "+s"(b.x)); b.bar = (unsigned*)bg_; }
    asm volatile("s_waitcnt vmcnt(0)" ::: "memory");
    __syncthreads();
    if (threadIdx.x == 0) {
        unsigned* bar = b.bar;
        __builtin_amdgcn_s_waitcnt(0);
        unsigned nloc = b.st[0], nx = b.st[1];
        if (nloc == 0u) { xcd_barrier_complete(bar, b.x, nloc, nx); b.st[0] = nloc; b.st[1] = nx; }
        const unsigned old = xb_add(&bar[XB_XSUB(b.x)], 1u);
        const unsigned gen = old / nloc;
        if (old + 1u == (gen + 1u) * nloc) {
            __builtin_amdgcn_fence(__ATOMIC_RELEASE, "agent");
            asm volatile("s_waitcnt vmcnt(0)" ::: "memory");
            const unsigned og = xb_add(&bar[XB_TOP], 1u);
            const unsigned tg = og / nx;
            if (og + 1u == (tg + 1u) * nx) xb_add(&bar[XB_TOPGEN], 1u);
            else XB_SPIN(xb_ld(&bar[XB_TOPGEN]) == tg, bar);
            __builtin_amdgcn_fence(__ATOMIC_ACQUIRE, "agent");
            xb_add(&bar[XB_XGEN(b.x)], 1u);
            asm volatile("s_waitcnt vmcnt(0)" ::: "memory");
        } else {
            XB_SPIN(xb_ld(&bar[XB_XGEN(b.x)]) == gen, bar);
            __builtin_amdgcn_fence(__ATOMIC_ACQUIRE, "agent");
            asm volatile("s_waitcnt vmcnt(0)" ::: "memory");
        }
    }
    __syncthreads();
}

#define LDS_WAIT() asm volatile("s_waitcnt lgkmcnt(0)" ::: "memory")
constexpr int NWAVES_ = 8;
__device__ __forceinline__ void tr_item(const float* __restrict__ W, int N, int k0, int n0, bf16_t* dst, int ldo, LAS float* scr, int lane, int rs = 1) {
#pragma unroll 8
    for (int i = 0; i < 32; ++i) { const int kk = 2 * i + (lane >> 5); scr[kk * 33 + (lane & 31)] = W[(size_t)(k0 + kk) * N + n0 + (lane & 31)]; }
    LDS_WAIT(); asm volatile("" ::: "memory");
    const int c = lane & 7;
#pragma unroll
    for (int j = 0; j < 4; ++j) { const int n = (lane >> 3) + 8 * j; const LAS float* s = scr + (8 * c) * 33 + n;
        u32x4 o; o.x = pk2(s[0 * 33], s[1 * 33]); o.y = pk2(s[2 * 33], s[3 * 33]); o.z = pk2(s[4 * 33], s[5 * 33]); o.w = pk2(s[6 * 33], s[7 * 33]);
        *(u32x4*)(dst + (size_t)n * rs * ldo + 8 * c) = o; }
    LDS_WAIT(); asm volatile("" ::: "memory");
}
struct LayerIn {
    const float *norm_mix, *w_in, *qg, *kg, *lq1, *lk1, *lq2, *lk2, *subln, *hg_lb, *hg_og, *s5_lre, *s5_lim, *s5_lstep, *s5_bre, *s5_bim, *s5_cre, *s5_cim, *s5_d, *glu_w, *glu_b,
                *pa, *pb, *pc, *pd, *w_out, *norm_ffn, *rgw, *rgb, *rew, *reb, *eg, *eu, *ed;
};
__device__ __forceinline__ void ph_weights(const CAS char* ka, int l, unsigned char* wts, LAS unsigned char* lds, int gw, int ngw, int wave, int lane) {
    LAS float* scr = (LAS float*)(lds + wave * 16384);
#define KIN(i) ((const float*)(*(const GAS float* const CAS*)(ka + 8 * (i))))
    const float* w_in = KIN(3) + (size_t)l * DM * IN_COLS; const float* pa = KIN(23) + (size_t)l * 512 * DM; const float* w_out = KIN(27) + (size_t)l * DM * DM; const float* glu_w = KIN(21) + (size_t)l * 65536;
    constexpr int I_IN = 16 * 240, I_PA = 8 * 32, I_PB = 4 * 32, I_OUT = 16 * 32, I_GLU = 4 * 8, I_EG = 16 * 16 * 12, I_ED = 16 * 6 * 32;
    constexpr int NITEMS = I_IN + I_PA + 3 * I_PB + I_OUT + I_GLU + 2 * I_EG;
    for (int it = gw; it < NITEMS; it += ngw) {
        int r = it;
        if (r < I_IN) { const int kb = r / 240, nb = r % 240, n0 = nb * 32;
            if (n0 < NMIX) tr_item(w_in, IN_COLS, kb * 64, n0, (bf16_t*)(wts + WT_IN) + (size_t)n0 * DM + kb * 64, DM, scr, lane);
            else { const int br = (n0 - NMIX) >> 10, c = (n0 - NMIX) & 1023; tr_item(w_in, IN_COLS, kb * 64, n0, (bf16_t*)(wts + WT_IN) + (size_t)(NMIX + 4 * c + br) * DM + kb * 64, DM, scr, lane, 4); }
            continue; } r -= I_IN;
        if (r < I_PA) { const int kb = r / 32, nb = r % 32; tr_item(pa, DM, kb * 64, nb * 32, (bf16_t*)(wts + WT_P) + (size_t)nb * 32 * YC_LD + kb * 64, YC_LD, scr, lane); continue; } r -= I_PA;
        if (r < 3 * I_PB) { const int w = r / I_PB, q = r % I_PB, kb = q / 32, nb = q % 32; const float* src = KIN(24 + w) + (size_t)l * 256 * DM;
            tr_item(src, DM, kb * 64, nb * 32, (bf16_t*)(wts + WT_P) + (size_t)nb * 32 * YC_LD + 512 + 256 * w + kb * 64, YC_LD, scr, lane); continue; } r -= 3 * I_PB;
        if (r < I_OUT) { const int kb = r / 32, nb = r % 32; tr_item(w_out, DM, kb * 64, nb * 32, (bf16_t*)(wts + WT_OUT) + (size_t)nb * 32 * DM + kb * 64, DM, scr, lane); continue; } r -= I_OUT;
        if (r < I_GLU) { const int kb = r / 8, nb = r % 8; tr_item(glu_w, 256, kb * 64, nb * 32, (bf16_t*)(wts + WT_GLU) + (size_t)nb * 32 * 256 + kb * 64, 256, scr, lane); continue; } r -= I_GLU;
        if (r < 2 * I_EG) { const int up = r / I_EG, q = r % I_EG, e = q / 192, q2 = q % 192, kb = q2 / 12, nb = q2 % 12, n0 = nb * 32;
            const float* src = KIN(33 + up) + ((size_t)l * NEXP + e) * DM * DEXP;
            tr_item(src, DEXP, kb * 64, n0, (bf16_t*)(wts + WT_E1) + (size_t)(e * 768 + (n0 >> 7) * 256 + up * 128 + (n0 & 127)) * DM + kb * 64, DM, scr, lane); continue; }
    }
}
__device__ __forceinline__ void ph_s5_tables(const float* lre, const float* lim, const float* lstep, const float* bre, const float* bim, float* apow, float* bb, int gtid, int nthr) {
    for (int i = gtid; i < 1024; i += nthr) { const int g = i >> 6;
        const float lr = fminf(lre[i], -1e-4f), li = lim[i], st = __expf(lstep[g]);
        const float mag = __expf(lr * st), ph = li * st; const float rv = ph * 0.15915494309189535f, fr_ = rv - floorf(rv), sn = __sinf(fr_ * 6.283185307179586f), cs = __cosf(fr_ * 6.283185307179586f);
        const float ar = mag * cs, ai = mag * sn;
        const float den = lr * lr + li * li, nr = ar - 1.f, gr = (nr * lr + ai * li) / den, gi = (ai * lr - nr * li) / den;
        float pr = 1.f, pi = 0.f;
        for (int p = 0; p <= 32; ++p) { apow[(i * 33 + p) * 2] = pr; apow[(i * 33 + p) * 2 + 1] = pi; const float t = pr * ar - pi * ai; pi = pr * ai + pi * ar; pr = t; }
        for (int c = 0; c < 16; ++c) { const float br = bre[i * 16 + c], bi = bim[i * 16 + c]; bb[(i * 16 + c) * 2] = gr * br - gi * bi; bb[(i * 16 + c) * 2 + 1] = gr * bi + gi * br; }
    }
}
__device__ __forceinline__ void ph_s5_mats(const float* __restrict__ apow, const float* __restrict__ bb, const float* __restrict__ cre, const float* __restrict__ cim, bf16_t* m1t, bf16_t* m2t, bf16_t* ktab, int gtid, int nthr) {
    for (int it = gtid; it < 16 * 256 * 64; it += nthr) { const int cg = it & 63, r = (it >> 6) & 255, g = it >> 14; float v[8];
        if (r < 128) { const int n = r & 63, im = r >> 6, s_ = cg >> 1, c0 = (cg & 1) * 8; const int gi = g * 64 + n; const float pr = apow[(gi * 33 + 31 - s_) * 2], pi = apow[(gi * 33 + 31 - s_) * 2 + 1];
#pragma unroll
            for (int j = 0; j < 8; ++j) { const float br = bb[(gi * 16 + c0 + j) * 2], bi = bb[(gi * 16 + c0 + j) * 2 + 1]; v[j] = im ? pr * bi + pi * br : pr * br - pi * bi; } }
        else {
#pragma unroll
            for (int j = 0; j < 8; ++j) v[j] = 0.f; }
        u32x4 w; w.x = pk2(v[0], v[1]); w.y = pk2(v[2], v[3]); w.z = pk2(v[4], v[5]); w.w = pk2(v[6], v[7]);
        *(u32x4*)(m1t + ((size_t)(g * 256 + r) * 512 + cg * 8)) = w; }
    for (int it = gtid; it < 16 * 32 * 16 * 2; it += nthr) { const int c0 = (it & 1) * 8, c = (it >> 1) & 15, tau = (it >> 5) & 31, g = it >> 10; float v[8];
#pragma unroll
        for (int j = 0; j < 8; ++j) v[j] = 0.f;
        for (int n = 0; n < 64; ++n) { const int gi = g * 64 + n; const float pr = apow[(gi * 33 + tau) * 2], pi = apow[(gi * 33 + tau) * 2 + 1], cr = cre[(g * 16 + c) * 64 + n], ci = cim[(g * 16 + c) * 64 + n];
            const float wr_ = cr * pr - ci * pi, wi_ = cr * pi + ci * pr;
#pragma unroll
            for (int j = 0; j < 8; ++j) v[j] += wr_ * bb[(gi * 16 + c0 + j) * 2] - wi_ * bb[(gi * 16 + c0 + j) * 2 + 1]; }
        u32x4 w; w.x = pk2(v[0], v[1]); w.y = pk2(v[2], v[3]); w.z = pk2(v[4], v[5]); w.w = pk2(v[6], v[7]);
        *(u32x4*)(ktab + ((size_t)((g * 32 + tau) * 16 + c) * 16 + c0)) = w; }
    for (int it = gtid; it < 16 * 512 * 16; it += nthr) { const int cg = it & 15, r = (it >> 4) & 511, g = it >> 13, t = r >> 4, c = r & 15, nn0 = cg * 8; float v[8];
#pragma unroll
        for (int j = 0; j < 8; ++j) { const int nn = nn0 + j, n = nn & 63, gi = g * 64 + n; const float pr = apow[(gi * 33 + t + 1) * 2], pi = apow[(gi * 33 + t + 1) * 2 + 1], cr = cre[(g * 16 + c) * 64 + n], ci = cim[(g * 16 + c) * 64 + n];
            v[j] = nn < 64 ? cr * pr - ci * pi : -(cr * pi + ci * pr); }
        u32x4 w; w.x = pk2(v[0], v[1]); w.y = pk2(v[2], v[3]); w.z = pk2(v[4], v[5]); w.w = pk2(v[6], v[7]);
        *(u32x4*)(m2t + ((size_t)(g * 512 + r) * S5_LD + 512 + cg * 8)) = w; }
}
__device__ __forceinline__ void ph_s5_expand(const bf16_t* __restrict__ ktab, bf16_t* m2t, int gtid, int nthr) {
    for (int it = gtid; it < 16 * 512 * 64; it += nthr) { const int cg = it & 63, r = (it >> 6) & 511, g = it >> 15, t = r >> 4, c = r & 15, s_ = cg >> 1, c0 = (cg & 1) * 8;
        u32x4 w = {0u, 0u, 0u, 0u}; if (s_ <= t) w = *(const u32x4*)(ktab + ((size_t)((g * 32 + t - s_) * 16 + c) * 16 + c0));
        *(u32x4*)(m2t + ((size_t)(g * 512 + r) * S5_LD + cg * 8)) = w; }
}
__device__ __forceinline__ void ph_s5_scan(const float* __restrict__ apow, const float* __restrict__ xloc, bf16_t* s5u, int gtid, int nthr) {
    for (int i = gtid; i < 4096; i += nthr) { const int n = i & 63, g = (i >> 6) & 15, b = i >> 10; const int gi = g * 64 + n;
        const float ar = apow[(gi * 33 + 32) * 2], ai = apow[(gi * 33 + 32) * 2 + 1]; float xr = 0.f, xi = 0.f;
        for (int k0 = 0; k0 < 256; k0 += 32) { float lr[32], li[32];
#pragma unroll
            for (int j = 0; j < 32; ++j) { const size_t row = (size_t)g * 1024 + b * 256 + k0 + j; lr[j] = xloc[row * 128 + n]; li[j] = xloc[row * 128 + 64 + n]; }
#pragma unroll
            for (int j = 0; j < 32; ++j) { const size_t row = (size_t)g * 1024 + b * 256 + k0 + j; s5u[row * S5_LD + 512 + n] = f2bf(xr); s5u[row * S5_LD + 576 + n] = f2bf(xi);
                const float t = ar * xr - ai * xi + lr[j]; xi = ar * xi + ai * xr + li[j]; xr = t; } }
    }
}
__device__ __forceinline__ void ph_pair_weights(const float* __restrict__ ed  , bf16_t* wp, LAS unsigned char* lds, int gw, int ngw, int wave, int lane) {
    LAS float* scr = (LAS float*)(lds + wave * 16384);
    for (int it = gw; it < NBUCKET * 2 * 6 * 32; it += ngw) { const int nb = it & 31, kb = (it >> 5) % 6, sel = (it / 192) & 1, p_ = it / 384; int e0, e1; pg8::pair_experts(p_, e0, e1); const int e = sel ? e1 : e0;
        tr_item(ed + (size_t)e * DEXP * DM, DM, kb * 64, nb * 32, wp + ((size_t)p_ * 1024 + nb * 32) * 768 + sel * DEXP + kb * 64, 768, scr, lane); }
    asm volatile("s_waitcnt lgkmcnt(0)" ::: "memory"); __syncthreads();
}
__device__ __forceinline__ void ph_rmsnorm(const float* __restrict__ x, const float* __restrict__ gain, bf16_t* __restrict__ out, int gw, int ngw, int lane) {
    for (int m = gw; m < NTOK; m += ngw) {
        const f32x4* xr = (const f32x4*)(x + (size_t)m * DM) + lane;
        f32x4 v[4]; float s = 0.f;
#pragma unroll
        for (int j = 0; j < 4; ++j) { v[j] = xr[64 * j]; s += (v[j].x * v[j].x + v[j].y * v[j].y) + (v[j].z * v[j].z + v[j].w * v[j].w); }
        const float r = rsqrtf(wave_sum(s, lane) * (1.f / DM) + RMS_EPS);
        u32x2* o = (u32x2*)(out + (size_t)m * DM) + lane;
#pragma unroll
        for (int j = 0; j < 4; ++j) { const f32x4 g = ((const f32x4*)gain)[64 * j + lane]; u32x2 w; w.x = pk2(v[j].x * r * g.x, v[j].y * r * g.y); w.y = pk2(v[j].z * r * g.z, v[j].w * r * g.w); o[64 * j] = w; }
    }
}
__device__ __forceinline__ void fix_row(bf16_t* row, const float* gain, const float* cs, const float* sn, float scale, int lane) {
    u32x4 raw = *(const u32x4*)(row + lane * 8);
    float v[8];
    v[0] = __uint_as_float(raw.x << 16); v[1] = __uint_as_float(raw.x & 0xffff0000u); v[2] = __uint_as_float(raw.y << 16); v[3] = __uint_as_float(raw.y & 0xffff0000u);
    v[4] = __uint_as_float(raw.z << 16); v[5] = __uint_as_float(raw.z & 0xffff0000u); v[6] = __uint_as_float(raw.w << 16); v[7] = __uint_as_float(raw.w & 0xffff0000u);
    float ss = 0.f;
#pragma unroll
    for (int i = 0; i < 8; ++i) ss += v[i] * v[i];
    ss += shx(ss, 1, lane); ss += shx(ss, 2, lane); ss += shx(ss, 4, lane);
    const float r = rsqrtf(ss * (1.f / 64.f) + RMS_EPS);
    const int sub = lane & 7;
#pragma unroll
    for (int i = 0; i < 8; ++i) v[i] = v[i] * r * gain[sub * 8 + i];
    float o[8];
#pragma unroll
    for (int i = 0; i < 8; ++i) {
        const float p = shx(v[i], 1, lane);
        float res = v[i];
        if (sub == 0) res = v[i] * cs[i] - p * sn[i];
        else if (sub == 1) res = v[i] * cs[i] + p * sn[i];
        o[i] = res * scale;
    }
    u32x4 w; w.x = pk2(o[0], o[1]); w.y = pk2(o[2], o[3]); w.z = pk2(o[4], o[5]); w.w = pk2(o[6], o[7]);
    *(u32x4*)(row + lane * 8) = w;
}
__device__ __forceinline__ void ph_fixup(bf16_t* Q, int ldq, bf16_t* K, const int* __restrict__ pos, const float* __restrict__ qg, const float* __restrict__ kg, int gw, int ngw, int lane) {
    for (int m = gw; m < NTOK; m += ngw) {
        const double p = (double)pos[m];
        float cs[8], sn[8];
#pragma unroll
        for (int i = 0; i < 8; ++i) {
            constexpr double RF[8] = {0.15915494309189535, 0.03086376340470123, 0.005985185712713705, 0.001160663641240061, 0.00022507907903927653, 4.364795279280289e-05, 8.464330808241401e-06, 1.6414262627950345e-06};
            double rv = p * RF[i];
            rv -= floor(rv);
            const float a = (float)rv * 6.283185307179586f;
            cs[i] = __cosf(a); sn[i] = __sinf(a);
        }
        fix_row(Q + (size_t)m * ldq, qg, cs, sn, QSCALE, lane);
        fix_row(K + (size_t)m * 512, kg, cs, sn, 1.f, lane);
    }
}
__device__ __forceinline__ void ph_combine(const bf16_t* __restrict__ O, bf16_t* __restrict__ YA, int ldy, const float* lq1, const float* lk1, const float* lq2, const float* lk2,
                                           const float* __restrict__ sg, float lambda_init, int gw, int ngw, int lane) {
    const float lam = __expf(wave_sum(lq1[lane] * lk1[lane], lane)) - __expf(wave_sum(lq2[lane] * lk2[lane], lane)) + lambda_init;
    const int h = lane >> 4, dv0 = (lane & 15) * 8;
    for (int m0 = gw * 4; m0 < NTOK; m0 += ngw * 4) {
      u32x4 aa[4], bb_[4];
#pragma unroll
      for (int u = 0; u < 4; ++u) { aa[u] = *(const u32x4*)(O + (size_t)(m0 + u) * 1024 + h * 256 + dv0); bb_[u] = *(const u32x4*)(O + (size_t)(m0 + u) * 1024 + h * 256 + 128 + dv0); }
#pragma unroll
      for (int u = 0; u < 4; ++u) { const int m = m0 + u; const u32x4 a = aa[u], b = bb_[u];
        float d[8]; const unsigned aw[4] = {a.x, a.y, a.z, a.w}, bw[4] = {b.x, b.y, b.z, b.w};
#pragma unroll
        for (int i = 0; i < 4; ++i) { d[2 * i] = __uint_as_float(aw[i] << 16) - lam * __uint_as_float(bw[i] << 16); d[2 * i + 1] = __uint_as_float(aw[i] & 0xffff0000u) - lam * __uint_as_float(bw[i] & 0xffff0000u); }
        float ss = 0.f;
#pragma unroll
        for (int i = 0; i < 8; ++i) ss += d[i] * d[i];
        ss += shx(ss, 1, lane); ss += shx(ss, 2, lane); ss += shx(ss, 4, lane); ss += shx(ss, 8, lane);
        const float r = rsqrtf(ss * (1.f / 128.f) + RMS_EPS) * (1.f - lambda_init);
        u32x4 w; w.x = pk2(d[0] * r * sg[dv0], d[1] * r * sg[dv0 + 1]); w.y = pk2(d[2] * r * sg[dv0 + 2], d[3] * r * sg[dv0 + 3]);
        w.z = pk2(d[4] * r * sg[dv0 + 4], d[5] * r * sg[dv0 + 5]); w.w = pk2(d[6] * r * sg[dv0 + 6], d[7] * r * sg[dv0 + 7]);
        *(u32x4*)(YA + (size_t)m * ldy + h * 128 + dv0) = w;
      }
    }
}
__device__ __forceinline__ void ph_router(LAS unsigned char* lds, const float* __restrict__ x1, const float* __restrict__ gain, const float* __restrict__ wg, const float* __restrict__ bg,
                                          const float* __restrict__ we, const float* __restrict__ be, bf16_t* __restrict__ xn2, int* bucket, int* rank, float* tw, unsigned* cnt, int gw, int ngw, int lane) {
    LAS float* Wt = (LAS float*)lds; LAS unsigned* lcnt = (LAS unsigned*)(lds + 20 * 4096); LAS unsigned* lbase = lcnt + 32;
    if ((gw & 7) * 64 + lane < 32) lcnt[(gw & 7) * 64 + lane] = 0u;
    { const int t = (gw & 7) * 64 + lane;
      f32x4 a[2], b[8];
#pragma unroll
      for (int i = 0; i < 2; ++i) a[i] = ((const f32x4*)wg)[t + 512 * i];
#pragma unroll
      for (int i = 0; i < 8; ++i) b[i] = ((const f32x4*)we)[t + 512 * i];
#pragma unroll
      for (int i = 0; i < 2; ++i) { const int e = t + 512 * i; Wt[e] = a[i].x; Wt[1024 + e] = a[i].y; Wt[2048 + e] = a[i].z; Wt[3072 + e] = a[i].w; }
#pragma unroll
      for (int i = 0; i < 8; ++i) { const int x = t + 512 * i, e = x >> 2, q = x & 3; Wt[(4 + 4 * q) * 1024 + e] = b[i].x; Wt[(5 + 4 * q) * 1024 + e] = b[i].y; Wt[(6 + 4 * q) * 1024 + e] = b[i].z; Wt[(7 + 4 * q) * 1024 + e] = b[i].w; } }
    __syncthreads();
    for (int m0 = gw * 2; m0 < NTOK; m0 += ngw * 2) {
        f32x4 v[2][4]; float r[2];
#pragma unroll
        for (int tk = 0; tk < 2; ++tk) { const f32x4* xr = (const f32x4*)(x1 + (size_t)(m0 + tk) * DM) + lane; float s = 0.f;
#pragma unroll
            for (int j = 0; j < 4; ++j) { v[tk][j] = xr[64 * j]; s += (v[tk][j].x * v[tk][j].x + v[tk][j].y * v[tk][j].y) + (v[tk][j].z * v[tk][j].z + v[tk][j].w * v[tk][j].w); }
            r[tk] = s; }
#pragma unroll
        for (int tk = 0; tk < 2; ++tk) r[tk] = rsqrtf(wave_sum_dpp(r[tk]) * (1.f / DM) + RMS_EPS);
#pragma unroll
        for (int j = 0; j < 4; ++j) { const f32x4 g = ((const f32x4*)gain)[64 * j + lane];
#pragma unroll
            for (int tk = 0; tk < 2; ++tk) { v[tk][j] = v[tk][j] * r[tk] * g; u32x2 w; w.x = pk2(v[tk][j].x, v[tk][j].y); w.y = pk2(v[tk][j].z, v[tk][j].w); ((u32x2*)(xn2 + (size_t)(m0 + tk) * DM) + lane)[64 * j] = w; } }
        float lg[2][20];
#pragma unroll
        for (int c = 0; c < 20; ++c) {
            float a0 = 0.f, a1 = 0.f;
#pragma unroll
            for (int j = 0; j < 4; ++j) { const f32x4 w = *(const LAS f32x4*)(Wt + c * 1024 + 256 * j + 4 * lane);
                a0 += (v[0][j].x * w.x + v[0][j].y * w.y) + (v[0][j].z * w.z + v[0][j].w * w.w); a1 += (v[1][j].x * w.x + v[1][j].y * w.y) + (v[1][j].z * w.z + v[1][j].w * w.w); }
            lg[0][c] = wave_sum_dpp(a0); lg[1][c] = wave_sum_dpp(a1);
            if ((c & 3) == 3) asm volatile("" ::: "memory");
        }
#pragma unroll
        for (int tk = 0; tk < 2; ++tk) {
            float gl[4]; int gi = 0;
#pragma unroll
            for (int c = 0; c < 4; ++c) gl[c] = lg[tk][c] + bg[c];
            float gm = gl[0];
#pragma unroll
            for (int c = 1; c < 4; ++c) if (gl[c] > gm) { gm = gl[c]; gi = c; }
            float gs = 0.f;
#pragma unroll
            for (int c = 0; c < 4; ++c) gs += __expf(gl[c] - gm);
            const float gval = 1.f / gs;
            float el[4];
#pragma unroll
            for (int c = 0; c < 4; ++c) { float t = lg[tk][4 + c] + be[c]; t = (gi == 1) ? lg[tk][8 + c] + be[4 + c] : t; t = (gi == 2) ? lg[tk][12 + c] + be[8 + c] : t; t = (gi == 3) ? lg[tk][16 + c] + be[12 + c] : t; el[c] = t; }
            int i0 = 0; float m0_ = el[0];
#pragma unroll
            for (int c = 1; c < 4; ++c) if (el[c] > m0_) { m0_ = el[c]; i0 = c; }
            int i1 = -1; float m1 = -INFINITY;
#pragma unroll
            for (int c = 0; c < 4; ++c) if (c != i0 && el[c] > m1) { m1 = el[c]; i1 = c; }
            const float p1 = __expf(m1 - m0_), w0 = gval / (1.f + p1), w1 = gval * p1 / (1.f + p1);
            const int lo = i0 < i1 ? i0 : i1, hi = i0 < i1 ? i1 : i0; const float wlo = i0 < i1 ? w0 : w1, whi = i0 < i1 ? w1 : w0;
            const int pair = (lo == 0) ? hi - 1 : (lo == 1 ? hi + 1 : 5);
            const int b = gi * 6 + pair, m = m0 + tk;
            if (lane == 0) { bucket[m] = b; tw[2 * m] = wlo; tw[2 * m + 1] = whi; rank[m] = (int)__hip_atomic_fetch_add(lcnt + b, 1u, __ATOMIC_RELAXED, __HIP_MEMORY_SCOPE_WORKGROUP); }
        }
    }
    asm volatile("s_waitcnt vmcnt(0) lgkmcnt(0)" ::: "memory"); __syncthreads();
    { const int t = (gw & 7) * 64 + lane; if (t < NBUCKET) lbase[t] = __hip_atomic_fetch_add(cnt + 64 * t, lcnt[t], __ATOMIC_RELAXED, __HIP_MEMORY_SCOPE_AGENT); }
    __syncthreads();
    for (int m0 = gw * 2; m0 < NTOK; m0 += ngw * 2) if (lane < 2) { const int m = m0 + lane; rank[m] += (int)lbase[bucket[m]]; }
}
__device__ __forceinline__ void ph_sort(const bf16_t* __restrict__ xn2, const int* __restrict__ bucket, const int* __restrict__ rank, const float* __restrict__ tw, const unsigned* __restrict__ cnt,
                                        bf16_t* __restrict__ xs, int* slot_tok, float* slot_w, int gw, int ngw, int lane) {
    int mybase = 0, mycnt = 0;
    { int run = 0; for (int b = 0; b < NBUCKET; ++b) { const int cb = (int)cnt[64 * b]; if (lane == b) { mybase = run; mycnt = cb; } run += (cb + 255) & ~255; } }
    for (int m0 = gw * 4; m0 < NTOK; m0 += ngw * 4) {
        int bk[4], rk_[4]; float w0[4], w1[4]; u32x4 ra[4], rb[4];
#pragma unroll
        for (int u = 0; u < 4; ++u) { bk[u] = bucket[m0 + u]; rk_[u] = rank[m0 + u]; w0[u] = tw[2 * (m0 + u)]; w1[u] = tw[2 * (m0 + u) + 1];
            const u32x4* s = (const u32x4*)(xn2 + (size_t)(m0 + u) * DM) + lane; ra[u] = s[0]; rb[u] = s[64]; }
#pragma unroll
        for (int u = 0; u < 4; ++u) { const int slot = shl_i(mybase, bk[u]) + rk_[u]; u32x4* d = (u32x4*)(xs + (size_t)slot * DM) + lane; d[0] = ra[u]; d[64] = rb[u];
            if (lane == 0) { slot_tok[slot] = m0 + u; slot_w[2 * slot] = w0[u]; slot_w[2 * slot + 1] = w1[u]; } }
    }
    if (gw < NBUCKET) { const int b = gw, bs = shl_i(mybase, b), cb = shl_i(mycnt, b), pe = (cb + 255) & ~255;
        float z = 0.f; asm volatile("" : "+v"(z));
        for (int s = cb + lane; s < pe; s += 64) { slot_tok[bs + s] = -1; slot_w[2 * (bs + s)] = z; slot_w[2 * (bs + s) + 1] = z; } }
}

constexpr int NWAVES = 8, RING_BYTES = 131072, MISC_OFF = RING_BYTES + 320, LDS_BYTES = 147456;
constexpr int PH_PER_LAYER = 14;
enum { PH_WTS = 0, PH_NORM, PH_GEMM_IN, PH_FIX, PH_SCAN, PH_MIX, PH_POST, PH_GATE, PH_BRANCH, PH_OUT, PH_ROUTE, PH_SORT, PH_MOE1, PH_MOE2 };
struct Args { const float* in[36]; float* out; unsigned char* ws; int ph_lo, ph_hi, li, pad; };
__device__ __forceinline__ bool inph(int lo, int hi, int k) { asm volatile("" : "+s"(lo), "+s"(hi)); return lo <= k && k < hi; }
__global__ void __launch_bounds__(NWAVES * 64, 2) fwd(Args args) {
    extern __shared__ __attribute__((aligned(16))) unsigned char lds_raw[];
    LAS unsigned char* lds = (LAS unsigned char*)lds_raw;
    volatile LAS unsigned* MISC = (volatile LAS unsigned*)(lds + MISC_OFF);
    const int tid = threadIdx.x, lane = tid & 63, wave = __builtin_amdgcn_readfirstlane(tid >> 6), G = gridDim.x;
    const int gw = blockIdx.x * NWAVES + wave, ngw = G * NWAVES;
    unsigned char* ws = args.ws; unsigned* ctl = (unsigned*)(ws + WS_CTL);
    for (int u = tid; u < (LDS_BYTES - RING_BYTES) / 4; u += NWAVES * 64) ((LAS unsigned*)(lds + RING_BYTES))[u] = 0u;
    __syncthreads();
    XcdBarrier bar = xcd_barrier_post(ctl + CW_BAR + args.li * XCD_BAR_WORDS, MISC + 8);
    const int lo = args.ph_lo, hi = args.ph_hi;
#define IN_(k) inph(lo, hi, (k))
#define SEAM(k) do { if (IN_(k) && IN_((k) + 1)) xcd_barrier(bar); } while (0)
#define PH_BEGIN GAS unsigned char* W = (GAS unsigned char*)ws; asm volatile("" : "+s"(W)); GAS float* OUTP_ = (GAS float*)args.out; asm volatile("" : "+s"(OUTP_)); float* OUTP = (float*)OUTP_; int LN = threadIdx.x; asm volatile("" : "+v"(LN)); LN &= 63; int GG = gridDim.x; asm volatile("" : "+s"(GG)); int BX = blockIdx.x; asm volatile("" : "+s"(BX)); const int NGW_ = GG * NWAVES; int GW = BX * NWAVES + __builtin_amdgcn_readfirstlane(threadIdx.x >> 6); asm volatile("" : "+s"(GW));
#define INP(i) ({ const CAS char* ka_ = (const CAS char*)__builtin_amdgcn_kernarg_segment_ptr(); asm volatile("" : "+s"(ka_)); (const float*)(*(const GAS float* const CAS*)(ka_ + 8 * (i))); })
    for (int l = 0; l < DEPTH; ++l) {
        const int p0 = l * PH_PER_LAYER;
        if (IN_(p0 + PH_WTS)) { PH_BEGIN; ph_weights(({ const CAS char* ka_ = (const CAS char*)__builtin_amdgcn_kernarg_segment_ptr(); asm volatile("" : "+s"(ka_)); ka_; }), l, (unsigned char*)(W + WS_WTS), lds, GW, NGW_, GW & 7, LN);
            ph_s5_tables(INP(13) + l * 1024, INP(14) + l * 1024, INP(15) + l * 16, INP(16) + l * 16384, INP(17) + l * 16384, (float*)(W + WS_WTS + WT_APOW), (float*)(W + WS_WTS + WT_BB), GW * 64 + LN, NGW_ * 64); }
        SEAM(p0 + PH_WTS);
        if (IN_(p0 + PH_NORM)) { PH_BEGIN; const float* xin = l == 0 ? INP(0) : OUTP; ph_rmsnorm(xin, INP(2) + l * DM, (bf16_t*)(W + WS_XN), GW, NGW_, LN);
            ph_s5_mats((const float*)(W + WS_WTS + WT_APOW), (const float*)(W + WS_WTS + WT_BB), INP(18) + l * 16384, INP(19) + l * 16384, (bf16_t*)(W + WS_WTS + WT_S5A), (bf16_t*)(W + WS_WTS + WT_S5B), (bf16_t*)(W + WS_WTS + WT_KTAB), GW * 64 + LN, NGW_ * 64); }
        SEAM(p0 + PH_NORM);
        if (IN_(p0 + PH_GEMM_IN)) { PH_BEGIN;
            pg8::Gemm g{(const bf16_t*)(W + WS_XN), (const bf16_t*)(W + WS_WTS + WT_IN), DM, DM}; pg8::PlainSched S; S.o.init(NTOK / 256, NMIX / 256, GG, BX); S.lda = DM; S.ldb = DM; S.nt = 16; S.pn0 = 0;
            pg8::EpiInMix E{(unsigned char*)W};
            pg8::gemm_phase<pg8::EpiInMix, pg8::PlainSched, true, true>(lds, g, S, E);
        }
        SEAM(p0 + PH_GEMM_IN);
        if (IN_(p0 + PH_FIX)) { PH_BEGIN; ph_s5_expand((const bf16_t*)(W + WS_WTS + WT_KTAB), (bf16_t*)(W + WS_WTS + WT_S5B), GW * 64 + LN, NGW_ * 64); ph_fixup((bf16_t*)(W + WS_YCAT) + YC_Q, YC_LD, (bf16_t*)(W + WS_K), (const int*)INP(1), INP(4) + l * 64, INP(5) + l * 64, GW, NGW_, LN);
            pg8::Gemm g{(const bf16_t*)(W + WS_S5U), (const bf16_t*)(W + WS_WTS + WT_S5A), S5_LD, 512}; pg8::S5aSched S{GG, BX};
            pg8::EpiS5a E{(float*)(W + WS_S5ST)};
            pg8::gemm_phase<pg8::EpiS5a, pg8::S5aSched, true, true>(lds, g, S, E);
            hg_local(lds, (const bf16_t*)(W + WS_HGF), (const bf16_t*)(W + WS_HGI), INP(11), l, (float*)(W + WS_HGST), (float*)(W + WS_WTS + WT_HGDEC), GW, NGW_, GW & 7, LN);
        }
        SEAM(p0 + PH_FIX);
        if (IN_(p0 + PH_SCAN)) { PH_BEGIN; ph_s5_scan((const float*)(W + WS_WTS + WT_APOW), (const float*)(W + WS_S5ST), (bf16_t*)(W + WS_S5U), GW * 64 + LN, NGW_ * 64);
            hg_scan((float*)(W + WS_HGST), (const float*)(W + WS_WTS + WT_HGDEC), GW * 64 + LN, NGW_ * 64);
            sb_phase(lds, (bf16_t*)(W + WS_YCAT) + YC_SB, YC_LD, (const bf16_t*)(W + WS_SBK), (const bf16_t*)(W + WS_SBV), GW, NGW_, GW & 7, LN);
        }
        SEAM(p0 + PH_SCAN);
        if (IN_(p0 + PH_MIX)) { PH_BEGIN;
            { const attn2::AttnTensors AT{(const attn2::bf16*)(W + WS_YCAT) + YC_Q, (const attn2::bf16*)(W + WS_K), (const attn2::bf16*)(W + WS_V), (attn2::bf16*)(W + WS_O)};
              const attn2::StaticOrder SA(GG, BX); attn2::attn_phase<8>((char*)lds_raw, AT, SA); }
            pg8::Gemm g{(const bf16_t*)(W + WS_S5U), (const bf16_t*)(W + WS_WTS + WT_S5B), S5_LD, S5_LD}; pg8::S5bSched S2{GG, BX};
            pg8::EpiS5b E{(const bf16_t*)(W + WS_S5U), INP(20) + l * 256, (bf16_t*)(W + WS_YG)};
            pg8::gemm_phase<pg8::EpiS5b, pg8::S5bSched, true, true>(lds, g, S2, E);
            hg_out(lds, (const bf16_t*)(W + WS_HGF), (const bf16_t*)(W + WS_HGI), (bf16_t*)(W + WS_YCAT) + YC_HG, YC_LD, (const bf16_t*)(W + WS_HGG), INP(11), l, INP(12) + l * 64, (const float*)(W + WS_HGST), GW, NGW_, GW & 7, LN);
        }
        SEAM(p0 + PH_MIX);
        if (IN_(p0 + PH_POST)) { PH_BEGIN;
            const float lambda_init = l == 0 ? 0.2f : 0.35550906759096926f;
            ph_combine((const bf16_t*)(W + WS_O), (bf16_t*)(W + WS_YCAT) + YC_Q, YC_LD, INP(6) + l * 64, INP(7) + l * 64, INP(8) + l * 64, INP(9) + l * 64, INP(10) + l * 128, lambda_init, GW, NGW_, LN);
            pg8::Gemm g{(const bf16_t*)(W + WS_YG), (const bf16_t*)(W + WS_WTS + WT_GLU), 256, 256}; pg8::PlainSched S; S.o.init(NTOK / 256, 1, GG, BX); S.lda = 256; S.ldb = 256; S.nt = 4; S.pn0 = 0;
            pg8::EpiGlu E{(const bf16_t*)(W + WS_YG), INP(22) + l * 256, (bf16_t*)(W + WS_YCAT)};
            pg8::gemm_phase<pg8::EpiGlu, pg8::PlainSched, true, true>(lds, g, S, E);
        }
        SEAM(p0 + PH_POST);
        if (IN_(p0 + PH_GATE)) { PH_BEGIN;
            pg8::Gemm g{(const bf16_t*)(W + WS_XN), (const bf16_t*)(W + WS_WTS + WT_IN), DM, DM}; pg8::PlainSched S; S.o.init(NTOK / 256, 16, GG, BX); S.lda = DM; S.ldb = DM; S.nt = 16; S.pn0 = NMIX / 256;
            pg8::EpiGateU8 E{(unsigned char*)(W + WS_GATE)};
            pg8::gemm_phase<pg8::EpiGateU8, pg8::PlainSched, true, true>(lds, g, S, E);
        }
        SEAM(p0 + PH_GATE);
        if (IN_(p0 + PH_BRANCH)) { PH_BEGIN;
            pg8::Gemm g{(const bf16_t*)(W + WS_YCAT), (const bf16_t*)(W + WS_WTS + WT_P), YC_LD, YC_LD}; pg8::BranchSched S; S.o.init(NTOK / 256, 4, GG, BX);
            pg8::EpiBranch E{(const unsigned char*)(W + WS_GATE), (bf16_t*)(W + WS_O)};
            pg8::gemm_phase<pg8::EpiBranch, pg8::BranchSched, true, true>(lds, g, S, E);
        }
        SEAM(p0 + PH_BRANCH);
        if (IN_(p0 + PH_OUT)) { PH_BEGIN; const float* xin = l == 0 ? INP(0) : OUTP;
            pg8::Gemm g{(const bf16_t*)(W + WS_O), (const bf16_t*)(W + WS_WTS + WT_OUT), DM, DM}; pg8::PlainSched S; S.o.init(NTOK / 256, 4, GG, BX); S.lda = DM; S.ldb = DM; S.nt = 16; S.pn0 = 0;
            pg8::EpiOutRes E{xin, OUTP};
            pg8::gemm_phase<pg8::EpiOutRes, pg8::PlainSched, true, true>(lds, g, S, E);
        }
        SEAM(p0 + PH_OUT);
        if (IN_(p0 + PH_ROUTE)) { PH_BEGIN;
            ph_pair_weights(INP(35) + (size_t)l * NEXP * DEXP * DM, (bf16_t*)(W + WS_O), lds, GW, NGW_, GW & 7, LN);
            ph_router(lds, OUTP, INP(28) + l * DM, INP(29) + l * DM * 4, INP(30) + l * 4, INP(31) + l * DM * 16, INP(32) + l * 16, (bf16_t*)(W + WS_XN), (int*)(W + WS_SMALL + SM_BUCKET), (int*)(W + WS_SMALL + SM_RANK),
                      (float*)(W + WS_SMALL + SM_TW), (unsigned*)(W + WS_CTL) + CW_CNT + CNT_LSTRIDE * l, GW, NGW_, LN); }
        SEAM(p0 + PH_ROUTE);
        if (IN_(p0 + PH_SORT)) { PH_BEGIN;
            ph_sort((const bf16_t*)(W + WS_XN), (const int*)(W + WS_SMALL + SM_BUCKET), (const int*)(W + WS_SMALL + SM_RANK), (const float*)(W + WS_SMALL + SM_TW), (const unsigned*)(W + WS_CTL) + CW_CNT + CNT_LSTRIDE * l,
                    (bf16_t*)(W + WS_XS), (int*)(W + WS_SMALL + SM_SLOTTOK), (float*)(W + WS_SMALL + SM_SLOTW), GW, NGW_, LN); }
        SEAM(p0 + PH_SORT);
        if (IN_(p0 + PH_MOE1)) { PH_BEGIN;
            pg8::Gemm g{(const bf16_t*)(W + WS_XS), (const bf16_t*)(W + WS_WTS + WT_E1), DM, DM}; LAS int* tbl = (LAS int*)(lds + MISC_OFF + 256); pg8::moe_table(tbl, (const unsigned*)(W + WS_CTL) + CW_CNT + CNT_LSTRIDE * l); pg8::MoeSched<1> S{tbl, GG, BX};
            pg8::EpiMoe1 E{(bf16_t*)(W + WS_HID), (const float*)(W + WS_SMALL + SM_SLOTW)};
            pg8::gemm_phase<pg8::EpiMoe1, pg8::MoeSched<1>, true, true>(lds, g, S, E);
        }
        SEAM(p0 + PH_MOE1);
        if (IN_(p0 + PH_MOE2)) { PH_BEGIN;
            pg8::Gemm g{(const bf16_t*)(W + WS_HID), (const bf16_t*)(W + WS_O), 768, 768};        LAS int* tbl = (LAS int*)(lds + MISC_OFF + 256); pg8::moe_table(tbl, (const unsigned*)(W + WS_CTL) + CW_CNT + CNT_LSTRIDE * l); pg8::MoeSched<2> S{tbl, GG, BX};
            pg8::EpiMoe2 E{OUTP, (const int*)(W + WS_SMALL + SM_SLOTTOK), (float*)(W + WS_SMALL + SM_DUMMY)};
            pg8::gemm_phase<pg8::EpiMoe2, pg8::MoeSched<2>, true, true>(lds, g, S, E);
        }
        SEAM(p0 + PH_MOE2);
    }
#undef IN_
#undef SEAM
}

extern "C" void kernel_launch(void* const* d_in, const int* in_sizes, int n_in, void* d_out, int out_size, void* d_ws, size_t ws_size, hipStream_t stream) {
    static int grid = 0;
    if (grid == 0) {
        if (n_in != 36 || out_size != NTOK * DM || ws_size < WS_END) { fprintf(stderr, "kernel_launch: unexpected shapes (n_in %d out %d ws %zu)\n", n_in, out_size, ws_size); grid = -1; return; }
        int dev = 0, cus = 0, per_cu = 0;
        if (hipGetDevice(&dev) != hipSuccess || hipDeviceGetAttribute(&cus, hipDeviceAttributeMultiprocessorCount, dev) != hipSuccess) { grid = -1; return; }
        if (hipFuncSetAttribute((const void*)fwd, hipFuncAttributeMaxDynamicSharedMemorySize, LDS_BYTES) != hipSuccess) { fprintf(stderr, "kernel_launch: hipFuncSetAttribute failed\n"); grid = -1; return; }
        if (hipOccupancyMaxActiveBlocksPerMultiprocessor(&per_cu, (const void*)fwd, NWAVES * 64, LDS_BYTES) != hipSuccess || per_cu < 1) { fprintf(stderr, "kernel_launch: occupancy query says %d\n", per_cu); }
        (void)hipGetLastError();
        grid = cus;
    }
    if (grid < 0) return;
    unsigned char* ws = (unsigned char*)d_ws;
    const float* const* in = (const float* const*)d_in;
    (void)hipMemsetAsync(ws + WS_CTL, 0, 1 * MiB, stream);
    bf16_t *OB = (bf16_t*)(ws + WS_O), *YC = (bf16_t*)(ws + WS_YCAT), *K = (bf16_t*)(ws + WS_K), *V = (bf16_t*)(ws + WS_V);
    bf16_t *SBK = (bf16_t*)(ws + WS_SBK), *SBV = (bf16_t*)(ws + WS_SBV), *HGF = (bf16_t*)(ws + WS_HGF), *HGI = (bf16_t*)(ws + WS_HGI), *HGG = (bf16_t*)(ws + WS_HGG);
    bf16_t *S5U = (bf16_t*)(ws + WS_S5U), *YG = (bf16_t*)(ws + WS_YG);
    Args a{};
    for (int i = 0; i < 36; ++i) a.in[i] = (const float*)d_in[i];
    a.out = (float*)d_out; a.ws = ws;
    a.ph_lo = 0; a.ph_hi = DEPTH * PH_PER_LAYER; a.li = 0;
    hipLaunchKernelGGL(fwd, dim3(grid), dim3(NWAVES * 64), LDS_BYTES, stream, a);
}
```

```cpp
#include <hip/hip_runtime.h>
#include <cstdio>
#include <cstdint>
#include <cmath>

typedef unsigned short bf16_t;
typedef float f32x4 __attribute__((ext_vector_type(4)));
typedef unsigned u32x4 __attribute__((ext_vector_type(4)));
typedef unsigned u32x2 __attribute__((ext_vector_type(2)));
#define GAS __attribute__((address_space(1)))
#define LAS __attribute__((address_space(3)))
#define CAS __attribute__((address_space(4)))

constexpr int NB = 4, SEQ = 8192, NTOK = NB * SEQ, DM = 1024, DEPTH = 2, IN_COLS = 7680;
constexpr int C_GATE = 3584;
constexpr int NMIX = 3584;
constexpr float RMS_EPS = 1e-6f;
constexpr float QSCALE = 0.125f * 1.4426950408889634f;
constexpr int NEXP = 16, DEXP = 384, NBUCKET = 24, MPAD = NTOK + NBUCKET * 256;
constexpr int YC_LD = 1280, YC_Q = 0, YC_SB = 512, YC_HG = 768, YC_YD = 1024;

constexpr size_t MiB = 1u << 20;
constexpr size_t WS_CTL = 0;
constexpr size_t WS_SMALL = 1 * MiB;
constexpr size_t WS_XN = 2 * MiB;
constexpr size_t WS_O = 66 * MiB;
constexpr size_t WS_YCAT = 130 * MiB;
constexpr size_t WS_K = 210 * MiB;
constexpr size_t WS_V = 242 * MiB;
constexpr size_t WS_SBK = 274 * MiB, WS_SBV = 290 * MiB, WS_HGF = 306 * MiB, WS_HGI = 322 * MiB;
constexpr size_t WS_GATE = 210 * MiB;
constexpr size_t WS_HGG = 338 * MiB, WS_S5U = 354 * MiB  , WS_YG = 374 * MiB;
constexpr size_t WS_HGST = 390 * MiB, WS_S5ST = 422 * MiB  , WS_WTS = 432 * MiB, WS_END = 512 * MiB;
constexpr size_t WS_XS = 130 * MiB;
constexpr size_t WS_HID = 210 * MiB;
constexpr size_t WT_IN = 0, WT_P = 15 * MiB, WT_OUT = 18 * MiB, WT_GLU = 20 * MiB, WT_E1 = 21 * MiB, WT_E2 = 45 * MiB, WT_S5A = 57 * MiB  , WT_S5B = 61 * MiB  ;
constexpr size_t WT_KTAB = 75 * MiB  ;
constexpr size_t WT_APOW = 72 * MiB  , WT_BB = 73 * MiB  , WT_HGDEC = 74 * MiB  ;
constexpr int S5_LD = 640;
constexpr size_t SM_BUCKET = 0;
constexpr size_t SM_RANK = 131072;
constexpr size_t SM_TW = 262144;
constexpr size_t SM_SLOTTOK = 524288;
constexpr size_t SM_SLOTW = 524288 + 163840;
constexpr size_t SM_DUMMY = 1040384;
constexpr int CW_CNT = 8192, CNT_LSTRIDE = 2048;
constexpr int CW_BAR = 4096;

__device__ __forceinline__ float bf2f(bf16_t v) { return __uint_as_float((unsigned)v << 16); }
__device__ __forceinline__ bf16_t f2bf(float f) { unsigned u = __float_as_uint(f); return (bf16_t)((u + 0x7fffu + ((u >> 16) & 1u)) >> 16); }
__device__ __forceinline__ unsigned pk2(float lo, float hi) { return (unsigned)f2bf(lo) | ((unsigned)f2bf(hi) << 16); }
__device__ __forceinline__ float shx(float v, int m, int lane) { return __int_as_float(__builtin_amdgcn_ds_bpermute((lane ^ m) << 2, __float_as_int(v))); }
__device__ __forceinline__ float shl_(float v, int src) { return __int_as_float(__builtin_amdgcn_ds_bpermute(src << 2, __float_as_int(v))); }
__device__ __forceinline__ int shl_i(int v, int src) { return __builtin_amdgcn_ds_bpermute(src << 2, v); }
__device__ __forceinline__ float wave_sum_dpp(float v) {
    v += __int_as_float(__builtin_amdgcn_update_dpp(0, __float_as_int(v), 0xb1, 0xf, 0xf, true));
    v += __int_as_float(__builtin_amdgcn_update_dpp(0, __float_as_int(v), 0x4e, 0xf, 0xf, true));
    v += __int_as_float(__builtin_amdgcn_update_dpp(0, __float_as_int(v), 0x114, 0xf, 0xf, true));
    v += __int_as_float(__builtin_amdgcn_update_dpp(0, __float_as_int(v), 0x118, 0xf, 0xf, true));
    v += __int_as_float(__builtin_amdgcn_update_dpp(0, __float_as_int(v), 0x142, 0xa, 0xf, true));
    v += __int_as_float(__builtin_amdgcn_update_dpp(0, __float_as_int(v), 0x143, 0xc, 0xf, true));
    return __int_as_float(__builtin_amdgcn_readlane(__float_as_int(v), 63));
}
__device__ __forceinline__ float wave_sum(float v, int lane) {
#pragma unroll
    for (int o = 1; o < 64; o <<= 1) v += shx(v, o, lane);
    return v;
}
__device__ __forceinline__ float sigmoidf_(float x) { return 1.f / (1.f + __expf(-x)); }
__device__ __forceinline__ float softplusf_(float x) { return fmaxf(x, 0.f) + log1pf(__expf(-fabsf(x))); }

namespace pg8 {
#define PG8_LAS __attribute__((address_space(3)))
typedef short bf16x8 __attribute__((ext_vector_type(8)));
constexpr int BM = 256, BK = 64, HALF = 128, HTB = HALF * BK * 2  , STAGE_BYTES = 8 * HTB, NXCD = 8, WGM = 8;

__host__ __device__ __forceinline__ int lds_byte(int r, int c) { const int st = (r >> 4) * 2 + (c >> 5), rr = r & 15, cc = c & 31, ob = rr * 64 + cc * 2; return st * 1024 + (ob ^ (((ob >> 9) & 1) << 5)); }
__host__ __device__ __forceinline__ void stage_rc(int b, int& R, int& C) { const int st = b / 1024, sb = b % 1024, swz = sb ^ (((sb >> 9) & 1) << 5); R = (st >> 1) * 16 + swz / 64; C = (st & 1) * 32 + (swz % 64) / 2; }
__host__ __device__ __forceinline__ int perm32(int rho) { const int n = rho >> 4, i = rho & 15; return 8 * (i >> 2) + 4 * n + (i & 3); }

struct Unit { unsigned aoff, boff; int nt, pm, pn, aux; };
struct Gemm { const bf16_t* A; const bf16_t* Bt; int lda, ldb; };

struct TileOrder {
    int nM, nN, nwg, G, c;
    __device__ __forceinline__ void init(int nM_, int nN_, int G_, int c_) { nM = nM_; nN = nN_; nwg = nM * nN; G = G_; c = c_; }
    __device__ __forceinline__ bool tile(int i, int& pm, int& pn) const {
        const int L = i * G + c; if (L >= nwg) return false;
        int wgid = L; { const int q = nwg / NXCD, r = nwg % NXCD, xcd = wgid % NXCD, off = wgid / NXCD; wgid = (xcd < r ? xcd * (q + 1) : r * (q + 1) + (xcd - r) * q) + off; }
        const int nig = WGM * nN, gid = wgid / nig, fm = gid * WGM, gsz = (nM - fm) < WGM ? (nM - fm) : WGM;
        pm = fm + ((wgid % nig) % gsz); pn = (wgid % nig) / gsz; return true;
    }
};
struct PlainSched {
    TileOrder o; int lda, ldb, nt, pn0;
    __device__ __forceinline__ bool next(int i, Unit& u) const { int pm, pn; if (!o.tile(i, pm, pn)) return false;
        u.aoff = (unsigned)pm * 256u * lda * 2u; u.boff = (unsigned)(pn0 + pn) * 256u * ldb * 2u; u.nt = nt; u.pm = pm; u.pn = pn; u.aux = 0; return true; }
    __device__ __forceinline__ void a_ready(const Unit&) const {}
    __device__ __forceinline__ void done(const Unit&) const {}
};
struct BranchSched {
    TileOrder o;
    __device__ __forceinline__ bool next(int i, Unit& u) const { int pm, pn; if (!o.tile(i, pm, pn)) return false;
        u.aoff = (unsigned)pm * 256u * YC_LD * 2u; u.boff = (unsigned)pn * 256u * YC_LD * 2u; u.nt = 20; u.pm = pm; u.pn = pn; u.aux = 0; return true; }
    __device__ __forceinline__ void a_ready(const Unit&) const {}
    __device__ __forceinline__ void done(const Unit&) const {}
};
__device__ __forceinline__ void pair_experts(int b, int& e0, int& e1) { const int g = b / 6, p = b % 6; const int lo = p < 3 ? 0 : (p < 5 ? 1 : 2), hi = p < 3 ? p + 1 : (p < 5 ? p - 1 : 3); e0 = g * 4 + lo; e1 = g * 4 + hi; }
constexpr int MOE_TBL_TOT = MPAD / 256;
__device__ __forceinline__ void moe_table(PG8_LAS int* tbl, const unsigned* cnt) {
    int t = threadIdx.x; asm volatile("" : "+v"(t));
    if (t <= MOE_TBL_TOT) { int tot = 0, bsel = NBUCKET - 1, found = 0;
#pragma nounroll
        for (int b = 0; b < NBUCKET; ++b) { const int tb = (int)((__hip_atomic_load(cnt + 64 * b, __ATOMIC_RELAXED, __HIP_MEMORY_SCOPE_AGENT) + 255u) >> 8); if (!found && t < tot + tb) { bsel = b; found = 1; } tot += tb; }
        tbl[t] = t == MOE_TBL_TOT ? tot : bsel; }
    __syncthreads();
}
template <int PHASE> struct MoeSched {
    const PG8_LAS int* tbl; int G, c;
    __device__ __forceinline__ bool next(int i, Unit& u) const {
        constexpr int NT = PHASE == 1 ? 6 : 4;
        const int L = i * G + c, pm = L / NT, pn = L % NT;
        if (pm >= __builtin_amdgcn_readfirstlane(tbl[MOE_TBL_TOT])) return false;
        const int bsel = __builtin_amdgcn_readfirstlane(tbl[pm]);
        int e0, e1; pair_experts(bsel, e0, e1);
        u.pm = pm; u.pn = pn; u.aux = 0;
        if (PHASE == 1) { const int sel = pn / 3, jt = pn % 3, e = sel ? e1 : e0;
            u.aoff = (unsigned)pm * 256u * DM * 2u; u.boff = (unsigned)(e * 3 + jt) * 256u * DM * 2u; u.nt = 16; }
        else { u.aoff = (unsigned)pm * 256u * 768u * 2u; u.boff = ((unsigned)bsel * 1024u + (unsigned)pn * 256u) * 768u * 2u; u.nt = 12; }
        return true;
    }
    __device__ __forceinline__ void a_ready(const Unit&) const {}
    __device__ __forceinline__ void done(const Unit&) const {}
};

__device__ __forceinline__ unsigned cvt_pk_bf16(float lo, float hi) { unsigned r; asm volatile("v_cvt_pk_bf16_f32 %0, %1, %2" : "=v"(r) : "v"(lo), "v"(hi)); return r; }
__device__ __forceinline__ u32x4 pack8(const f32x4 a, const f32x4 b) { u32x4 w; w.x = cvt_pk_bf16(a[0], a[1]); w.y = cvt_pk_bf16(a[2], a[3]); w.z = cvt_pk_bf16(b[0], b[1]); w.w = cvt_pk_bf16(b[2], b[3]); return w; }
__device__ __forceinline__ float fsig(float x) { return __builtin_amdgcn_rcpf(1.f + __builtin_amdgcn_exp2f(-1.4426950408889634f * x)); }
#define PG8_EPI_LOOP for (int ai = 0; ai < 2; ++ai) _Pragma("unroll") for (int m = 0; m < 4; ++m) _Pragma("unroll") for (int bj = 0; bj < 3; ++bj) if (bj == 2) { asm volatile("" ::: "memory"); } else

struct EpiInMix {
    static constexpr bool PERM = true, AFTER_DRAIN = false, MID = false; unsigned char* ws;
    __device__ __forceinline__ void operator()(const f32x4 (&acc)[2][2][4][2], const Unit& u, int wr, int wc, int fr, int fq) const {
        const int pn = u.pn; bf16_t* base; int ld;
        if (pn < 2) { base = (bf16_t*)(ws + WS_YCAT) + YC_Q + pn * 256; ld = YC_LD; }
        else if (pn < 4) { base = (bf16_t*)(ws + WS_K) + (pn - 2) * 256; ld = 512; }
        else if (pn < 6) { base = (bf16_t*)(ws + WS_V) + (pn - 4) * 256; ld = 512; }
        else if (pn == 6) { base = (bf16_t*)(ws + WS_YCAT) + YC_SB; ld = YC_LD; }
        else if (pn == 7) { base = (bf16_t*)(ws + WS_SBK); ld = 256; }
        else if (pn == 8) { base = (bf16_t*)(ws + WS_SBV); ld = 256; }
        else if (pn == 9) { base = (bf16_t*)(ws + WS_HGF); ld = 256; }
        else if (pn == 10) { base = (bf16_t*)(ws + WS_HGI); ld = 256; }
        else if (pn == 11) { base = (bf16_t*)(ws + WS_YCAT) + YC_HG; ld = YC_LD; }
        else if (pn == 12) { base = (bf16_t*)(ws + WS_HGG); ld = 256; }
        else { base = (bf16_t*)(ws + WS_S5U); ld = 16; }
        const int row0 = u.pm * BM + wr * 64 + fr, col0 = wc * 32 + 8 * fq;
#pragma unroll
        PG8_EPI_LOOP { const int row = row0 + ai * HALF + m * 16, col = col0 + bj * HALF; const u32x4 w = pack8(acc[ai][bj][m][0], acc[ai][bj][m][1]);
            if (pn == 13) *(u32x4*)(base + ((size_t)(col >> 4) * 1024 + (row >> 5)) * S5_LD + (row & 31) * 16 + (col & 15)) = w;
            else *(u32x4*)(base + (size_t)row * ld + col) = w; }
    }
};
struct EpiGateU8 {
    static constexpr bool PERM = true, AFTER_DRAIN = false, MID = false; unsigned char* G;
    __device__ __forceinline__ void operator()(const f32x4 (&acc)[2][2][4][2], const Unit& u, int wr, int wc, int fr, int fq) const {
        const int row0 = u.pm * BM + wr * 64 + fr, col0 = u.pn * BM + wc * 32 + 8 * fq;
#pragma unroll
        PG8_EPI_LOOP { const f32x4 a = acc[ai][bj][m][0], b = acc[ai][bj][m][1]; unsigned q[8];
#pragma unroll
            for (int i = 0; i < 4; ++i) { q[i] = (unsigned)(fsig(a[i]) * 255.f + 0.5f); q[4 + i] = (unsigned)(fsig(b[i]) * 255.f + 0.5f); }
            u32x2 w; w.x = q[0] | (q[1] << 8) | (q[2] << 16) | (q[3] << 24); w.y = q[4] | (q[5] << 8) | (q[6] << 16) | (q[7] << 24);
            *(u32x2*)(G + (size_t)(row0 + ai * HALF + m * 16) * 4096 + col0 + bj * HALF) = w; }
    }
};
struct EpiBranch {
    static constexpr bool PERM = true, AFTER_DRAIN = false, MID = true; const unsigned char* G; bf16_t* Mg;
    __device__ __forceinline__ void mid(f32x4 (&acc)[2][2][4][2], const Unit& u, int t, int, int, int, int) const {
        int tid = threadIdx.x; asm volatile("" : "+v"(tid));
        const int wid = __builtin_amdgcn_readfirstlane(tid >> 6), wr = wid >> 2, wc = wid & 3, fr = tid & 15, fq = (tid & 63) >> 4;
        const int row0 = u.pm * BM + wr * 64 + fr, col0 = u.pn * BM + wc * 32 + 8 * fq, sh = 2 * t - 16;
#pragma unroll
        PG8_EPI_LOOP { const unsigned char* gp = G + (size_t)(row0 + ai * HALF + m * 16) * 4096 + (col0 + bj * HALF) * 4; const u32x4 g0 = *(const u32x4*)gp, g1 = *(const u32x4*)(gp + 16);
#pragma unroll
            for (int i = 0; i < 4; ++i) { acc[ai][bj][m][0][i] *= fmaxf((float)((g0[i] >> sh) & 255u), 0.5f) * __builtin_amdgcn_rcpf(fmaxf((float)((g0[i] >> (sh + 8)) & 255u), 0.5f));
                                          acc[ai][bj][m][1][i] *= fmaxf((float)((g1[i] >> sh) & 255u), 0.5f) * __builtin_amdgcn_rcpf(fmaxf((float)((g1[i] >> (sh + 8)) & 255u), 0.5f)); } }
    }
    __device__ __forceinline__ void operator()(const f32x4 (&acc)[2][2][4][2], const Unit& u, int, int, int, int) const {
        int tid = threadIdx.x; asm volatile("" : "+v"(tid));
        const int wid = __builtin_amdgcn_readfirstlane(tid >> 6), wr = wid >> 2, wc = wid & 3, fr = tid & 15, fq = (tid & 63) >> 4;
        const int row0 = u.pm * BM + wr * 64 + fr, col0 = u.pn * BM + wc * 32 + 8 * fq;
#pragma unroll
        PG8_EPI_LOOP { const int row = row0 + ai * HALF + m * 16, col = col0 + bj * HALF;
            const unsigned char* gp = G + (size_t)row * 4096 + col * 4; const u32x4 g0 = *(const u32x4*)gp, g1 = *(const u32x4*)(gp + 16);
            f32x4 a = acc[ai][bj][m][0], b = acc[ai][bj][m][1];
#pragma unroll
            for (int i = 0; i < 4; ++i) { a[i] *= fmaxf((float)(g0[i] >> 24), 0.5f) * (1.f / 255.f); b[i] *= fmaxf((float)(g1[i] >> 24), 0.5f) * (1.f / 255.f); }
            *(u32x4*)(Mg + (size_t)row * DM + col) = pack8(a, b); }
    }
};
struct EpiOutRes {
    static constexpr bool PERM = true, AFTER_DRAIN = false, MID = false; const float* xi; float* xo;
    __device__ __forceinline__ void operator()(const f32x4 (&acc)[2][2][4][2], const Unit& u, int wr, int wc, int fr, int fq) const {
        const int row0 = u.pm * BM + wr * 64 + fr, col0 = u.pn * BM + wc * 32 + 8 * fq;
#pragma unroll
        PG8_EPI_LOOP { const size_t off = (size_t)(row0 + ai * HALF + m * 16) * DM + col0 + bj * HALF;
            const f32x4 a = *(const f32x4*)(xi + off), b = *(const f32x4*)(xi + off + 4);
            *(f32x4*)(xo + off) = a + acc[ai][bj][m][0]; *(f32x4*)(xo + off + 4) = b + acc[ai][bj][m][1]; }
    }
};
struct EpiGlu {
    static constexpr bool PERM = true, AFTER_DRAIN = false, MID = false; const bf16_t* yg; const float* bias; bf16_t* yc;
    __device__ __forceinline__ void operator()(const f32x4 (&acc)[2][2][4][2], const Unit& u, int wr, int wc, int fr, int fq) const {
        const int row0 = u.pm * BM + wr * 64 + fr, col0 = wc * 32 + 8 * fq;
#pragma unroll
        PG8_EPI_LOOP { const int row = row0 + ai * HALF + m * 16, col = col0 + bj * HALF;
            const u32x4 p = *(const u32x4*)(yg + (size_t)row * 256 + col); const f32x4 b0 = *(const f32x4*)(bias + col), b1 = *(const f32x4*)(bias + col + 4);
            f32x4 a = acc[ai][bj][m][0] + b0, b = acc[ai][bj][m][1] + b1;
            const float y[8] = {__uint_as_float(p.x << 16), __uint_as_float(p.x & 0xffff0000u), __uint_as_float(p.y << 16), __uint_as_float(p.y & 0xffff0000u),
                                __uint_as_float(p.z << 16), __uint_as_float(p.z & 0xffff0000u), __uint_as_float(p.w << 16), __uint_as_float(p.w & 0xffff0000u)};
#pragma unroll
            for (int i = 0; i < 4; ++i) { a[i] = y[i] * fsig(a[i]); b[i] = y[4 + i] * fsig(b[i]); }
            *(u32x4*)(yc + (size_t)row * YC_LD + YC_YD + col) = pack8(a, b); }
    }
};
struct S5aSched {
    int G, c;
    __device__ __forceinline__ bool next(int i, Unit& u) const { const int L = i * G + c; if (L >= 64) return false; const int g = L >> 2, pm = L & 3;
        u.aoff = ((unsigned)(g * 1024 + pm * 256) * S5_LD) * 2u; u.boff = (unsigned)g * 256u * 512u * 2u; u.nt = 8; u.pm = g * 4 + pm; u.pn = 0; u.aux = 0; return true; }
    __device__ __forceinline__ void a_ready(const Unit&) const {}
    __device__ __forceinline__ void done(const Unit&) const {}
};
struct S5bSched {
    int G, c;
    __device__ __forceinline__ bool next(int i, Unit& u) const { const int L = i * G + c; if (L >= 128) return false; const int g = L >> 3, pm = (L >> 1) & 3, pn = L & 1;
        u.aoff = ((unsigned)(g * 1024 + pm * 256) * S5_LD) * 2u; u.boff = ((unsigned)(g * 512 + pn * 256) * S5_LD) * 2u; u.nt = 10; u.pm = g * 4 + pm; u.pn = pn; u.aux = g; return true; }
    __device__ __forceinline__ void a_ready(const Unit&) const {}
    __device__ __forceinline__ void done(const Unit&) const {}
};
struct EpiS5a {
    static constexpr bool PERM = true, AFTER_DRAIN = false, MID = false; float* st;
    __device__ __forceinline__ void operator()(const f32x4 (&acc)[2][2][4][2], const Unit& u, int wr, int wc, int fr, int fq) const {
        const int row0 = u.pm * BM + wr * 64 + fr, col0 = wc * 32 + 8 * fq;
#pragma unroll
        for (int ai = 0; ai < 2; ++ai)
#pragma unroll
            for (int m = 0; m < 4; ++m) { float* p = st + (size_t)(row0 + ai * HALF + m * 16) * 128 + col0; *(f32x4*)p = acc[ai][0][m][0]; *(f32x4*)(p + 4) = acc[ai][0][m][1]; }
    }
};
struct EpiS5b {
    static constexpr bool PERM = true, AFTER_DRAIN = false, MID = false; const bf16_t* s5u; const float* dsk; bf16_t* yg;
    __device__ __forceinline__ void operator()(const f32x4 (&acc)[2][2][4][2], const Unit& u, int wr, int wc, int fr, int fq) const {
        const int g = u.aux, row0 = u.pm * BM + wr * 64 + fr  , col0 = u.pn * BM + wc * 32 + 8 * fq, c0 = col0 & 15;
        const f32x4 d0 = *(const f32x4*)(dsk + g * 16 + c0), d1 = *(const f32x4*)(dsk + g * 16 + c0 + 4);
#pragma unroll
        PG8_EPI_LOOP { const int row = row0 + ai * HALF + m * 16, col = col0 + bj * HALF, chunk = row - g * 1024, t = col >> 4;
            const u32x4 p = *(const u32x4*)(s5u + (size_t)row * S5_LD + col);
            const float uu[8] = {__uint_as_float(p.x << 16), __uint_as_float(p.x & 0xffff0000u), __uint_as_float(p.y << 16), __uint_as_float(p.y & 0xffff0000u),
                                 __uint_as_float(p.z << 16), __uint_as_float(p.z & 0xffff0000u), __uint_as_float(p.w << 16), __uint_as_float(p.w & 0xffff0000u)};
            f32x4 a = acc[ai][bj][m][0], b = acc[ai][bj][m][1];
#pragma unroll
            for (int i = 0; i < 4; ++i) { float y = a[i] + d0[i] * uu[i]; float z = 0.7978845608028654f * (y + 0.044715f * y * y * y); a[i] = y * fsig(2.f * z);
                y = b[i] + d1[i] * uu[4 + i]; z = 0.7978845608028654f * (y + 0.044715f * y * y * y); b[i] = y * fsig(2.f * z); }
            *(u32x4*)(yg + (size_t)(chunk * 32 + t) * 256 + g * 16 + c0) = pack8(a, b); }
    }
};
struct EpiMoe1 {
    static constexpr bool PERM = true, AFTER_DRAIN = false, MID = false; bf16_t* hid; const float* slot_w;
    __device__ __forceinline__ void operator()(const f32x4 (&acc)[2][2][4][2], const Unit& u, int wr, int wc, int fr, int fq) const {
        const int row0 = u.pm * BM + wr * 64 + fr, sel = u.pn / 3, col0 = sel * DEXP + (u.pn % 3) * 128 + wc * 32 + 8 * fq;
#pragma unroll
        for (int ai = 0; ai < 2; ++ai)
#pragma unroll
            for (int m = 0; m < 4; ++m) { const int row = row0 + ai * HALF + m * 16; const float w = slot_w[2 * row + sel]; f32x4 a, b;
#pragma unroll
                for (int i = 0; i < 4; ++i) { const float g0 = acc[ai][0][m][0][i], g1 = acc[ai][0][m][1][i]; a[i] = g0 * fsig(g0) * acc[ai][1][m][0][i] * w; b[i] = g1 * fsig(g1) * acc[ai][1][m][1][i] * w; }
                *(u32x4*)(hid + (size_t)row * 768 + col0) = pack8(a, b); asm volatile("" ::: "memory"); }
    }
};
struct EpiMoe2 {
    static constexpr bool PERM = true, AFTER_DRAIN = false, MID = false; float* x; const int* slot_tok; float* dummy;
    __device__ __forceinline__ void operator()(const f32x4 (&acc)[2][2][4][2], const Unit& u, int wr, int wc, int fr, int fq) const {
        const int row0 = u.pm * BM + wr * 64 + fr, col0 = u.pn * BM + wc * 32 + 8 * fq;
#pragma unroll
        for (int ai = 0; ai < 2; ++ai)
#pragma unroll
            for (int m = 0; m < 4; ++m) { const int t = slot_tok[row0 + ai * HALF + m * 16]; float* rowp = (t >= 0 ? x + (size_t)t * DM : dummy) + col0;
#pragma unroll
                for (int bj = 0; bj < 2; ++bj) { float* p = rowp + bj * HALF; const f32x4 a = *(const f32x4*)p, b = *(const f32x4*)(p + 4);
                    *(f32x4*)p = a + acc[ai][bj][m][0]; *(f32x4*)(p + 4) = b + acc[ai][bj][m][1]; }
                asm volatile("" ::: "memory"); }
    }
};

template <class Epi, class Sched, bool ALIGN_EPI = false, bool SP2 = false>
__device__ __forceinline__ void gemm_phase(PG8_LAS unsigned char* lds, const Gemm g, const Sched& S, const Epi& E) {
    int tid_ = threadIdx.x; asm volatile("" : "+v"(tid_));
    const int tid = tid_, wid = __builtin_amdgcn_readfirstlane(tid >> 6), lane = tid & 63, wr = wid >> 2, wc = wid & 3, fr = lane & 15, fq = lane >> 4;
    unsigned voffA[2], voffB[2];
#pragma unroll
    for (int i = 0; i < 2; ++i) { int R, C; stage_rc(tid * 16 + i * 8192, R, C); const int Rb = Epi::PERM ? ((R & ~31) + perm32(R & 31)) : R;
        voffA[i] = (unsigned)(R * g.lda + C) * 2u; voffB[i] = (unsigned)(Rb * g.ldb + C) * 2u; }
    const size_t kstep = (size_t)(BK * 2);
    const size_t hstepA = (size_t)HALF * g.lda * 2, hstepB = (size_t)HALF * g.ldb * 2;
    const unsigned ldsw = (unsigned)wid * 1024u;
    const int aoff = lds_byte(wr * 64 + fr, fq * 8), boff = lds_byte(wc * 32 + fr, fq * 8);
#define PG8_SA(b, h) (((b) * 2 + (h)) * HTB)
#define PG8_SB(b, h) ((4 + (b) * 2 + (h)) * HTB)
#define PG8_STAGE(bufoff, gbase, voff) do { _Pragma("unroll") for (int _i = 0; _i < 2; ++_i) \
        __builtin_amdgcn_global_load_lds((const unsigned*)((const char*)(gbase) + (voff)[_i]), (PG8_LAS unsigned*)(lds + (bufoff) + ldsw + _i * 8192), 16, 0, 0); } while (0)
#define PG8_LDA(dst, b, h) do { _Pragma("unroll") for (int m = 0; m < 4; ++m) _Pragma("unroll") for (int k = 0; k < 2; ++k) dst[m][k] = *(const PG8_LAS bf16x8*)(lds + PG8_SA(b, h) + aoff + m * 2048 + k * 1024); } while (0)
#define PG8_LDB(dst, b, h) do { _Pragma("unroll") for (int n = 0; n < 2; ++n) _Pragma("unroll") for (int k = 0; k < 2; ++k) dst[n][k] = *(const PG8_LAS bf16x8*)(lds + PG8_SB(b, h) + boff + n * 2048 + k * 1024); } while (0)
#define PG8_MMA(ai, bj, At, Bt) do { __builtin_amdgcn_s_setprio(1); _Pragma("unroll") for (int m = 0; m < 4; ++m) _Pragma("unroll") for (int n = 0; n < 2; ++n) _Pragma("unroll") for (int k = 0; k < 2; ++k) \
        acc[ai][bj][m][n] = __builtin_amdgcn_mfma_f32_16x16x32_bf16(Bt[n][k], At[m][k], acc[ai][bj][m][n], 0, 0, 0); __builtin_amdgcn_s_setprio(0); } while (0)
#define PG8_WAIT_V(n) asm volatile("s_waitcnt vmcnt(" #n ")" ::: "memory")
#define PG8_WAIT_L(n) asm volatile("s_waitcnt lgkmcnt(" #n ")" ::: "memory")
#define PG8_BAR __builtin_amdgcn_s_barrier()
#define PG8_SCHED __builtin_amdgcn_sched_barrier(0)
    Unit cur; int ui = 0;
    if (!S.next(0, cur)) return;
    f32x4 acc[2][2][4][2];
#pragma unroll
    for (int a = 0; a < 2; ++a)
#pragma unroll
        for (int b = 0; b < 2; ++b)
#pragma unroll
            for (int m = 0; m < 4; ++m)
#pragma unroll
                for (int n = 0; n < 2; ++n) acc[a][b][m][n] = (f32x4){0.f, 0.f, 0.f, 0.f};
    bf16x8 At[4][2], B0[2][2], B1[2][2];
    const char* cA = (const char*)g.A + cur.aoff; const char* cB = (const char*)g.Bt + cur.boff;
    S.a_ready(cur);
    if constexpr (SP2) {
        PG8_STAGE(PG8_SB(0, 0), cB, voffB); PG8_STAGE(PG8_SB(0, 1), cB + hstepB, voffB); PG8_STAGE(PG8_SA(0, 0), cA, voffA); PG8_STAGE(PG8_SA(0, 1), cA + hstepA, voffA);
        if (wr == 1) PG8_BAR;
        PG8_WAIT_V(2); PG8_BAR;
        PG8_STAGE(PG8_SB(1, 0), cB + kstep, voffB); PG8_STAGE(PG8_SA(1, 0), cA + kstep, voffA); PG8_STAGE(PG8_SB(1, 1), cB + hstepB + kstep, voffB);
        PG8_WAIT_V(6); PG8_BAR;
    } else {
        PG8_STAGE(PG8_SB(0, 0), cB, voffB); PG8_STAGE(PG8_SA(0, 0), cA, voffA); PG8_STAGE(PG8_SB(0, 1), cB + hstepB, voffB); PG8_STAGE(PG8_SA(0, 1), cA + hstepA, voffA);
        if (wr == 1) PG8_BAR;
        PG8_WAIT_V(4); PG8_BAR;
        PG8_STAGE(PG8_SB(1, 0), cB + kstep, voffB); PG8_STAGE(PG8_SA(1, 0), cA + kstep, voffA); PG8_STAGE(PG8_SB(1, 1), cB + hstepB + kstep, voffB);
        PG8_WAIT_V(6); PG8_BAR;
    }
    for (;;) {
        Unit nxt; const bool has_next = S.next(ui + 1, nxt);
        const char* nA = has_next ? (const char*)g.A + nxt.aoff : cA; const char* nB = has_next ? (const char*)g.Bt + nxt.boff : cB;
        const int nt = cur.nt;
        for (int t = 0; t < nt; t += 2) {
            const bool last = (t == nt - 2);
            const char* a1 = cA + (size_t)(t + 1) * kstep;
            const char* a2 = last ? nA : cA + (size_t)(t + 2) * kstep; const char* b2 = last ? nB : cB + (size_t)(t + 2) * kstep;
            const char* a3 = a2 + kstep; const char* b3 = b2 + kstep;
            if (last && has_next) S.a_ready(nxt);
            if constexpr (Epi::MID) { if (t == 8 || t == 12 || t == 16) E.mid(acc, cur, t, wr, wc, fr, fq); }
            if constexpr (SP2) {
            PG8_LDB(B0, 0, 0); PG8_LDB(B1, 0, 1); PG8_SCHED; PG8_LDA(At, 0, 0); PG8_STAGE(PG8_SA(1, 1), a1 + hstepA, voffA);
            PG8_WAIT_V(8); PG8_WAIT_L(0); PG8_BAR; PG8_MMA(0, 0, At, B0); PG8_MMA(0, 1, At, B1); PG8_BAR; PG8_SCHED;
            PG8_LDA(At, 0, 1); PG8_STAGE(PG8_SB(0, 0), b2, voffB); PG8_STAGE(PG8_SB(0, 1), b2 + hstepB, voffB); PG8_STAGE(PG8_SA(0, 0), a2, voffA);
            PG8_WAIT_V(8); PG8_WAIT_L(0); PG8_BAR; PG8_MMA(1, 0, At, B0); PG8_MMA(1, 1, At, B1); PG8_BAR; PG8_SCHED;
            PG8_LDB(B0, 1, 0); PG8_LDB(B1, 1, 1); PG8_SCHED; PG8_LDA(At, 1, 0); PG8_STAGE(PG8_SA(0, 1), a2 + hstepA, voffA);
            PG8_WAIT_V(8); PG8_WAIT_L(0); PG8_BAR; PG8_MMA(0, 0, At, B0); PG8_MMA(0, 1, At, B1); PG8_BAR; PG8_SCHED;
            PG8_LDA(At, 1, 1); PG8_STAGE(PG8_SB(1, 0), b3, voffB); PG8_STAGE(PG8_SB(1, 1), b3 + hstepB, voffB); PG8_STAGE(PG8_SA(1, 0), a3, voffA);
            PG8_WAIT_V(8); PG8_WAIT_L(0); PG8_BAR; PG8_MMA(1, 0, At, B0); PG8_MMA(1, 1, At, B1); PG8_BAR; PG8_SCHED;
            } else {
            PG8_LDB(B0, 0, 0); PG8_SCHED; PG8_LDA(At, 0, 0); PG8_STAGE(PG8_SA(1, 1), a1 + hstepA, voffA);
            PG8_WAIT_L(8); PG8_BAR; PG8_WAIT_L(0); PG8_MMA(0, 0, At, B0); PG8_BAR; PG8_SCHED;
            PG8_LDB(B1, 0, 1); PG8_STAGE(PG8_SB(0, 0), b2, voffB);
            PG8_BAR; PG8_WAIT_L(0); PG8_MMA(0, 1, At, B1); PG8_BAR;
            PG8_LDA(At, 0, 1); PG8_STAGE(PG8_SA(0, 0), a2, voffA);
            PG8_BAR; PG8_WAIT_L(0); PG8_MMA(1, 0, At, B0); PG8_BAR; PG8_SCHED;
            PG8_STAGE(PG8_SB(0, 1), b2 + hstepB, voffB);
            PG8_WAIT_V(6); PG8_BAR; PG8_MMA(1, 1, At, B1); PG8_BAR;
            PG8_LDB(B0, 1, 0); PG8_SCHED; PG8_LDA(At, 1, 0); PG8_STAGE(PG8_SA(0, 1), a2 + hstepA, voffA);
            PG8_WAIT_L(8); PG8_BAR; PG8_WAIT_L(0); PG8_MMA(0, 0, At, B0); PG8_BAR; PG8_SCHED;
            PG8_LDB(B1, 1, 1); PG8_STAGE(PG8_SB(1, 0), b3, voffB);
            PG8_BAR; PG8_WAIT_L(0); PG8_MMA(0, 1, At, B1); PG8_BAR;
            PG8_LDA(At, 1, 1); PG8_STAGE(PG8_SA(1, 0), a3, voffA);
            PG8_BAR; PG8_WAIT_L(0); PG8_MMA(1, 0, At, B0); PG8_BAR; PG8_SCHED;
            PG8_STAGE(PG8_SB(1, 1), b3 + hstepB, voffB);
            PG8_WAIT_V(6); PG8_BAR; PG8_MMA(1, 1, At, B1); PG8_BAR;
            }
        }
        if constexpr (ALIGN_EPI) { if (wr == 0) PG8_BAR; }
        if constexpr (!Epi::AFTER_DRAIN) { E(acc, cur, wr, wc, fr, fq); S.done(cur); }
        if (!has_next) break;
#pragma unroll
        for (int a = 0; a < 2; ++a)
#pragma unroll
            for (int b = 0; b < 2; ++b)
#pragma unroll
                for (int m = 0; m < 4; ++m)
#pragma unroll
                    for (int n = 0; n < 2; ++n) acc[a][b][m][n] = (f32x4){0.f, 0.f, 0.f, 0.f};
        cA = nA; cB = nB; ++ui; (void)S.next(ui, cur);
        if constexpr (ALIGN_EPI) { if (wr == 1) PG8_BAR; }
    }
    PG8_WAIT_V(0);
    if constexpr (!ALIGN_EPI) { if (wr == 0) PG8_BAR; }
    PG8_BAR;
    if constexpr (Epi::AFTER_DRAIN) { E.fused(acc, cur, wr, wc, fr, fq, lds, wid, lane); S.done(cur); }
#undef PG8_SA
#undef PG8_SB
#undef PG8_STAGE
#undef PG8_LDA
#undef PG8_LDB
#undef PG8_MMA
#undef PG8_WAIT_V
#undef PG8_WAIT_L
#undef PG8_BAR
#undef PG8_SCHED
}
}

#include <hip/hip_bf16.h>
#include <cmath>
namespace attn_body {
using bf16=__hip_bfloat16;
using bf16x8=__attribute__((ext_vector_type(8)))short;
using s16x4=__attribute__((ext_vector_type(4)))short;
using f32x16=__attribute__((ext_vector_type(16)))float;
using u32x4=__attribute__((ext_vector_type(4)))unsigned;
constexpr int BATCH=4,NHEAD=16,SEQ=8192,D=64;
constexpr int QP=1280,KP=512,VP=512,OP=1024;
constexpr int NW=8,QBLK=32,QB=QBLK*NW,KVBLK=64,NQB=SEQ/QB;
constexpr int ATTN_UNIT_ROWS=QB;
__device__ __forceinline__ int crow(int r,int hi){return (r&3)+8*(r>>2)+4*hi;}
#define SBAR() __builtin_amdgcn_sched_barrier(0)
__device__ __forceinline__ void cmask(f32x16&p0,f32x16&p1,int jb,int qrel,int hi){
  const float NEG=-INFINITY; int kb=64*jb+4*hi;
  #pragma unroll
  for(int r=0;r<16;++r){int kv=kb+(r&3)+8*(r>>2); if(kv>qrel)p0[r]=NEG; if(kv+32>qrel)p1[r]=NEG;}
}

constexpr int NSLOT=3, SLOTB=8192;
constexpr int LDS_K=0, LDS_V=NSLOT*SLOTB, LDS_WS=2*NSLOT*SLOTB, LDS_OST=LDS_WS+NW*64*4, LDS_BYTES=LDS_OST+NW*4096;
constexpr float C2=0.125f*1.4426950408889634f;
__device__ __forceinline__ void glds16(const void*gsrc,unsigned lds_dst){unsigned keep;
  asm volatile("s_mov_b32 %0, m0\n\ts_mov_b32 m0, %2\n\ts_nop 0\n\tglobal_load_lds_dwordx4 %1, off\n\ts_mov_b32 m0, %0":"=&s"(keep):"v"(gsrc),"s"(lds_dst):"memory");}
__device__ __forceinline__ float max3f(float a,float b,float c){float r;asm("v_max3_f32 %0, %1, %2, %3":"=v"(r):"v"(a),"v"(b),"v"(c));return r;}
__device__ __forceinline__ float max2f(float a,float b){float r;asm("v_max_f32_e32 %0, %1, %2":"=v"(r):"v"(a),"v"(b));return r;}
__device__ __forceinline__ float fadd_s(float a,float b){float r;asm("v_add_f32_e32 %0, %1, %2":"=v"(r):"v"(a),"v"(b));return r;}
__device__ __forceinline__ float fsub_s(float a,float b){float r;asm("v_sub_f32_e32 %0, %1, %2":"=v"(r):"v"(a),"v"(b));return r;}
typedef float f32x2_t __attribute__((ext_vector_type(2))); typedef __bf16 bf16x2_t __attribute__((ext_vector_type(2)));
__device__ __forceinline__ unsigned cvtpk_s(float lo,float hi){f32x2_t v={lo,hi};bf16x2_t b=__builtin_convertvector(v,bf16x2_t);return __builtin_bit_cast(unsigned,b);}
#define WAIT_BAR(N) asm volatile("s_waitcnt vmcnt(" #N ") lgkmcnt(0)\n\ts_barrier":::"memory")

__device__ __forceinline__ float rowmax(const f32x16&p0,const f32x16&p1){
  float a=max3f(p0[0],p0[1],p1[0]),b=max3f(p0[2],p0[3],p1[1]);a=max3f(a,p1[2],p1[3]);
  #pragma unroll
  for(int r=4;r<16;r+=4){a=max3f(a,p0[r],p0[r+1]);b=max3f(b,p0[r+2],p0[r+3]);a=max3f(a,p1[r],p1[r+1]);b=max3f(b,p1[r+2],p1[r+3]);}
  const float m=max2f(a,b);
  auto rr=__builtin_amdgcn_permlane32_swap(__float_as_uint(m),__float_as_uint(m),false,false);
  return max2f(__uint_as_float(rr[0]),__uint_as_float(rr[1]));
}

#undef SBAR
#undef WAIT_BAR
}

namespace attn2 {
using attn_body::bf16; using attn_body::bf16x8; using attn_body::s16x4; using attn_body::f32x16; using attn_body::u32x4; using attn_body::crow; using attn_body::cmask; using attn_body::glds16; using attn_body::rowmax; using attn_body::cvtpk_s;
constexpr int SEQ = 8192, QP = 1280, KP = 512, VP = 512, OP = 1024, NW = 8, QBLK = 32, QB = 256, KVBLK = 64, NSLOT = 3, NVSLOT = 4, KSLOT = 8192, VSLOT = 16384;
constexpr int LDS_K = 0, LDS_V = NSLOT * KSLOT, LDS_WS = LDS_V + NVSLOT * VSLOT, LDS_OST = LDS_WS + NW * 64 * 4, LDS_BYTES = LDS_OST + NW * 4096;
typedef __attribute__((address_space(3))) const char* lds_cptr; typedef short v4i16_t __attribute__((ext_vector_type(4)));
__device__ __forceinline__ s16x4 vtr(lds_cptr p) { return __builtin_bit_cast(s16x4, __builtin_amdgcn_ds_read_tr16_b64_v4i16((__attribute__((address_space(3))) v4i16_t*)p)); }
template <int THRL> __device__ __forceinline__ void attn_unit(int b, int hc, int qb, const bf16* Q, const bf16* __restrict__ K, const bf16* __restrict__ V, bf16* O, char* shm) {
    int tid_ = threadIdx.x; asm volatile("" : "+v"(tid_)); const int tid = tid_, lane = tid & 63, r32 = lane & 31, hi = lane >> 5; const int wid = __builtin_amdgcn_readfirstlane(tid >> 6);
    const int qcol = hc * 64, kcol = hc * 64, vcol = (hc >> 1) * 128, ocol = hc * 128;
    const long rowbase = (long)b * SEQ; const int q0 = qb * QB;
    const bf16* Qw = Q + (rowbase + q0 + wid * QBLK) * QP + qcol;
    const bf16 *Kh = K + rowbase * KP + kcol, *Vh = V + rowbase * VP + vcol;
    const unsigned lds0 = (unsigned)(uintptr_t)shm;
    float* wsf = (float*)(shm + LDS_WS) + wid * 64;
    const bf16* ksrc = Kh + (long)lane * KP + wid * 8;
    const bf16* vsrc = Vh + (long)(16 * (wid & 3) + (lane >> 2)) * VP + (wid >> 2) * 32 + (lane & 3) * 8;
    const unsigned kdst = lds0 + LDS_K + wid * 1024, vdst = lds0 + LDS_V + wid * 1024;
    const lds_cptr shm3 = (lds_cptr)shm; const lds_cptr vp0 = shm3 + LDS_V + ((lane >> 4) & 1) * 32 + (lane & 3) * 8 + (4 * hi + ((lane & 15) >> 2)) * 64;
    const int NT = (q0 + QB) / KVBLK;
#define A2_DMAK(t, sl) glds16(ksrc + (long)(t) * KVBLK * KP, (unsigned)__builtin_amdgcn_readfirstlane(kdst + (sl) * KSLOT))
#define A2_DMAV(t, sl) do { glds16(vsrc + (long)(t) * KVBLK * VP, (unsigned)__builtin_amdgcn_readfirstlane(vdst + (sl) * VSLOT)); glds16(vsrc + (long)(t) * KVBLK * VP + 64, (unsigned)__builtin_amdgcn_readfirstlane(vdst + (sl) * VSLOT + 8192)); } while (0)
    A2_DMAK(0, 0); A2_DMAV(0, 0); A2_DMAK(1, 1); A2_DMAV(1, 1);
    bf16x8 qr[4];
#pragma unroll
    for (int d0 = 0; d0 < 4; ++d0) qr[d0] = *reinterpret_cast<const bf16x8*>(&Qw[(long)r32 * QP + d0 * 16 + hi * 8]);
    float mhat = 0.f, l_reg = 0.f; f32x16 o[4]; o[0] = f32x16{}; o[1] = f32x16{}; o[2] = f32x16{}; o[3] = f32x16{};
    const int qrel = wid * QBLK + r32;
    u32x4 pw[4] = {};
    int slot = 0, slot2 = 2;
#define A2_PV(sl) do { const lds_cptr vp_ = vp0 + (sl) * VSLOT; _Pragma("unroll") for (int ks = 0; ks < 4; ++ks) { const bf16x8 pa = __builtin_bit_cast(bf16x8, pw[ks]); \
        _Pragma("unroll") for (int d0 = 0; d0 < 4; ++d0) { const s16x4 lo = vtr(vp_ + d0 * 4096 + ks * 1024), h4 = vtr(vp_ + d0 * 4096 + ks * 1024 + 512); \
            o[d0] = __builtin_amdgcn_mfma_f32_32x32x16_bf16(pa, (bf16x8){lo[0], lo[1], lo[2], lo[3], h4[0], h4[1], h4[2], h4[3]}, o[d0], 0, 0, 0); } } } while (0)
#define A2_VRD(i_) do { const int d0_ = (i_) & 3, ks_ = (i_) >> 2; vlo[(i_) % 3] = vtr(vp_ + d0_ * 4096 + ks_ * 1024); vhi[(i_) % 3] = vtr(vp_ + d0_ * 4096 + ks_ * 1024 + 512); } while (0)
typedef float f32x2a __attribute__((ext_vector_type(2)));
#define A2_PE2(P, e_) do { f32x2a d_ = (f32x2a){P[e_], P[(e_) + 1]} - mhat2; P[e_] = __builtin_amdgcn_exp2f(d_.x); P[(e_) + 1] = __builtin_amdgcn_exp2f(d_.y); } while (0)
#define A2_GAP(i_) do { if ((i_) + 2 < 16) A2_VRD((i_) + 2); \
        o[(i_) & 3] = __builtin_amdgcn_mfma_f32_32x32x16_bf16(__builtin_bit_cast(bf16x8, pw[(i_) >> 2]), (bf16x8){vlo[(i_) % 3][0], vlo[(i_) % 3][1], vlo[(i_) % 3][2], vlo[(i_) % 3][3], vhi[(i_) % 3][0], vhi[(i_) % 3][1], vhi[(i_) % 3][2], vhi[(i_) % 3][3]}, o[(i_) & 3], 0, 0, 0); \
        if ((i_) < 8) { A2_PE2(p0, 2 * (i_)); asm volatile("" : "+v"(p0)); } else { A2_PE2(p1, 2 * (i_) - 16); asm volatile("" : "+v"(p1)); } \
        __builtin_amdgcn_sched_barrier(0); } while (0)
#define A2_STEP(MASKED) do { \
          \
        if (t + 1 < NT) asm volatile("s_waitcnt vmcnt(5) lgkmcnt(0)\n\ts_barrier" ::: "memory"); \
        else asm volatile("s_waitcnt vmcnt(2) lgkmcnt(0)\n\ts_barrier" ::: "memory"); \
        if (t + 2 < NT) { A2_DMAK(t + 2, slot2); A2_DMAV(t + 2, (vslotp + 3) & 3); } \
        __builtin_amdgcn_sched_barrier(0); \
        f32x16 p0 = f32x16{}, p1 = f32x16{}; \
        const char* kb = shm + LDS_K + slot * KSLOT + hi * 1024 + r32 * 16; \
        const lds_cptr vp_ = vp0 + (t == 0 ? 0 : vslotp) * VSLOT; s16x4 vlo[3], vhi[3]; \
        _Pragma("unroll") for (int d0 = 0; d0 < 4; ++d0) { const bf16x8 b0 = *reinterpret_cast<const bf16x8*>(kb + d0 * 2048), b1 = *reinterpret_cast<const bf16x8*>(kb + d0 * 2048 + 512); \
            p0 = __builtin_amdgcn_mfma_f32_32x32x16_bf16(b0, qr[d0], p0, 0, 0, 0); p1 = __builtin_amdgcn_mfma_f32_32x32x16_bf16(b1, qr[d0], p1, 0, 0, 0); } \
        A2_VRD(0); A2_VRD(1); \
        if (MASKED) cmask(p0, p1, t - (NT - 4), qrel, hi); \
        asm volatile("s_nop 15\n\ts_nop 7" : "+v"(p0), "+v"(p1));        \
        const float rm = rowmax(p0, p1) - mhat; \
        resc = __any(rm > (float)THRL); \
        const float dl = resc ? __builtin_fmaxf(rm, 0.f) : 0.f; mhat += dl; \
        fsc = __builtin_amdgcn_exp2f(-dl); const f32x2a mhat2 = {mhat, mhat}; \
        __builtin_amdgcn_sched_barrier(0); \
        A2_GAP(0); A2_GAP(1); A2_GAP(2); A2_GAP(3); A2_GAP(4); A2_GAP(5); A2_GAP(6); A2_GAP(7); A2_GAP(8); A2_GAP(9); A2_GAP(10); A2_GAP(11); A2_GAP(12); A2_GAP(13); A2_GAP(14); A2_GAP(15); \
        f32x2a s2_ = {0.f, 0.f}; \
        _Pragma("unroll") for (int r = 0; r < 16; r += 2) { s2_ += (f32x2a){p0[r], p0[r + 1]}; s2_ += (f32x2a){p1[r], p1[r + 1]}; }        \
        l_reg = l_reg * fsc + (s2_.x + s2_.y); \
        pw[0] = (u32x4){cvtpk_s(p0[0], p0[1]), cvtpk_s(p0[2], p0[3]), cvtpk_s(p0[4], p0[5]), cvtpk_s(p0[6], p0[7])}; pw[1] = (u32x4){cvtpk_s(p0[8], p0[9]), cvtpk_s(p0[10], p0[11]), cvtpk_s(p0[12], p0[13]), cvtpk_s(p0[14], p0[15])}; \
        pw[2] = (u32x4){cvtpk_s(p1[0], p1[1]), cvtpk_s(p1[2], p1[3]), cvtpk_s(p1[4], p1[5]), cvtpk_s(p1[6], p1[7])}; pw[3] = (u32x4){cvtpk_s(p1[8], p1[9]), cvtpk_s(p1[10], p1[11]), cvtpk_s(p1[12], p1[13]), cvtpk_s(p1[14], p1[15])}; \
        if (resc) { if (hi == 0) wsf[r32] = fsc;                   \
            asm volatile("s_waitcnt lgkmcnt(0)" ::: "memory"); \
            _Pragma("unroll") for (int r = 0; r < 16; ++r) { const float fr = wsf[crow(r, hi)]; \
                _Pragma("unroll") for (int d = 0; d < 4; ++d) o[d][r] *= fr; } } \
        slot2 = slot; slot = slot == NSLOT - 1 ? 0 : slot + 1; vslotp = (vslotp + 1) & 3;        \
    } while (0)
    bool resc = false; float fsc = 1.f; int vslotp = 3;
    int t = 0;
    if (wid >= 4) __builtin_amdgcn_s_setprio(1);
    for (; t < NT - 4; ++t) A2_STEP(false);
    for (; t < NT; ++t) A2_STEP(true);
    __builtin_amdgcn_s_setprio(0);
#undef A2_STEP
#undef A2_GAP
#undef A2_PE2
#undef A2_VRD
    asm volatile("s_waitcnt vmcnt(0) lgkmcnt(0)\n\ts_barrier" ::: "memory");
    A2_PV(vslotp);
#undef A2_PV
#undef A2_DMAK
#undef A2_DMAV
    { auto rr = __builtin_amdgcn_permlane32_swap(__float_as_uint(l_reg), __float_as_uint(l_reg), false, false); l_reg = __uint_as_float(rr[0]) + __uint_as_float(rr[1]); }
    if (hi == 0) wsf[32 + r32] = l_reg; asm volatile("s_waitcnt lgkmcnt(0)" ::: "memory");
    float rli[16];
#pragma unroll
    for (int r = 0; r < 16; ++r) rli[r] = __builtin_amdgcn_rcpf(wsf[32 + crow(r, hi)]);
    bf16* Ow = O + (rowbase + q0 + wid * QBLK) * OP + ocol;
    bf16* stg = (bf16*)(shm + LDS_OST) + wid * 2048;
#pragma unroll
    for (int pass = 0; pass < 2; ++pass) {
#pragma unroll
        for (int r = 0; r < 16; ++r) { const int orow = crow(r, hi);
#pragma unroll
            for (int d0 = 0; d0 < 2; ++d0) stg[orow * 64 + d0 * 32 + r32] = __float2bfloat16(o[2 * pass + d0][r] * rli[r]); }
        asm volatile("s_waitcnt lgkmcnt(0)" ::: "memory");
#pragma unroll
        for (int i = 0; i < 4; ++i) { const int row = i * 8 + (lane >> 3), ch = lane & 7; const u32x4 v = *(const u32x4*)(stg + row * 64 + ch * 8); *(u32x4*)(Ow + (long)row * OP + pass * 64 + ch * 8) = v; }
        asm volatile("s_waitcnt lgkmcnt(0)" ::: "memory");
    }
    asm volatile("s_waitcnt lgkmcnt(0)\n\ts_barrier" ::: "memory");
}
struct AttnTensors { const bf16* Q; const bf16* K; const bf16* V; bf16* O; };
struct AttnUnit { int bh; int qb; };
struct StaticOrder {
    int vcu, G;
    __device__ __forceinline__ explicit StaticOrder(int grid, int block) : vcu((grid % 8 == 0) ? (block % 8) * (grid / 8) + block / 8 : block), G(grid) {}
    __device__ __forceinline__ bool next(int i, AttnUnit& u) const { const int oct = vcu + (i >> 2) * G; if (oct >= 256) return false; const int s = oct & 7, ii = i & 3; u.bh = oct >> 3; u.qb = (ii == 0) ? s : (ii == 1) ? 15 - s : (ii == 2) ? 16 + s : 31 - s; return true; }
};
template <int THRL = 8> __device__ __forceinline__ void attn_phase(char* lds, const AttnTensors& T, const StaticOrder& S) {
    AttnUnit u;
    for (int i = 0; S.next(i, u); ++i) attn_unit<THRL>(u.bh >> 3, u.bh & 7, u.qb, T.Q, T.K, T.V, T.O, lds);
}
}

namespace tile {
typedef short bf16x8 __attribute__((ext_vector_type(8)));
typedef short s16x4 __attribute__((ext_vector_type(4)));
typedef float f32x16 __attribute__((ext_vector_type(16)));
constexpr int TP = 72;
__device__ __forceinline__ int crow(int r, int hi) { return (r & 3) + 8 * (r >> 2) + 4 * hi; }
__device__ __forceinline__ bf16x8 frag_row(const LAS bf16_t* T, int r0, int k0, int lane) { return *(const LAS bf16x8*)(T + (r0 + (lane & 31)) * TP + k0 + 8 * (lane >> 5)); }
__device__ __forceinline__ bf16x8 frag_tr(const LAS bf16_t* T, int ra, int rb, int c0, int lane) {
    const int hi = lane >> 5, g16 = (lane >> 4) & 1, q = (lane & 15) >> 2, p = lane & 3;
    const LAS bf16_t* a0 = T + (ra + 4 * hi + q) * TP + c0 + 16 * g16 + 4 * p; const LAS bf16_t* a1 = T + (rb + 4 * hi + q) * TP + c0 + 16 * g16 + 4 * p;
    const s16x4 lo = __builtin_bit_cast(s16x4, __builtin_amdgcn_ds_read_tr16_b64_v4i16((LAS s16x4*)a0)), hi4 = __builtin_bit_cast(s16x4, __builtin_amdgcn_ds_read_tr16_b64_v4i16((LAS s16x4*)a1));
    return (bf16x8){lo[0], lo[1], lo[2], lo[3], hi4[0], hi4[1], hi4[2], hi4[3]};
}
__device__ __forceinline__ bf16x8 frag_tr_nat(const LAS bf16_t* T, int k0, int c0, int lane) {
    const int hi = lane >> 5, g16 = (lane >> 4) & 1, q = (lane & 15) >> 2, p = lane & 3;
    const LAS bf16_t* a0 = T + (k0 + 8 * hi + q) * TP + c0 + 16 * g16 + 4 * p;
    const s16x4 lo = __builtin_bit_cast(s16x4, __builtin_amdgcn_ds_read_tr16_b64_v4i16((LAS s16x4*)a0)), hi4 = __builtin_bit_cast(s16x4, __builtin_amdgcn_ds_read_tr16_b64_v4i16((LAS s16x4*)(a0 + 4 * TP)));
    return (bf16x8){lo[0], lo[1], lo[2], lo[3], hi4[0], hi4[1], hi4[2], hi4[3]};
}
__device__ __forceinline__ unsigned cvtpk(float lo, float hi) { typedef float f2 __attribute__((ext_vector_type(2))); typedef __bf16 b2 __attribute__((ext_vector_type(2))); f2 v = {lo, hi}; return __builtin_bit_cast(unsigned, __builtin_convertvector(v, b2)); }
__device__ __forceinline__ bf16x8 acc_frag(const f32x16& x, int s_) { u32x4 w; w.x = cvtpk(x[8 * s_], x[8 * s_ + 1]); w.y = cvtpk(x[8 * s_ + 2], x[8 * s_ + 3]); w.z = cvtpk(x[8 * s_ + 4], x[8 * s_ + 5]); w.w = cvtpk(x[8 * s_ + 6], x[8 * s_ + 7]); return __builtin_bit_cast(bf16x8, w); }
#define MFMA32(a, b, c) __builtin_amdgcn_mfma_f32_32x32x16_bf16((a), (b), (c), 0, 0, 0)
}

__device__ __forceinline__ void sb_phase(LAS unsigned char* lds, bf16_t* QO, int ldq, const bf16_t* __restrict__ Kb, const bf16_t* __restrict__ Vb, int gw, int ngw, int wave, int lane) {
    using namespace tile;
    LAS bf16_t* Kt = (LAS bf16_t*)(lds + wave * 16384); LAS bf16_t* Vt = Kt + 32 * TP; LAS bf16_t* Ot = Vt + 32 * TP;
    const int hi = lane >> 5, ql = lane & 31;
    bf16x8 uf[2];
#pragma unroll
    for (int s_ = 0; s_ < 2; ++s_)
#pragma unroll
        for (int j = 0; j < 8; ++j) uf[s_][j] = (16 * s_ + 8 * (j >> 2) + 4 * hi + (j & 3)) > ql ? (short)0x3F80 : (short)0;
    for (int unit = gw; unit < NTOK * 4 / 32; unit += ngw) {
        const int qb = unit & 255, h = (unit >> 8) & 3, b = unit >> 10, q0 = qb * 32; const size_t rb = (size_t)b * SEQ;
        bf16x8 qf[4];
#pragma unroll
        for (int s_ = 0; s_ < 4; ++s_) qf[s_] = *(const bf16x8*)(QO + (rb + q0 + ql) * ldq + h * 64 + 16 * s_ + 8 * hi);
        f32x16 o0 = {}, o1 = {}; float carry = 0.f;
        u32x4 kp[4], vp[4];
#define SB_LOAD(k0_) do { _Pragma("unroll") for (int i = 0; i < 4; ++i) { const int c = lane + 64 * i, row = c >> 3, c16 = c & 7; \
            kp[i] = *(const u32x4*)(Kb + (rb + (k0_) + row) * 256 + h * 64 + c16 * 8); vp[i] = *(const u32x4*)(Vb + (rb + (k0_) + row) * 256 + h * 64 + c16 * 8); } } while (0)
#define SB_STORE() do { _Pragma("unroll") for (int i = 0; i < 4; ++i) { const int c = lane + 64 * i, row = c >> 3, c16 = c & 7; *(LAS u32x4*)(Kt + row * TP + c16 * 8) = kp[i]; *(LAS u32x4*)(Vt + row * TP + c16 * 8) = vp[i]; } } while (0)
        SB_LOAD(q0);
        for (int k0 = q0; k0 >= 0; k0 -= 32) {
            asm volatile("s_waitcnt lgkmcnt(0)" ::: "memory");
            SB_STORE();
            if (k0 >= 32) SB_LOAD(k0 - 32);
            asm volatile("s_waitcnt lgkmcnt(0)" ::: "memory");
            f32x16 p = {};
#pragma unroll
            for (int s_ = 0; s_ < 4; ++s_) p = MFMA32(frag_row(Kt, 0, 16 * s_, lane), qf[s_], p);
            f32x16 lk, z;
            const bool diag = (k0 == q0);
#pragma unroll
            for (int r = 0; r < 16; ++r) { z[r] = p[r] * 0.125f; const bool valid = !diag || crow(r, hi) < ql; const float az = fabsf(z[r]);
                const float sp = fmaxf(z[r], 0.f) + __logf(1.f + __expf(-az)); lk[r] = valid ? -sp : 0.f; }
            f32x16 lo_;
#pragma unroll
            for (int r = 0; r < 16; ++r) { const float hb = __uint_as_float(__float_as_uint(lk[r]) & 0xffff0000u); lo_[r] = lk[r] - hb; p[r] = hb; }
            f32x16 cs = {};
#pragma unroll
            for (int s_ = 0; s_ < 2; ++s_) { cs = MFMA32(uf[s_], acc_frag(p, s_), cs); cs = MFMA32(uf[s_], acc_frag(lo_, s_), cs); }
            const float tot = shl_(cs[0] + lk[0], ql);
            f32x16 w;
#pragma unroll
            for (int r = 0; r < 16; ++r) { const bool valid = !diag || crow(r, hi) < ql; w[r] = valid ? __expf(z[r] + lk[r] + cs[r] + carry) : 0.f; }
            carry += tot;
#pragma unroll
            for (int s_ = 0; s_ < 2; ++s_) { const bf16x8 wf = acc_frag(w, s_);
                o0 = MFMA32(frag_tr(Vt, 16 * s_, 16 * s_ + 8, 0, lane), wf, o0); o1 = MFMA32(frag_tr(Vt, 16 * s_, 16 * s_ + 8, 32, lane), wf, o1); }
            if (__all(carry < -104.f)) break;
        }
#undef SB_LOAD
#undef SB_STORE
        asm volatile("s_waitcnt lgkmcnt(0)" ::: "memory");
#pragma unroll
        for (int r = 0; r < 16; ++r) { Ot[ql * TP + crow(r, hi)] = f2bf(o0[r]); Ot[ql * TP + 32 + crow(r, hi)] = f2bf(o1[r]); }
        asm volatile("s_waitcnt lgkmcnt(0)" ::: "memory");
#pragma unroll
        for (int i = 0; i < 4; ++i) { const int c = lane + 64 * i, row = c >> 3, c16 = c & 7; *(u32x4*)(QO + (rb + q0 + row) * ldq + h * 64 + c16 * 8) = *(const LAS u32x4*)(Ot + row * TP + c16 * 8); }
    }
}

__device__ __forceinline__ float hg_lb(const float* lbl, int layer, int c) { if (layer == 0) return 0.f; const float a0 = lbl[c], a1 = lbl[256 + c]; return 1.f / (1.f + __expf(a0 - a1)); }
__device__ __forceinline__ float hg_logf(float z, float lb) {
    if (lb == 0.f) return -(fmaxf(-z, 0.f) + __logf(1.f + __expf(-fabsf(z))));
    return __logf(lb + (1.f - lb) * __builtin_amdgcn_rcpf(1.f + __expf(-z)));
}
__device__ __forceinline__ void hg_local(LAS unsigned char* lds, const bf16_t* __restrict__ F, const bf16_t* __restrict__ Iv, const float* lbl, int layer, float* __restrict__ st, float* __restrict__ dec,
                                         int gw, int ngw, int wave, int lane) {
    using namespace tile;
    LAS bf16_t* Zt = (LAS bf16_t*)(lds + wave * 16384); LAS bf16_t* Vt = Zt + 64 * TP;
    const int hi = lane >> 5, ql = lane & 31;
    for (int unit = gw; unit < 2048; unit += ngw) {
        const int chunk = unit & 127, h = (unit >> 7) & 3, b = unit >> 9; const size_t tok0 = (size_t)b * SEQ + chunk * 64;
        const float lb = hg_lb(lbl, layer, h * 64 + lane);
        float lf[64]; float bend = 0.f;
#pragma unroll
        for (int t = 0; t < 64; ++t) { lf[t] = hg_logf(bf2f(F[(tok0 + t) * 256 + h * 64 + lane]), lb); bend += lf[t]; }
        dec[unit * 64 + lane] = __expf(bend);
        asm volatile("s_waitcnt lgkmcnt(0)" ::: "memory");
        { float bb = 0.f;
#pragma unroll
          for (int t = 0; t < 64; ++t) { bb += lf[t]; Zt[t * TP + lane] = f2bf((1.f - __expf(lf[t])) * __expf(bend - bb)); } }
        f32x16 acc[2][2] = {};
#pragma unroll
        for (int half = 0; half < 2; ++half) {
            u32x4 vp[4];
#pragma unroll
            for (int i = 0; i < 4; ++i) { const int c = lane + 64 * i, row = c >> 3, c16 = c & 7; vp[i] = *(const u32x4*)(Iv + (tok0 + half * 32 + row) * 256 + h * 64 + c16 * 8); }
            asm volatile("s_waitcnt lgkmcnt(0)" ::: "memory");
#pragma unroll
            for (int i = 0; i < 4; ++i) { const int c = lane + 64 * i, row = c >> 3, c16 = c & 7; *(LAS u32x4*)(Vt + row * TP + c16 * 8) = vp[i]; }
            asm volatile("s_waitcnt lgkmcnt(0)" ::: "memory");
#pragma unroll
            for (int s2 = 0; s2 < 2; ++s2) { const int t0 = half * 32 + 16 * s2;
                const bf16x8 a0 = frag_tr_nat(Zt, t0, 0, lane), a1 = frag_tr_nat(Zt, t0, 32, lane), b0 = frag_tr_nat(Vt, 16 * s2, 0, lane), b1 = frag_tr_nat(Vt, 16 * s2, 32, lane);
                acc[0][0] = MFMA32(a0, b0, acc[0][0]); acc[0][1] = MFMA32(a0, b1, acc[0][1]); acc[1][0] = MFMA32(a1, b0, acc[1][0]); acc[1][1] = MFMA32(a1, b1, acc[1][1]); }
        }
        float* o = st + (size_t)unit * 4096;
#pragma unroll
        for (int kb = 0; kb < 2; ++kb)
#pragma unroll
            for (int vb = 0; vb < 2; ++vb)
#pragma unroll
                for (int r = 0; r < 16; ++r) o[(kb * 32 + crow(r, hi)) * 64 + vb * 32 + ql] = acc[kb][vb][r];
    }
}
__device__ __forceinline__ void hg_scan(float* st, const float* __restrict__ dec, int gtid, int nthr) {
    for (int e = gtid - 65536; e < 65536; e += nthr) { if (e < 0) continue;
        const int bh = e >> 12, kv = e & 4095, k = kv >> 6; float S = 0.f;
        for (int c0 = 0; c0 < 128; c0 += 16) { float lc[16], dc[16];
#pragma unroll
            for (int j = 0; j < 16; ++j) { lc[j] = st[(size_t)(bh * 128 + c0 + j) * 4096 + kv]; dc[j] = dec[(bh * 128 + c0 + j) * 64 + k]; }
#pragma unroll
            for (int j = 0; j < 16; ++j) { st[(size_t)(bh * 128 + c0 + j) * 4096 + kv] = S; S = dc[j] * S + lc[j]; } }
    }
}
__device__ __forceinline__ void hg_out(LAS unsigned char* lds, const bf16_t* __restrict__ F, const bf16_t* __restrict__ Iv, bf16_t* QY, int ldq, const bf16_t* __restrict__ Gt, const float* lbl, int layer,
                                       const float* __restrict__ og, const float* __restrict__ st, int gw, int ngw, int wave, int lane) {
    using namespace tile;
    LAS bf16_t* bA = (LAS bf16_t*)(lds + wave * 16384); LAS bf16_t* Z = bA + 32 * TP;
    const int hi = lane >> 5, ql = lane & 31;
    for (int unit = gw; unit < 4096; unit += ngw) {
        const int I = unit & 1, cu = unit >> 1, chunk = cu & 127, h = (cu >> 7) & 3, b = cu >> 9; const size_t tok0 = (size_t)b * SEQ + chunk * 64;
        const float lb = hg_lb(lbl, layer, h * 64 + lane);
        const float* S = st + (size_t)cu * 4096;
        {   u32x4 zq[12];
#pragma unroll
            for (int i = 0; i < 4; ++i) { const int c = lane + 64 * i, row = c >> 3, c16 = c & 7; zq[i] = *(const u32x4*)(F + (tok0 + row) * 256 + h * 64 + c16 * 8); zq[8 + i] = *(const u32x4*)(QY + (tok0 + 32 * I + row) * ldq + h * 64 + c16 * 8); }
            if (I) {
#pragma unroll
                for (int i = 0; i < 4; ++i) { const int c = lane + 64 * i, row = c >> 3, c16 = c & 7; zq[4 + i] = *(const u32x4*)(F + (tok0 + 32 + row) * 256 + h * 64 + c16 * 8); } }
            asm volatile("s_waitcnt lgkmcnt(0)" ::: "memory");
#pragma unroll
            for (int i = 0; i < 4; ++i) { const int c = lane + 64 * i, row = c >> 3, c16 = c & 7; *(LAS u32x4*)(Z + row * TP + c16 * 8) = zq[i]; *(LAS u32x4*)(bA + row * TP + c16 * 8) = zq[8 + i]; }
            if (I) {
#pragma unroll
                for (int i = 0; i < 4; ++i) { const int c = lane + 64 * i, row = c >> 3, c16 = c & 7; *(LAS u32x4*)(Z + (32 + row) * TP + c16 * 8) = zq[4 + i]; } }
        }
        asm volatile("s_waitcnt lgkmcnt(0)" ::: "memory");
        float bref = 0.f;
        if (I) { float lfp[32];
#pragma unroll
            for (int t = 0; t < 32; ++t) { lfp[t] = hg_logf(bf2f(Z[t * TP + lane]), lb); bref += lfp[t]; }
            float bb = 0.f;
#pragma unroll
            for (int t = 0; t < 32; ++t) { bb += lfp[t]; Z[t * TP + lane] = f2bf((1.f - __expf(lfp[t])) * __expf(bref - bb)); } }
        { LAS bf16_t* Zb = Z + 32 * I * TP; float bb = 0.f;
#pragma unroll
          for (int t = 0; t < 32; ++t) { const float lf = hg_logf(bf2f(Zb[t * TP + lane]), lb); bb += lf; const float eb = __expf(bb);
              bA[t * TP + lane] = f2bf(bf2f(bA[t * TP + lane]) * eb); Zb[t * TP + lane] = f2bf((1.f - __expf(lf)) * __expf(fminf(-bb, 80.f))); } }
        asm volatile("s_waitcnt lgkmcnt(0)" ::: "memory");
        bf16x8 qf[4];
#pragma unroll
        for (int s4 = 0; s4 < 4; ++s4) qf[s4] = frag_row(bA, 0, 16 * s4, lane);
        f32x16 o0 = {}, o1 = {};
        const float es = __expf(bref);
#pragma unroll
        for (int kh = 0; kh < 2; ++kh) {
            f32x4 sv[8];
#pragma unroll
            for (int i = 0; i < 8; ++i) { const int c = lane + 64 * i, row = c >> 4, c4 = c & 15; sv[i] = *(const f32x4*)(S + (32 * kh + row) * 64 + c4 * 4); }
            asm volatile("s_waitcnt lgkmcnt(0)" ::: "memory");
#pragma unroll
            for (int i = 0; i < 8; ++i) { const int c = lane + 64 * i, row = c >> 4, c4 = c & 15; const float sc = shl_(es, 32 * kh + row);
                u32x2 w; w.x = cvtpk(sv[i][0] * sc, sv[i][1] * sc); w.y = cvtpk(sv[i][2] * sc, sv[i][3] * sc); *(LAS u32x2*)(bA + row * TP + c4 * 4) = w; }
            asm volatile("s_waitcnt lgkmcnt(0)" ::: "memory");
#pragma unroll
            for (int s2 = 0; s2 < 2; ++s2) { const bf16x8 q_ = qf[2 * kh + s2]; o0 = MFMA32(frag_tr_nat(bA, 16 * s2, 0, lane), q_, o0); o1 = MFMA32(frag_tr_nat(bA, 16 * s2, 32, lane), q_, o1); }
        }
        for (int J = 0; J <= I; ++J) {
            u32x4 vp[4];
#pragma unroll
            for (int i = 0; i < 4; ++i) { const int c = lane + 64 * i, row = c >> 3, c16 = c & 7; vp[i] = *(const u32x4*)(Iv + (tok0 + 32 * J + row) * 256 + h * 64 + c16 * 8); }
            asm volatile("s_waitcnt lgkmcnt(0)" ::: "memory");
#pragma unroll
            for (int i = 0; i < 4; ++i) { const int c = lane + 64 * i, row = c >> 3, c16 = c & 7; *(LAS u32x4*)(bA + row * TP + c16 * 8) = vp[i]; }
            asm volatile("s_waitcnt lgkmcnt(0)" ::: "memory");
            f32x16 pt = {};
#pragma unroll
            for (int s4 = 0; s4 < 4; ++s4) pt = MFMA32(frag_row(Z, 32 * J, 16 * s4, lane), qf[s4], pt);
            if (J == I) {
#pragma unroll
                for (int r = 0; r < 16; ++r) pt[r] = crow(r, hi) <= ql ? pt[r] : 0.f; }
#pragma unroll
            for (int s2 = 0; s2 < 2; ++s2) { const bf16x8 pf = acc_frag(pt, s2); o0 = MFMA32(frag_tr(bA, 16 * s2, 16 * s2 + 8, 0, lane), pf, o0); o1 = MFMA32(frag_tr(bA, 16 * s2, 16 * s2 + 8, 32, lane), pf, o1); }
        }
        float ss = 0.f;
#pragma unroll
        for (int r = 0; r < 16; ++r) ss += o0[r] * o0[r] + o1[r] * o1[r];
        ss += shx(ss, 32, lane);
        const float rr = rsqrtf(ss * (1.f / 64.f) + RMS_EPS);
        u32x4 gv[4];
#pragma unroll
        for (int i = 0; i < 4; ++i) { const int c = lane + 64 * i, row = c >> 3, c16 = c & 7; gv[i] = *(const u32x4*)(Gt + (tok0 + 32 * I + row) * 256 + h * 64 + c16 * 8); }
        asm volatile("s_waitcnt lgkmcnt(0)" ::: "memory");
#pragma unroll
        for (int r = 0; r < 16; ++r) { bA[ql * TP + crow(r, hi)] = f2bf(o0[r] * rr); bA[ql * TP + 32 + crow(r, hi)] = f2bf(o1[r] * rr); }
        asm volatile("s_waitcnt lgkmcnt(0)" ::: "memory");
#pragma unroll
        for (int i = 0; i < 4; ++i) { const int c = lane + 64 * i, row = c >> 3, c16 = c & 7; const size_t tok = tok0 + 32 * I + row;
            const u32x4 ov = *(const LAS u32x4*)(bA + row * TP + c16 * 8); const unsigned ow[4] = {ov.x, ov.y, ov.z, ov.w}, gw_[4] = {gv[i].x, gv[i].y, gv[i].z, gv[i].w}; float y[8];
#pragma unroll
            for (int j = 0; j < 4; ++j) { const float g0 = __uint_as_float(gw_[j] << 16), g1 = __uint_as_float(gw_[j] & 0xffff0000u);
                y[2 * j] = __uint_as_float(ow[j] << 16) * og[c16 * 8 + 2 * j] * g0 * __builtin_amdgcn_rcpf(1.f + __expf(-g0)); y[2 * j + 1] = __uint_as_float(ow[j] & 0xffff0000u) * og[c16 * 8 + 2 * j + 1] * g1 * __builtin_amdgcn_rcpf(1.f + __expf(-g1)); }
            u32x4 w; w.x = cvtpk(y[0], y[1]); w.y = cvtpk(y[2], y[3]); w.z = cvtpk(y[4], y[5]); w.w = cvtpk(y[6], y[7]);
            *(u32x4*)(QY + tok * ldq + h * 64 + c16 * 8) = w; }
    }
}

#define XB_TMO      128
#define XB_XCNT(j)  (256  + 64 * (j))
#define XB_XSUB(j)  (1280 + 64 * (j))
#define XB_XGEN(j)  (2304 + 64 * (j))
#define XB_TOP      3328
#define XB_TOPGEN   3392
#define XCD_BAR_WORDS 3456
#define XB_SPIN_CAP (1u << 18)

__device__ __forceinline__ unsigned xb_ld(unsigned* p)              { return __hip_atomic_load(p, __ATOMIC_RELAXED, __HIP_MEMORY_SCOPE_AGENT); }
__device__ __forceinline__ unsigned xb_add(unsigned* p, unsigned v) { return __hip_atomic_fetch_add(p, v, __ATOMIC_RELAXED, __HIP_MEMORY_SCOPE_AGENT); }
__device__ __forceinline__ unsigned xb_xcc_id() { return (unsigned)__builtin_amdgcn_s_getreg((3 << 11) | 20) & 0xFu; }
#define XB_SPIN(cond, bar) do { unsigned _sp = 0; while (cond) { __builtin_amdgcn_s_sleep(1); \
    if ((++_sp & 255u) == 0u) { if (xb_ld(&(bar)[XB_TMO])) break; if (_sp > XB_SPIN_CAP) { atomicAdd(&(bar)[XB_TMO], 1u); break; } } } } while (0)

struct XcdBarrier {
    unsigned* bar; unsigned x;
    volatile LAS unsigned* st;
};

__device__ __forceinline__ XcdBarrier xcd_barrier_post(unsigned* bar, volatile LAS unsigned* st) {
    XcdBarrier b; b.bar = bar; b.x = xb_xcc_id(); b.st = st;
    if (threadIdx.x == 0) (void)xb_add(&bar[XB_XCNT(b.x)], 1u);
    return b;
}
__device__ __forceinline__ void xcd_barrier_complete(unsigned* bar, unsigned x, unsigned& nloc, unsigned& nx) {
    const unsigned G = gridDim.x * gridDim.y * gridDim.z;
    unsigned sum, cnt, mine, sp = 0u;
    for (;;) {
        sum = 0u; cnt = 0u; mine = 0u;
#pragma unroll
        for (unsigned j = 0; j < 16; ++j) { const unsigned c = xb_ld(&bar[XB_XCNT(j)]); sum += c; cnt += (c > 0u) ? 1u : 0u; mine = (j == x) ? c : mine; }
        if (sum == G) break;
        __builtin_amdgcn_s_sleep(1);
        if ((++sp & 255u) == 0u) { if (xb_ld(&bar[XB_TMO])) break; if (sp > XB_SPIN_CAP) { atomicAdd(&bar[XB_TMO], 1u); break; } }
    }
    nloc = mine > 0u ? mine : 1u; nx = cnt > 0u ? cnt : 1u;
}

__device__ __forceinline__ void xcd_barrier(const XcdBarrier& b_) {
    XcdBarrier b = b_; { GAS unsigned* bg_ = (GAS unsigned*)b.bar; asm volatile("" : "+s"(bg_), "+s"(b.x)); b.bar = (unsigned*)bg_; }
    asm volatile("s_waitcnt vmcnt(0)" ::: "memory");
    __syncthreads();
    if (threadIdx.x == 0) {
        unsigned* bar = b.bar;
        __builtin_amdgcn_s_waitcnt(0);
        unsigned nloc = b.st[0], nx = b.st[1];
        if (nloc == 0u) { xcd_barrier_complete(bar, b.x, nloc, nx); b.st[0] = nloc; b.st[1] = nx; }
        const unsigned old = xb_add(&bar[XB_XSUB(b.x)], 1u);
        const unsigned gen = old / nloc;
        if (old + 1u == (gen + 1u) * nloc) {
            __builtin_amdgcn_fence(__ATOMIC_RELEASE, "agent");
            asm volatile("s_waitcnt vmcnt(0)" ::: "memory");
            const unsigned og = xb_add(&bar[XB_TOP], 1u);
            const unsigned tg = og / nx;
            if (og + 1u == (tg + 1u) * nx) xb_add(&bar[XB_TOPGEN], 1u);
            else XB_SPIN(xb_ld(&bar[XB_TOPGEN]) == tg, bar);
            __builtin_amdgcn_fence(__ATOMIC_ACQUIRE, "agent");
            xb_add(&bar[XB_XGEN(b.x)], 1u);
            asm volatile("s_waitcnt vmcnt(0)" ::: "memory");
        } else {
            XB_SPIN(xb_ld(&bar[XB_XGEN(b.x)]) == gen, bar);
            __builtin_amdgcn_fence(__ATOMIC_ACQUIRE, "agent");
            asm volatile("s_waitcnt vmcnt(0)" ::: "memory");
        }
    }
    __syncthreads();
}

#define LDS_WAIT() asm volatile("s_waitcnt lgkmcnt(0)" ::: "memory")
constexpr int NWAVES_ = 8;
__device__ __forceinline__ void tr_item(const float* __restrict__ W, int N, int k0, int n0, bf16_t* dst, int ldo, LAS float* scr, int lane, int rs = 1) {
#pragma unroll 8
    for (int i = 0; i < 32; ++i) { const int kk = 2 * i + (lane >> 5); scr[kk * 33 + (lane & 31)] = W[(size_t)(k0 + kk) * N + n0 + (lane & 31)]; }
    LDS_WAIT(); asm volatile("" ::: "memory");
    const int c = lane & 7;
#pragma unroll
    for (int j = 0; j < 4; ++j) { const int n = (lane >> 3) + 8 * j; const LAS float* s = scr + (8 * c) * 33 + n;
        u32x4 o; o.x = pk2(s[0 * 33], s[1 * 33]); o.y = pk2(s[2 * 33], s[3 * 33]); o.z = pk2(s[4 * 33], s[5 * 33]); o.w = pk2(s[6 * 33], s[7 * 33]);
        *(u32x4*)(dst + (size_t)n * rs * ldo + 8 * c) = o; }
    LDS_WAIT(); asm volatile("" ::: "memory");
}
struct LayerIn {
    const float *norm_mix, *w_in, *qg, *kg, *lq1, *lk1, *lq2, *lk2, *subln, *hg_lb, *hg_og, *s5_lre, *s5_lim, *s5_lstep, *s5_bre, *s5_bim, *s5_cre, *s5_cim, *s5_d, *glu_w, *glu_b,
                *pa, *pb, *pc, *pd, *w_out, *norm_ffn, *rgw, *rgb, *rew, *reb, *eg, *eu, *ed;
};
__device__ __forceinline__ void ph_weights(const CAS char* ka, int l, unsigned char* wts, LAS unsigned char* lds, int gw, int ngw, int wave, int lane) {
    LAS float* scr = (LAS float*)(lds + wave * 16384);
#define KIN(i) ((const float*)(*(const GAS float* const CAS*)(ka + 8 * (i))))
    const float* w_in = KIN(3) + (size_t)l * DM * IN_COLS; const float* pa = KIN(23) + (size_t)l * 512 * DM; const float* w_out = KIN(27) + (size_t)l * DM * DM; const float* glu_w = KIN(21) + (size_t)l * 65536;
    constexpr int I_IN = 16 * 240, I_PA = 8 * 32, I_PB = 4 * 32, I_OUT = 16 * 32, I_GLU = 4 * 8, I_EG = 16 * 16 * 12, I_ED = 16 * 6 * 32;
    constexpr int NITEMS = I_IN + I_PA + 3 * I_PB + I_OUT + I_GLU + 2 * I_EG;
    for (int it = gw; it < NITEMS; it += ngw) {
        int r = it;
        if (r < I_IN) { const int kb = r / 240, nb = r % 240, n0 = nb * 32;
            if (n0 < NMIX) tr_item(w_in, IN_COLS, kb * 64, n0, (bf16_t*)(wts + WT_IN) + (size_t)n0 * DM + kb * 64, DM, scr, lane);
            else { const int br = (n0 - NMIX) >> 10, c = (n0 - NMIX) & 1023; tr_item(w_in, IN_COLS, kb * 64, n0, (bf16_t*)(wts + WT_IN) + (size_t)(NMIX + 4 * c + br) * DM + kb * 64, DM, scr, lane, 4); }
            continue; } r -= I_IN;
        if (r < I_PA) { const int kb = r / 32, nb = r % 32; tr_item(pa, DM, kb * 64, nb * 32, (bf16_t*)(wts + WT_P) + (size_t)nb * 32 * YC_LD + kb * 64, YC_LD, scr, lane); continue; } r -= I_PA;
        if (r < 3 * I_PB) { const int w = r / I_PB, q = r % I_PB, kb = q / 32, nb = q % 32; const float* src = KIN(24 + w) + (size_t)l * 256 * DM;
            tr_item(src, DM, kb * 64, nb * 32, (bf16_t*)(wts + WT_P) + (size_t)nb * 32 * YC_LD + 512 + 256 * w + kb * 64, YC_LD, scr, lane); continue; } r -= 3 * I_PB;
        if (r < I_OUT) { const int kb = r / 32, nb = r % 32; tr_item(w_out, DM, kb * 64, nb * 32, (bf16_t*)(wts + WT_OUT) + (size_t)nb * 32 * DM + kb * 64, DM, scr, lane); continue; } r -= I_OUT;
        if (r < I_GLU) { const int kb = r / 8, nb = r % 8; tr_item(glu_w, 256, kb * 64, nb * 32, (bf16_t*)(wts + WT_GLU) + (size_t)nb * 32 * 256 + kb * 64, 256, scr, lane); continue; } r -= I_GLU;
        if (r < 2 * I_EG) { const int up = r / I_EG, q = r % I_EG, e = q / 192, q2 = q % 192, kb = q2 / 12, nb = q2 % 12, n0 = nb * 32;
            const float* src = KIN(33 + up) + ((size_t)l * NEXP + e) * DM * DEXP;
            tr_item(src, DEXP, kb * 64, n0, (bf16_t*)(wts + WT_E1) + (size_t)(e * 768 + (n0 >> 7) * 256 + up * 128 + (n0 & 127)) * DM + kb * 64, DM, scr, lane); continue; }
    }
}
__device__ __forceinline__ void ph_s5_tables(const float* lre, const float* lim, const float* lstep, const float* bre, const float* bim, float* apow, float* bb, int gtid, int nthr) {
    for (int i = gtid; i < 1024; i += nthr) { const int g = i >> 6;
        const float lr = fminf(lre[i], -1e-4f), li = lim[i], st = __expf(lstep[g]);
        const float mag = __expf(lr * st), ph = li * st; const float rv = ph * 0.15915494309189535f, fr_ = rv - floorf(rv), sn = __sinf(fr_ * 6.283185307179586f), cs = __cosf(fr_ * 6.283185307179586f);
        const float ar = mag * cs, ai = mag * sn;
        const float den = lr * lr + li * li, nr = ar - 1.f, gr = (nr * lr + ai * li) / den, gi = (ai * lr - nr * li) / den;
        float pr = 1.f, pi = 0.f;
        for (int p = 0; p <= 32; ++p) { apow[(i * 33 + p) * 2] = pr; apow[(i * 33 + p) * 2 + 1] = pi; const float t = pr * ar - pi * ai; pi = pr * ai + pi * ar; pr = t; }
        for (int c = 0; c < 16; ++c) { const float br = bre[i * 16 + c], bi = bim[i * 16 + c]; bb[(i * 16 + c) * 2] = gr * br - gi * bi; bb[(i * 16 + c) * 2 + 1] = gr * bi + gi * br; }
    }
}
__device__ __forceinline__ void ph_s5_mats(const float* __restrict__ apow, const float* __restrict__ bb, const float* __restrict__ cre, const float* __restrict__ cim, bf16_t* m1t, bf16_t* m2t, bf16_t* ktab, int gtid, int nthr) {
    for (int it = gtid; it < 16 * 256 * 64; it += nthr) { const int cg = it & 63, r = (it >> 6) & 255, g = it >> 14; float v[8];
        if (r < 128) { const int n = r & 63, im = r >> 6, s_ = cg >> 1, c0 = (cg & 1) * 8; const int gi = g * 64 + n; const float pr = apow[(gi * 33 + 31 - s_) * 2], pi = apow[(gi * 33 + 31 - s_) * 2 + 1];
#pragma unroll
            for (int j = 0; j < 8; ++j) { const float br = bb[(gi * 16 + c0 + j) * 2], bi = bb[(gi * 16 + c0 + j) * 2 + 1]; v[j] = im ? pr * bi + pi * br : pr * br - pi * bi; } }
        else {
#pragma unroll
            for (int j = 0; j < 8; ++j) v[j] = 0.f; }
        u32x4 w; w.x = pk2(v[0], v[1]); w.y = pk2(v[2], v[3]); w.z = pk2(v[4], v[5]); w.w = pk2(v[6], v[7]);
        *(u32x4*)(m1t + ((size_t)(g * 256 + r) * 512 + cg * 8)) = w; }
    for (int it = gtid; it < 16 * 32 * 16 * 2; it += nthr) { const int c0 = (it & 1) * 8, c = (it >> 1) & 15, tau = (it >> 5) & 31, g = it >> 10; float v[8];
#pragma unroll
        for (int j = 0; j < 8; ++j) v[j] = 0.f;
        for (int n = 0; n < 64; ++n) { const int gi = g * 64 + n; const float pr = apow[(gi * 33 + tau) * 2], pi = apow[(gi * 33 + tau) * 2 + 1], cr = cre[(g * 16 + c) * 64 + n], ci = cim[(g * 16 + c) * 64 + n];
            const float wr_ = cr * pr - ci * pi, wi_ = cr * pi + ci * pr;
#pragma unroll
            for (int j = 0; j < 8; ++j) v[j] += wr_ * bb[(gi * 16 + c0 + j) * 2] - wi_ * bb[(gi * 16 + c0 + j) * 2 + 1]; }
        u32x4 w; w.x = pk2(v[0], v[1]); w.y = pk2(v[2], v[3]); w.z = pk2(v[4], v[5]); w.w = pk2(v[6], v[7]);
        *(u32x4*)(ktab + ((size_t)((g * 32 + tau) * 16 + c) * 16 + c0)) = w; }
    for (int it = gtid; it < 16 * 512 * 16; it += nthr) { const int cg = it & 15, r = (it >> 4) & 511, g = it >> 13, t = r >> 4, c = r & 15, nn0 = cg * 8; float v[8];
#pragma unroll
        for (int j = 0; j < 8; ++j) { const int nn = nn0 + j, n = nn & 63, gi = g * 64 + n; const float pr = apow[(gi * 33 + t + 1) * 2], pi = apow[(gi * 33 + t + 1) * 2 + 1], cr = cre[(g * 16 + c) * 64 + n], ci = cim[(g * 16 + c) * 64 + n];
            v[j] = nn < 64 ? cr * pr - ci * pi : -(cr * pi + ci * pr); }
        u32x4 w; w.x = pk2(v[0], v[1]); w.y = pk2(v[2], v[3]); w.z = pk2(v[4], v[5]); w.w = pk2(v[6], v[7]);
        *(u32x4*)(m2t + ((size_t)(g * 512 + r) * S5_LD + 512 + cg * 8)) = w; }
}
__device__ __forceinline__ void ph_s5_expand(const bf16_t* __restrict__ ktab, bf16_t* m2t, int gtid, int nthr) {
    for (int it = gtid; it < 16 * 512 * 64; it += nthr) { const int cg = it & 63, r = (it >> 6) & 511, g = it >> 15, t = r >> 4, c = r & 15, s_ = cg >> 1, c0 = (cg & 1) * 8;
        u32x4 w = {0u, 0u, 0u, 0u}; if (s_ <= t) w = *(const u32x4*)(ktab + ((size_t)((g * 32 + t - s_) * 16 + c) * 16 + c0));
        *(u32x4*)(m2t + ((size_t)(g * 512 + r) * S5_LD + cg * 8)) = w; }
}
__device__ __forceinline__ void ph_s5_scan(const float* __restrict__ apow, const float* __restrict__ xloc, bf16_t* s5u, int gtid, int nthr) {
    for (int i = gtid; i < 4096; i += nthr) { const int n = i & 63, g = (i >> 6) & 15, b = i >> 10; const int gi = g * 64 + n;
        const float ar = apow[(gi * 33 + 32) * 2], ai = apow[(gi * 33 + 32) * 2 + 1]; float xr = 0.f, xi = 0.f;
        for (int k0 = 0; k0 < 256; k0 += 32) { float lr[32], li[32];
#pragma unroll
            for (int j = 0; j < 32; ++j) { const size_t row = (size_t)g * 1024 + b * 256 + k0 + j; lr[j] = xloc[row * 128 + n]; li[j] = xloc[row * 128 + 64 + n]; }
#pragma unroll
            for (int j = 0; j < 32; ++j) { const size_t row = (size_t)g * 1024 + b * 256 + k0 + j; s5u[row * S5_LD + 512 + n] = f2bf(xr); s5u[row * S5_LD + 576 + n] = f2bf(xi);
                const float t = ar * xr - ai * xi + lr[j]; xi = ar * xi + ai * xr + li[j]; xr = t; } }
    }
}
__device__ __forceinline__ void ph_pair_weights(const float* __restrict__ ed  , bf16_t* wp, LAS unsigned char* lds, int gw, int ngw, int wave, int lane) {
    LAS float* scr = (LAS float*)(lds + wave * 16384);
    for (int it = gw; it < NBUCKET * 2 * 6 * 32; it += ngw) { const int nb = it & 31, kb = (it >> 5) % 6, sel = (it / 192) & 1, p_ = it / 384; int e0, e1; pg8::pair_experts(p_, e0, e1); const int e = sel ? e1 : e0;
        tr_item(ed + (size_t)e * DEXP * DM, DM, kb * 64, nb * 32, wp + ((size_t)p_ * 1024 + nb * 32) * 768 + sel * DEXP + kb * 64, 768, scr, lane); }
    asm volatile("s_waitcnt lgkmcnt(0)" ::: "memory"); __syncthreads();
}
__device__ __forceinline__ void ph_rmsnorm(const float* __restrict__ x, const float* __restrict__ gain, bf16_t* __restrict__ out, int gw, int ngw, int lane) {
    for (int m = gw; m < NTOK; m += ngw) {
        const f32x4* xr = (const f32x4*)(x + (size_t)m * DM) + lane;
        f32x4 v[4]; float s = 0.f;
#pragma unroll
        for (int j = 0; j < 4; ++j) { v[j] = xr[64 * j]; s += (v[j].x * v[j].x + v[j].y * v[j].y) + (v[j].z * v[j].z + v[j].w * v[j].w); }
        const float r = rsqrtf(wave_sum(s, lane) * (1.f / DM) + RMS_EPS);
        u32x2* o = (u32x2*)(out + (size_t)m * DM) + lane;
#pragma unroll
        for (int j = 0; j < 4; ++j) { const f32x4 g = ((const f32x4*)gain)[64 * j + lane]; u32x2 w; w.x = pk2(v[j].x * r * g.x, v[j].y * r * g.y); w.y = pk2(v[j].z * r * g.z, v[j].w * r * g.w); o[64 * j] = w; }
    }
}
__device__ __forceinline__ void fix_row(bf16_t* row, const float* gain, const float* cs, const float* sn, float scale, int lane) {
    u32x4 raw = *(const u32x4*)(row + lane * 8);
    float v[8];
    v[0] = __uint_as_float(raw.x << 16); v[1] = __uint_as_float(raw.x & 0xffff0000u); v[2] = __uint_as_float(raw.y << 16); v[3] = __uint_as_float(raw.y & 0xffff0000u);
    v[4] = __uint_as_float(raw.z << 16); v[5] = __uint_as_float(raw.z & 0xffff0000u); v[6] = __uint_as_float(raw.w << 16); v[7] = __uint_as_float(raw.w & 0xffff0000u);
    float ss = 0.f;
#pragma unroll
    for (int i = 0; i < 8; ++i) ss += v[i] * v[i];
    ss += shx(ss, 1, lane); ss += shx(ss, 2, lane); ss += shx(ss, 4, lane);
    const float r = rsqrtf(ss * (1.f / 64.f) + RMS_EPS);
    const int sub = lane & 7;
#pragma unroll
    for (int i = 0; i < 8; ++i) v[i] = v[i] * r * gain[sub * 8 + i];
    float o[8];
#pragma unroll
    for (int i = 0; i < 8; ++i) {
        const float p = shx(v[i], 1, lane);
        float res = v[i];
        if (sub == 0) res = v[i] * cs[i] - p * sn[i];
        else if (sub == 1) res = v[i] * cs[i] + p * sn[i];
        o[i] = res * scale;
    }
    u32x4 w; w.x = pk2(o[0], o[1]); w.y = pk2(o[2], o[3]); w.z = pk2(o[4], o[5]); w.w = pk2(o[6], o[7]);
    *(u32x4*)(row + lane * 8) = w;
}
__device__ __forceinline__ void ph_fixup(bf16_t* Q, int ldq, bf16_t* K, const int* __restrict__ pos, const float* __restrict__ qg, const float* __restrict__ kg, int gw, int ngw, int lane) {
    for (int m = gw; m < NTOK; m += ngw) {
        const double p = (double)pos[m];
        float cs[8], sn[8];
#pragma unroll
        for (int i = 0; i < 8; ++i) {
            constexpr double RF[8] = {0.15915494309189535, 0.03086376340470123, 0.005985185712713705, 0.001160663641240061, 0.00022507907903927653, 4.364795279280289e-05, 8.464330808241401e-06, 1.6414262627950345e-06};
            double rv = p * RF[i];
            rv -= floor(rv);
            const float a = (float)rv * 6.283185307179586f;
            cs[i] = __cosf(a); sn[i] = __sinf(a);
        }
        fix_row(Q + (size_t)m * ldq, qg, cs, sn, QSCALE, lane);
        fix_row(K + (size_t)m * 512, kg, cs, sn, 1.f, lane);
    }
}
__device__ __forceinline__ void ph_combine(const bf16_t* __restrict__ O, bf16_t* __restrict__ YA, int ldy, const float* lq1, const float* lk1, const float* lq2, const float* lk2,
                                           const float* __restrict__ sg, float lambda_init, int gw, int ngw, int lane) {
    const float lam = __expf(wave_sum(lq1[lane] * lk1[lane], lane)) - __expf(wave_sum(lq2[lane] * lk2[lane], lane)) + lambda_init;
    const int h = lane >> 4, dv0 = (lane & 15) * 8;
    for (int m0 = gw * 4; m0 < NTOK; m0 += ngw * 4) {
      u32x4 aa[4], bb_[4];
#pragma unroll
      for (int u = 0; u < 4; ++u) { aa[u] = *(const u32x4*)(O + (size_t)(m0 + u) * 1024 + h * 256 + dv0); bb_[u] = *(const u32x4*)(O + (size_t)(m0 + u) * 1024 + h * 256 + 128 + dv0); }
#pragma unroll
      for (int u = 0; u < 4; ++u) { const int m = m0 + u; const u32x4 a = aa[u], b = bb_[u];
        float d[8]; const unsigned aw[4] = {a.x, a.y, a.z, a.w}, bw[4] = {b.x, b.y, b.z, b.w};
#pragma unroll
        for (int i = 0; i < 4; ++i) { d[2 * i] = __uint_as_float(aw[i] << 16) - lam * __uint_as_float(bw[i] << 16); d[2 * i + 1] = __uint_as_float(aw[i] & 0xffff0000u) - lam * __uint_as_float(bw[i] & 0xffff0000u); }
        float ss = 0.f;
#pragma unroll
        for (int i = 0; i < 8; ++i) ss += d[i] * d[i];
        ss += shx(ss, 1, lane); ss += shx(ss, 2, lane); ss += shx(ss, 4, lane); ss += shx(ss, 8, lane);
        const float r = rsqrtf(ss * (1.f / 128.f) + RMS_EPS) * (1.f - lambda_init);
        u32x4 w; w.x = pk2(d[0] * r * sg[dv0], d[1] * r * sg[dv0 + 1]); w.y = pk2(d[2] * r * sg[dv0 + 2], d[3] * r * sg[dv0 + 3]);
        w.z = pk2(d[4] * r * sg[dv0 + 4], d[5] * r * sg[dv0 + 5]); w.w = pk2(d[6] * r * sg[dv0 + 6], d[7] * r * sg[dv0 + 7]);
        *(u32x4*)(YA + (size_t)m * ldy + h * 128 + dv0) = w;
      }
    }
}
__device__ __forceinline__ void ph_router(LAS unsigned char* lds, const float* __restrict__ x1, const float* __restrict__ gain, const float* __restrict__ wg, const float* __restrict__ bg,
                                          const float* __restrict__ we, const float* __restrict__ be, bf16_t* __restrict__ xn2, int* bucket, int* rank, float* tw, unsigned* cnt, int gw, int ngw, int lane) {
    LAS float* Wt = (LAS float*)lds; LAS unsigned* lcnt = (LAS unsigned*)(lds + 20 * 4096); LAS unsigned* lbase = lcnt + 32;
    if ((gw & 7) * 64 + lane < 32) lcnt[(gw & 7) * 64 + lane] = 0u;
    { const int t = (gw & 7) * 64 + lane;
      f32x4 a[2], b[8];
#pragma unroll
      for (int i = 0; i < 2; ++i) a[i] = ((const f32x4*)wg)[t + 512 * i];
#pragma unroll
      for (int i = 0; i < 8; ++i) b[i] = ((const f32x4*)we)[t + 512 * i];
#pragma unroll
      for (int i = 0; i < 2; ++i) { const int e = t + 512 * i; Wt[e] = a[i].x; Wt[1024 + e] = a[i].y; Wt[2048 + e] = a[i].z; Wt[3072 + e] = a[i].w; }
#pragma unroll
      for (int i = 0; i < 8; ++i) { const int x = t + 512 * i, e = x >> 2, q = x & 3; Wt[(4 + 4 * q) * 1024 + e] = b[i].x; Wt[(5 + 4 * q) * 1024 + e] = b[i].y; Wt[(6 + 4 * q) * 1024 + e] = b[i].z; Wt[(7 + 4 * q) * 1024 + e] = b[i].w; } }
    __syncthreads();
    for (int m0 = gw * 2; m0 < NTOK; m0 += ngw * 2) {
        f32x4 v[2][4]; float r[2];
#pragma unroll
        for (int tk = 0; tk < 2; ++tk) { const f32x4* xr = (const f32x4*)(x1 + (size_t)(m0 + tk) * DM) + lane; float s = 0.f;
#pragma unroll
            for (int j = 0; j < 4; ++j) { v[tk][j] = xr[64 * j]; s += (v[tk][j].x * v[tk][j].x + v[tk][j].y * v[tk][j].y) + (v[tk][j].z * v[tk][j].z + v[tk][j].w * v[tk][j].w); }
            r[tk] = s; }
#pragma unroll
        for (int tk = 0; tk < 2; ++tk) r[tk] = rsqrtf(wave_sum_dpp(r[tk]) * (1.f / DM) + RMS_EPS);
#pragma unroll
        for (int j = 0; j < 4; ++j) { const f32x4 g = ((const f32x4*)gain)[64 * j + lane];
#pragma unroll
            for (int tk = 0; tk < 2; ++tk) { v[tk][j] = v[tk][j] * r[tk] * g; u32x2 w; w.x = pk2(v[tk][j].x, v[tk][j].y); w.y = pk2(v[tk][j].z, v[tk][j].w); ((u32x2*)(xn2 + (size_t)(m0 + tk) * DM) + lane)[64 * j] = w; } }
        float lg[2][20];
#pragma unroll
        for (int c = 0; c < 20; ++c) {
            float a0 = 0.f, a1 = 0.f;
#pragma unroll
            for (int j = 0; j < 4; ++j) { const f32x4 w = *(const LAS f32x4*)(Wt + c * 1024 + 256 * j + 4 * lane);
                a0 += (v[0][j].x * w.x + v[0][j].y * w.y) + (v[0][j].z * w.z + v[0][j].w * w.w); a1 += (v[1][j].x * w.x + v[1][j].y * w.y) + (v[1][j].z * w.z + v[1][j].w * w.w); }
            lg[0][c] = wave_sum_dpp(a0); lg[1][c] = wave_sum_dpp(a1);
            if ((c & 3) == 3) asm volatile("" ::: "memory");
        }
#pragma unroll
        for (int tk = 0; tk < 2; ++tk) {
            float gl[4]; int gi = 0;
#pragma unroll
            for (int c = 0; c < 4; ++c) gl[c] = lg[tk][c] + bg[c];
            float gm = gl[0];
#pragma unroll
            for (int c = 1; c < 4; ++c) if (gl[c] > gm) { gm = gl[c]; gi = c; }
            float gs = 0.f;
#pragma unroll
            for (int c = 0; c < 4; ++c) gs += __expf(gl[c] - gm);
            const float gval = 1.f / gs;
            float el[4];
#pragma unroll
            for (int c = 0; c < 4; ++c) { float t = lg[tk][4 + c] + be[c]; t = (gi == 1) ? lg[tk][8 + c] + be[4 + c] : t; t = (gi == 2) ? lg[tk][12 + c] + be[8 + c] : t; t = (gi == 3) ? lg[tk][16 + c] + be[12 + c] : t; el[c] = t; }
            int i0 = 0; float m0_ = el[0];
#pragma unroll
            for (int c = 1; c < 4; ++c) if (el[c] > m0_) { m0_ = el[c]; i0 = c; }
            int i1 = -1; float m1 = -INFINITY;
#pragma unroll
            for (int c = 0; c < 4; ++c) if (c != i0 && el[c] > m1) { m1 = el[c]; i1 = c; }
            const float p1 = __expf(m1 - m0_), w0 = gval / (1.f + p1), w1 = gval * p1 / (1.f + p1);
            const int lo = i0 < i1 ? i0 : i1, hi = i0 < i1 ? i1 : i0; const float wlo = i0 < i1 ? w0 : w1, whi = i0 < i1 ? w1 : w0;
            const int pair = (lo == 0) ? hi - 1 : (lo == 1 ? hi + 1 : 5);
            const int b = gi * 6 + pair, m = m0 + tk;
            if (lane == 0) { bucket[m] = b; tw[2 * m] = wlo; tw[2 * m + 1] = whi; rank[m] = (int)__hip_atomic_fetch_add(lcnt + b, 1u, __ATOMIC_RELAXED, __HIP_MEMORY_SCOPE_WORKGROUP); }
        }
    }
    asm volatile("s_waitcnt vmcnt(0) lgkmcnt(0)" ::: "memory"); __syncthreads();
    { const int t = (gw & 7) * 64 + lane; if (t < NBUCKET) lbase[t] = __hip_atomic_fetch_add(cnt + 64 * t, lcnt[t], __ATOMIC_RELAXED, __HIP_MEMORY_SCOPE_AGENT); }
    __syncthreads();
    for (int m0 = gw * 2; m0 < NTOK; m0 += ngw * 2) if (lane < 2) { const int m = m0 + lane; rank[m] += (int)lbase[bucket[m]]; }
}
__device__ __forceinline__ void ph_sort(const bf16_t* __restrict__ xn2, const int* __restrict__ bucket, const int* __restrict__ rank, const float* __restrict__ tw, const unsigned* __restrict__ cnt,
                                        bf16_t* __restrict__ xs, int* slot_tok, float* slot_w, int gw, int ngw, int lane) {
    int mybase = 0, mycnt = 0;
    { int run = 0; for (int b = 0; b < NBUCKET; ++b) { const int cb = (int)cnt[64 * b]; if (lane == b) { mybase = run; mycnt = cb; } run += (cb + 255) & ~255; } }
    for (int m0 = gw * 4; m0 < NTOK; m0 += ngw * 4) {
        int bk[4], rk_[4]; float w0[4], w1[4]; u32x4 ra[4], rb[4];
#pragma unroll
        for (int u = 0; u < 4; ++u) { bk[u] = bucket[m0 + u]; rk_[u] = rank[m0 + u]; w0[u] = tw[2 * (m0 + u)]; w1[u] = tw[2 * (m0 + u) + 1];
            const u32x4* s = (const u32x4*)(xn2 + (size_t)(m0 + u) * DM) + lane; ra[u] = s[0]; rb[u] = s[64]; }
#pragma unroll
        for (int u = 0; u < 4; ++u) { const int slot = shl_i(mybase, bk[u]) + rk_[u]; u32x4* d = (u32x4*)(xs + (size_t)slot * DM) + lane; d[0] = ra[u]; d[64] = rb[u];
            if (lane == 0) { slot_tok[slot] = m0 + u; slot_w[2 * slot] = w0[u]; slot_w[2 * slot + 1] = w1[u]; } }
    }
    if (gw < NBUCKET) { const int b = gw, bs = shl_i(mybase, b), cb = shl_i(mycnt, b), pe = (cb + 255) & ~255;
        float z = 0.f; asm volatile("" : "+v"(z));
        for (int s = cb + lane; s < pe; s += 64) { slot_tok[bs + s] = -1; slot_w[2 * (bs + s)] = z; slot_w[2 * (bs + s) + 1] = z; } }
}

constexpr int NWAVES = 8, RING_BYTES = 131072, MISC_OFF = RING_BYTES + 320, LDS_BYTES = 147456;
constexpr int PH_PER_LAYER = 14;
enum { PH_WTS = 0, PH_NORM, PH_GEMM_IN, PH_FIX, PH_SCAN, PH_MIX, PH_POST, PH_GATE, PH_BRANCH, PH_OUT, PH_ROUTE, PH_SORT, PH_MOE1, PH_MOE2 };
struct Args { const float* in[36]; float* out; unsigned char* ws; int ph_lo, ph_hi, li, pad; };
__device__ __forceinline__ bool inph(int lo, int hi, int k) { asm volatile("" : "+s"(lo), "+s"(hi)); return lo <= k && k < hi; }
__global__ void __launch_bounds__(NWAVES * 64, 2) fwd(Args args) {
    extern __shared__ __attribute__((aligned(16))) unsigned char lds_raw[];
    LAS unsigned char* lds = (LAS unsigned char*)lds_raw;
    volatile LAS unsigned* MISC = (volatile LAS unsigned*)(lds + MISC_OFF);
    const int tid = threadIdx.x, lane = tid & 63, wave = __builtin_amdgcn_readfirstlane(tid >> 6), G = gridDim.x;
    const int gw = blockIdx.x * NWAVES + wave, ngw = G * NWAVES;
    unsigned char* ws = args.ws; unsigned* ctl = (unsigned*)(ws + WS_CTL);
    for (int u = tid; u < (LDS_BYTES - RING_BYTES) / 4; u += NWAVES * 64) ((LAS unsigned*)(lds + RING_BYTES))[u] = 0u;
    __syncthreads();
    XcdBarrier bar = xcd_barrier_post(ctl + CW_BAR + args.li * XCD_BAR_WORDS, MISC + 8);
    const int lo = args.ph_lo, hi = args.ph_hi;
#define IN_(k) inph(lo, hi, (k))
#define SEAM(k) do { if (IN_(k) && IN_((k) + 1)) xcd_barrier(bar); } while (0)
#define PH_BEGIN GAS unsigned char* W = (GAS unsigned char*)ws; asm volatile("" : "+s"(W)); GAS float* OUTP_ = (GAS float*)args.out; asm volatile("" : "+s"(OUTP_)); float* OUTP = (float*)OUTP_; int LN = threadIdx.x; asm volatile("" : "+v"(LN)); LN &= 63; int GG = gridDim.x; asm volatile("" : "+s"(GG)); int BX = blockIdx.x; asm volatile("" : "+s"(BX)); const int NGW_ = GG * NWAVES; int GW = BX * NWAVES + __builtin_amdgcn_readfirstlane(threadIdx.x >> 6); asm volatile("" : "+s"(GW));
#define INP(i) ({ const CAS char* ka_ = (const CAS char*)__builtin_amdgcn_kernarg_segment_ptr(); asm volatile("" : "+s"(ka_)); (const float*)(*(const GAS float* const CAS*)(ka_ + 8 * (i))); })
    for (int l = 0; l < DEPTH; ++l) {
        const int p0 = l * PH_PER_LAYER;
        if (IN_(p0 + PH_WTS)) { PH_BEGIN; ph_weights(({ const CAS char* ka_ = (const CAS char*)__builtin_amdgcn_kernarg_segment_ptr(); asm volatile("" : "+s"(ka_)); ka_; }), l, (unsigned char*)(W + WS_WTS), lds, GW, NGW_, GW & 7, LN);
            ph_s5_tables(INP(13) + l * 1024, INP(14) + l * 1024, INP(15) + l * 16, INP(16) + l * 16384, INP(17) + l * 16384, (float*)(W + WS_WTS + WT_APOW), (float*)(W + WS_WTS + WT_BB), GW * 64 + LN, NGW_ * 64); }
        SEAM(p0 + PH_WTS);
        if (IN_(p0 + PH_NORM)) { PH_BEGIN; const float* xin = l == 0 ? INP(0) : OUTP; ph_rmsnorm(xin, INP(2) + l * DM, (bf16_t*)(W + WS_XN), GW, NGW_, LN);
            ph_s5_mats((const float*)(W + WS_WTS + WT_APOW), (const float*)(W + WS_WTS + WT_BB), INP(18) + l * 16384, INP(19) + l * 16384, (bf16_t*)(W + WS_WTS + WT_S5A), (bf16_t*)(W + WS_WTS + WT_S5B), (bf16_t*)(W + WS_WTS + WT_KTAB), GW * 64 + LN, NGW_ * 64); }
        SEAM(p0 + PH_NORM);
        if (IN_(p0 + PH_GEMM_IN)) { PH_BEGIN;
            pg8::Gemm g{(const bf16_t*)(W + WS_XN), (const bf16_t*)(W + WS_WTS + WT_IN), DM, DM}; pg8::PlainSched S; S.o.init(NTOK / 256, NMIX / 256, GG, BX); S.lda = DM; S.ldb = DM; S.nt = 16; S.pn0 = 0;
            pg8::EpiInMix E{(unsigned char*)W};
            pg8::gemm_phase<pg8::EpiInMix, pg8::PlainSched, true, true>(lds, g, S, E);
        }
        SEAM(p0 + PH_GEMM_IN);
        if (IN_(p0 + PH_FIX)) { PH_BEGIN; ph_s5_expand((const bf16_t*)(W + WS_WTS + WT_KTAB), (bf16_t*)(W + WS_WTS + WT_S5B), GW * 64 + LN, NGW_ * 64); ph_fixup((bf16_t*)(W + WS_YCAT) + YC_Q, YC_LD, (bf16_t*)(W + WS_K), (const int*)INP(1), INP(4) + l * 64, INP(5) + l * 64, GW, NGW_, LN);
            pg8::Gemm g{(const bf16_t*)(W + WS_S5U), (const bf16_t*)(W + WS_WTS + WT_S5A), S5_LD, 512}; pg8::S5aSched S{GG, BX};
            pg8::EpiS5a E{(float*)(W + WS_S5ST)};
            pg8::gemm_phase<pg8::EpiS5a, pg8::S5aSched, true, true>(lds, g, S, E);
            hg_local(lds, (const bf16_t*)(W + WS_HGF), (const bf16_t*)(W + WS_HGI), INP(11), l, (float*)(W + WS_HGST), (float*)(W + WS_WTS + WT_HGDEC), GW, NGW_, GW & 7, LN);
        }
        SEAM(p0 + PH_FIX);
        if (IN_(p0 + PH_SCAN)) { PH_BEGIN; ph_s5_scan((const float*)(W + WS_WTS + WT_APOW), (const float*)(W + WS_S5ST), (bf16_t*)(W + WS_S5U), GW * 64 + LN, NGW_ * 64);
            hg_scan((float*)(W + WS_HGST), (const float*)(W + WS_WTS + WT_HGDEC), GW * 64 + LN, NGW_ * 64);
            sb_phase(lds, (bf16_t*)(W + WS_YCAT) + YC_SB, YC_LD, (const bf16_t*)(W + WS_SBK), (const bf16_t*)(W + WS_SBV), GW, NGW_, GW & 7, LN);
        }
        SEAM(p0 + PH_SCAN);
        if (IN_(p0 + PH_MIX)) { PH_BEGIN;
            { const attn2::AttnTensors AT{(const attn2::bf16*)(W + WS_YCAT) + YC_Q, (const attn2::bf16*)(W + WS_K), (const attn2::bf16*)(W + WS_V), (attn2::bf16*)(W + WS_O)};
              const attn2::StaticOrder SA(GG, BX); attn2::attn_phase<8>((char*)lds_raw, AT, SA); }
            pg8::Gemm g{(const bf16_t*)(W + WS_S5U), (const bf16_t*)(W + WS_WTS + WT_S5B), S5_LD, S5_LD}; pg8::S5bSched S2{GG, BX};
            pg8::EpiS5b E{(const bf16_t*)(W + WS_S5U), INP(20) + l * 256, (bf16_t*)(W + WS_YG)};
            pg8::gemm_phase<pg8::EpiS5b, pg8::S5bSched, true, true>(lds, g, S2, E);
            hg_out(lds, (const bf16_t*)(W + WS_HGF), (const bf16_t*)(W + WS_HGI), (bf16_t*)(W + WS_YCAT) + YC_HG, YC_LD, (const bf16_t*)(W + WS_HGG), INP(11), l, INP(12) + l * 64, (const float*)(W + WS_HGST), GW, NGW_, GW & 7, LN);
        }
        SEAM(p0 + PH_MIX);
        if (IN_(p0 + PH_POST)) { PH_BEGIN;
            const float lambda_init = l == 0 ? 0.2f : 0.35550906759096926f;
            ph_combine((const bf16_t*)(W + WS_O), (bf16_t*)(W + WS_YCAT) + YC_Q, YC_LD, INP(6) + l * 64, INP(7) + l * 64, INP(8) + l * 64, INP(9) + l * 64, INP(10) + l * 128, lambda_init, GW, NGW_, LN);
            pg8::Gemm g{(const bf16_t*)(W + WS_YG), (const bf16_t*)(W + WS_WTS + WT_GLU), 256, 256}; pg8::PlainSched S; S.o.init(NTOK / 256, 1, GG, BX); S.lda = 256; S.ldb = 256; S.nt = 4; S.pn0 = 0;
            pg8::EpiGlu E{(const bf16_t*)(W + WS_YG), INP(22) + l * 256, (bf16_t*)(W + WS_YCAT)};
            pg8::gemm_phase<pg8::EpiGlu, pg8::PlainSched, true, true>(lds, g, S, E);
        }
        SEAM(p0 + PH_POST);
        if (IN_(p0 + PH_GATE)) { PH_BEGIN;
            pg8::Gemm g{(const bf16_t*)(W + WS_XN), (const bf16_t*)(W + WS_WTS + WT_IN), DM, DM}; pg8::PlainSched S; S.o.init(NTOK / 256, 16, GG, BX); S.lda = DM; S.ldb = DM; S.nt = 16; S.pn0 = NMIX / 256;
            pg8::EpiGateU8 E{(unsigned char*)(W + WS_GATE)};
            pg8::gemm_phase<pg8::EpiGateU8, pg8::PlainSched, true, true>(lds, g, S, E);
        }
        SEAM(p0 + PH_GATE);
        if (IN_(p0 + PH_BRANCH)) { PH_BEGIN;
            pg8::Gemm g{(const bf16_t*)(W + WS_YCAT), (const bf16_t*)(W + WS_WTS + WT_P), YC_LD, YC_LD}; pg8::BranchSched S; S.o.init(NTOK / 256, 4, GG, BX);
            pg8::EpiBranch E{(const unsigned char*)(W + WS_GATE), (bf16_t*)(W + WS_O)};
            pg8::gemm_phase<pg8::EpiBranch, pg8::BranchSched, true, true>(lds, g, S, E);
        }
        SEAM(p0 + PH_BRANCH);
        if (IN_(p0 + PH_OUT)) { PH_BEGIN; const float* xin = l == 0 ? INP(0) : OUTP;
            pg8::Gemm g{(const bf16_t*)(W + WS_O), (const bf16_t*)(W + WS_WTS + WT_OUT), DM, DM}; pg8::PlainSched S; S.o.init(NTOK / 256, 4, GG, BX); S.lda = DM; S.ldb = DM; S.nt = 16; S.pn0 = 0;
            pg8::EpiOutRes E{xin, OUTP};
            pg8::gemm_phase<pg8::EpiOutRes, pg8::PlainSched, true, true>(lds, g, S, E);
        }
        SEAM(p0 + PH_OUT);
        if (IN_(p0 + PH_ROUTE)) { PH_BEGIN;
            ph_pair_weights(INP(35) + (size_t)l * NEXP * DEXP * DM, (bf16_t*)(W + WS_O), lds, GW, NGW_, GW & 7, LN);
            ph_router(lds, OUTP, INP(28) + l * DM, INP(29) + l * DM * 4, INP(30) + l * 4, INP(31) + l * DM * 16, INP(32) + l * 16, (bf16_t*)(W + WS_XN), (int*)(W + WS_SMALL + SM_BUCKET), (int*)(W + WS_SMALL + SM_RANK),
                      (float*)(W + WS_SMALL + SM_TW), (unsigned*)(W + WS_CTL) + CW_CNT + CNT_LSTRIDE * l, GW, NGW_, LN); }
        SEAM(p0 + PH_ROUTE);
        if (IN_(p0 + PH_SORT)) { PH_BEGIN;
            ph_sort((const bf16_t*)(W + WS_XN), (const int*)(W + WS_SMALL + SM_BUCKET), (const int*)(W + WS_SMALL + SM_RANK), (const float*)(W + WS_SMALL + SM_TW), (const unsigned*)(W + WS_CTL) + CW_CNT + CNT_LSTRIDE * l,
                    (bf16_t*)(W + WS_XS), (int*)(W + WS_SMALL + SM_SLOTTOK), (float*)(W + WS_SMALL + SM_SLOTW), GW, NGW_, LN); }
        SEAM(p0 + PH_SORT);
        if (IN_(p0 + PH_MOE1)) { PH_BEGIN;
            pg8::Gemm g{(const bf16_t*)(W + WS_XS), (const bf16_t*)(W + WS_WTS + WT_E1), DM, DM}; LAS int* tbl = (LAS int*)(lds + MISC_OFF + 256); pg8::moe_table(tbl, (const unsigned*)(W + WS_CTL) + CW_CNT + CNT_LSTRIDE * l); pg8::MoeSched<1> S{tbl, GG, BX};
            pg8::EpiMoe1 E{(bf16_t*)(W + WS_HID), (const float*)(W + WS_SMALL + SM_SLOTW)};
            pg8::gemm_phase<pg8::EpiMoe1, pg8::MoeSched<1>, true, true>(lds, g, S, E);
        }
        SEAM(p0 + PH_MOE1);
        if (IN_(p0 + PH_MOE2)) { PH_BEGIN;
            pg8::Gemm g{(const bf16_t*)(W + WS_HID), (const bf16_t*)(W + WS_O), 768, 768};        LAS int* tbl = (LAS int*)(lds + MISC_OFF + 256); pg8::moe_table(tbl, (const unsigned*)(W + WS_CTL) + CW_CNT + CNT_LSTRIDE * l); pg8::MoeSched<2> S{tbl, GG, BX};
            pg8::EpiMoe2 E{OUTP, (const int*)(W + WS_SMALL + SM_SLOTTOK), (float*)(W + WS_SMALL + SM_DUMMY)};
            pg8::gemm_phase<pg8::EpiMoe2, pg8::MoeSched<2>, true, true>(lds, g, S, E);
        }
        SEAM(p0 + PH_MOE2);
    }
#undef IN_
#undef SEAM
}

extern "C" void kernel_launch(void* const* d_in, const int* in_sizes, int n_in, void* d_out, int out_size, void* d_ws, size_t ws_size, hipStream_t stream) {
    static int grid = 0;
    if (grid == 0) {
        if (n_in != 36 || out_size != NTOK * DM || ws_size < WS_END) { fprintf(stderr, "kernel_launch: unexpected shapes (n_in %d out %d ws %zu)\n", n_in, out_size, ws_size); grid = -1; return; }
        int dev = 0, cus = 0, per_cu = 0;
        if (hipGetDevice(&dev) != hipSuccess || hipDeviceGetAttribute(&cus, hipDeviceAttributeMultiprocessorCount, dev) != hipSuccess) { grid = -1; return; }
        if (hipFuncSetAttribute((const void*)fwd, hipFuncAttributeMaxDynamicSharedMemorySize, LDS_BYTES) != hipSuccess) { fprintf(stderr, "kernel_launch: hipFuncSetAttribute failed\n"); grid = -1; return; }
        if (hipOccupancyMaxActiveBlocksPerMultiprocessor(&per_cu, (const void*)fwd, NWAVES * 64, LDS_BYTES) != hipSuccess || per_cu < 1) { fprintf(stderr, "kernel_launch: occupancy query says %d\n", per_cu); }
        (void)hipGetLastError();
        grid = cus;
    }
    if (grid < 0) return;
    unsigned char* ws = (unsigned char*)d_ws;
    const float* const* in = (const float* const*)d_in;
    (void)hipMemsetAsync(ws + WS_CTL, 0, 1 * MiB, stream);
    bf16_t *OB = (bf16_t*)(ws + WS_O), *YC = (bf16_t*)(ws + WS_YCAT), *K = (bf16_t*)(ws + WS_K), *V = (bf16_t*)(ws + WS_V);
    bf16_t *SBK = (bf16_t*)(ws + WS_SBK), *SBV = (bf16_t*)(ws + WS_SBV), *HGF = (bf16_t*)(ws + WS_HGF), *HGI = (bf16_t*)(ws + WS_HGI), *HGG = (bf16_t*)(ws + WS_HGG);
    bf16_t *S5U = (bf16_t*)(ws + WS_S5U), *YG = (bf16_t*)(ws + WS_YG);
    Args a{};
    for (int i = 0; i < 36; ++i) a.in[i] = (const float*)d_in[i];
    a.out = (float*)d_out; a.ws = ws;
    a.ph_lo = 0; a.ph_hi = DEPTH * PH_PER_LAYER; a.li = 0;
    hipLaunchKernelGGL(fwd, dim3(grid), dim3(NWAVES * 64), LDS_BYTES, stream, a);
}
```

```cpp
#include <hip/hip_runtime.h>
#include <cstdio>
#include <cstdint>
#include <cmath>

typedef unsigned short bf16_t;
typedef float f32x4 __attribute__((ext_vector_type(4)));
typedef unsigned u32x4 __attribute__((ext_vector_type(4)));
typedef unsigned u32x2 __attribute__((ext_vector_type(2)));
#define GAS __attribute__((address_space(1)))
#define LAS __attribute__((address_space(3)))
#define CAS __attribute__((address_space(4)))

constexpr int NB = 4, SEQ = 8192, NTOK = NB * SEQ, DM = 1024, DEPTH = 2, IN_COLS = 7680;
constexpr int C_GATE = 3584;
constexpr int NMIX = 3584;
constexpr float RMS_EPS = 1e-6f;
constexpr float QSCALE = 0.125f * 1.4426950408889634f;
constexpr int NEXP = 16, DEXP = 384, NBUCKET = 24, MPAD = NTOK + NBUCKET * 256;
constexpr int YC_LD = 1280, YC_Q = 0, YC_SB = 512, YC_HG = 768, YC_YD = 1024;

constexpr size_t MiB = 1u << 20;
constexpr size_t WS_CTL = 0;
constexpr size_t WS_SMALL = 1 * MiB;
constexpr size_t WS_XN = 2 * MiB;
constexpr size_t WS_O = 66 * MiB;
constexpr size_t WS_YCAT = 130 * MiB;
constexpr size_t WS_K = 210 * MiB;
constexpr size_t WS_V = 242 * MiB;
constexpr size_t WS_SBK = 274 * MiB, WS_SBV = 290 * MiB, WS_HGF = 306 * MiB, WS_HGI = 322 * MiB;
constexpr size_t WS_GATE = 210 * MiB;
constexpr size_t WS_HGG = 338 * MiB, WS_S5U = 354 * MiB  , WS_YG = 374 * MiB;
constexpr size_t WS_HGST = 390 * MiB, WS_S5ST = 422 * MiB  , WS_WTS = 432 * MiB, WS_END = 512 * MiB;
constexpr size_t WS_XS = 130 * MiB;
constexpr size_t WS_HID = 210 * MiB;
constexpr size_t WT_IN = 0, WT_P = 15 * MiB, WT_OUT = 18 * MiB, WT_GLU = 20 * MiB, WT_E1 = 21 * MiB, WT_E2 = 45 * MiB, WT_S5A = 57 * MiB  , WT_S5B = 61 * MiB  ;
constexpr size_t WT_KTAB = 75 * MiB  ;
constexpr size_t WT_APOW = 72 * MiB  , WT_BB = 73 * MiB  , WT_HGDEC = 74 * MiB  ;
constexpr int S5_LD = 640;
constexpr size_t SM_BUCKET = 0;
constexpr size_t SM_RANK = 131072;
constexpr size_t SM_TW = 262144;
constexpr size_t SM_SLOTTOK = 524288;
constexpr size_t SM_SLOTW = 524288 + 163840;
constexpr size_t SM_DUMMY = 1040384;
constexpr int CW_CNT = 8192, CNT_LSTRIDE = 2048;
constexpr int CW_BAR = 4096;

__device__ __forceinline__ float bf2f(bf16_t v) { return __uint_as_float((unsigned)v << 16); }
__device__ __forceinline__ bf16_t f2bf(float f) { unsigned u = __float_as_uint(f); return (bf16_t)((u + 0x7fffu + ((u >> 16) & 1u)) >> 16); }
__device__ __forceinline__ unsigned pk2(float lo, float hi) { return (unsigned)f2bf(lo) | ((unsigned)f2bf(hi) << 16); }
__device__ __forceinline__ float shx(float v, int m, int lane) { return __int_as_float(__builtin_amdgcn_ds_bpermute((lane ^ m) << 2, __float_as_int(v))); }
__device__ __forceinline__ float shl_(float v, int src) { return __int_as_float(__builtin_amdgcn_ds_bpermute(src << 2, __float_as_int(v))); }
__device__ __forceinline__ int shl_i(int v, int src) { return __builtin_amdgcn_ds_bpermute(src << 2, v); }
__device__ __forceinline__ float wave_sum_dpp(float v) {
    v += __int_as_float(__builtin_amdgcn_update_dpp(0, __float_as_int(v), 0xb1, 0xf, 0xf, true));
    v += __int_as_float(__builtin_amdgcn_update_dpp(0, __float_as_int(v), 0x4e, 0xf, 0xf, true));
    v += __int_as_float(__builtin_amdgcn_update_dpp(0, __float_as_int(v), 0x114, 0xf, 0xf, true));
    v += __int_as_float(__builtin_amdgcn_update_dpp(0, __float_as_int(v), 0x118, 0xf, 0xf, true));
    v += __int_as_float(__builtin_amdgcn_update_dpp(0, __float_as_int(v), 0x142, 0xa, 0xf, true));
    v += __int_as_float(__builtin_amdgcn_update_dpp(0, __float_as_int(v), 0x143, 0xc, 0xf, true));
    return __int_as_float(__builtin_amdgcn_readlane(__float_as_int(v), 63));
}
__device__ __forceinline__ float wave_sum(float v, int lane) {
#pragma unroll
    for (int o = 1; o < 64; o <<= 1) v += shx(v, o, lane);
    return v;
}
__device__ __forceinline__ float sigmoidf_(float x) { return 1.f / (1.f + __expf(-x)); }
__device__ __forceinline__ float softplusf_(float x) { return fmaxf(x, 0.f) + log1pf(__expf(-fabsf(x))); }

namespace pg8 {
#define PG8_LAS __attribute__((address_space(3)))
typedef short bf16x8 __attribute__((ext_vector_type(8)));
constexpr int BM = 256, BK = 64, HALF = 128, HTB = HALF * BK * 2  , STAGE_BYTES = 8 * HTB, NXCD = 8, WGM = 8;

__host__ __device__ __forceinline__ int lds_byte(int r, int c) { const int st = (r >> 4) * 2 + (c >> 5), rr = r & 15, cc = c & 31, ob = rr * 64 + cc * 2; return st * 1024 + (ob ^ (((ob >> 9) & 1) << 5)); }
__host__ __device__ __forceinline__ void stage_rc(int b, int& R, int& C) { const int st = b / 1024, sb = b % 1024, swz = sb ^ (((sb >> 9) & 1) << 5); R = (st >> 1) * 16 + swz / 64; C = (st & 1) * 32 + (swz % 64) / 2; }
__host__ __device__ __forceinline__ int perm32(int rho) { const int n = rho >> 4, i = rho & 15; return 8 * (i >> 2) + 4 * n + (i & 3); }

struct Unit { unsigned aoff, boff; int nt, pm, pn, aux; };
struct Gemm { const bf16_t* A; const bf16_t* Bt; int lda, ldb; };

struct TileOrder {
    int nM, nN, nwg, G, c;
    __device__ __forceinline__ void init(int nM_, int nN_, int G_, int c_) { nM = nM_; nN = nN_; nwg = nM * nN; G = G_; c = c_; }
    __device__ __forceinline__ bool tile(int i, int& pm, int& pn) const {
        const int L = i * G + c; if (L >= nwg) return false;
        int wgid = L; { const int q = nwg / NXCD, r = nwg % NXCD, xcd = wgid % NXCD, off = wgid / NXCD; wgid = (xcd < r ? xcd * (q + 1) : r * (q + 1) + (xcd - r) * q) + off; }
        const int nig = WGM * nN, gid = wgid / nig, fm = gid * WGM, gsz = (nM - fm) < WGM ? (nM - fm) : WGM;
        pm = fm + ((wgid % nig) % gsz); pn = (wgid % nig) / gsz; return true;
    }
};
struct PlainSched {
    TileOrder o; int lda, ldb, nt, pn0;
    __device__ __forceinline__ bool next(int i, Unit& u) const { int pm, pn; if (!o.tile(i, pm, pn)) return false;
        u.aoff = (unsigned)pm * 256u * lda * 2u; u.boff = (unsigned)(pn0 + pn) * 256u * ldb * 2u; u.nt = nt; u.pm = pm; u.pn = pn; u.aux = 0; return true; }
    __device__ __forceinline__ void a_ready(const Unit&) const {}
    __device__ __forceinline__ void done(const Unit&) const {}
};
struct BranchSched {
    TileOrder o;
    __device__ __forceinline__ bool next(int i, Unit& u) const { int pm, pn; if (!o.tile(i, pm, pn)) return false;
        u.aoff = (unsigned)pm * 256u * YC_LD * 2u; u.boff = (unsigned)pn * 256u * YC_LD * 2u; u.nt = 20; u.pm = pm; u.pn = pn; u.aux = 0; return true; }
    __device__ __forceinline__ void a_ready(const Unit&) const {}
    __device__ __forceinline__ void done(const Unit&) const {}
};
__device__ __forceinline__ void pair_experts(int b, int& e0, int& e1) { const int g = b / 6, p = b % 6; const int lo = p < 3 ? 0 : (p < 5 ? 1 : 2), hi = p < 3 ? p + 1 : (p < 5 ? p - 1 : 3); e0 = g * 4 + lo; e1 = g * 4 + hi; }
constexpr int MOE_TBL_TOT = MPAD / 256;
__device__ __forceinline__ void moe_table(PG8_LAS int* tbl, const unsigned* cnt) {
    int t = threadIdx.x; asm volatile("" : "+v"(t));
    if (t <= MOE_TBL_TOT) { int tot = 0, bsel = NBUCKET - 1, found = 0;
#pragma nounroll
        for (int b = 0; b < NBUCKET; ++b) { const int tb = (int)((__hip_atomic_load(cnt + 64 * b, __ATOMIC_RELAXED, __HIP_MEMORY_SCOPE_AGENT) + 255u) >> 8); if (!found && t < tot + tb) { bsel = b; found = 1; } tot += tb; }
        tbl[t] = t == MOE_TBL_TOT ? tot : bsel; }
    __syncthreads();
}
template <int PHASE> struct MoeSched {
    const PG8_LAS int* tbl; int G, c;
    __device__ __forceinline__ bool next(int i, Unit& u) const {
        constexpr int NT = PHASE == 1 ? 6 : 4;
        const int L = i * G + c, pm = L / NT, pn = L % NT;
        if (pm >= __builtin_amdgcn_readfirstlane(tbl[MOE_TBL_TOT])) return false;
        const int bsel = __builtin_amdgcn_readfirstlane(tbl[pm]);
        int e0, e1; pair_experts(bsel, e0, e1);
        u.pm = pm; u.pn = pn; u.aux = 0;
        if (PHASE == 1) { const int sel = pn / 3, jt = pn % 3, e = sel ? e1 : e0;
            u.aoff = (unsigned)pm * 256u * DM * 2u; u.boff = (unsigned)(e * 3 + jt) * 256u * DM * 2u; u.nt = 16; }
        else { u.aoff = (unsigned)pm * 256u * 768u * 2u; u.boff = ((unsigned)bsel * 1024u + (unsigned)pn * 256u) * 768u * 2u; u.nt = 12; }
        return true;
    }
    __device__ __forceinline__ void a_ready(const Unit&) const {}
    __device__ __forceinline__ void done(const Unit&) const {}
};

__device__ __forceinline__ unsigned cvt_pk_bf16(float lo, float hi) { unsigned r; asm volatile("v_cvt_pk_bf16_f32 %0, %1, %2" : "=v"(r) : "v"(lo), "v"(hi)); return r; }
__device__ __forceinline__ u32x4 pack8(const f32x4 a, const f32x4 b) { u32x4 w; w.x = cvt_pk_bf16(a[0], a[1]); w.y = cvt_pk_bf16(a[2], a[3]); w.z = cvt_pk_bf16(b[0], b[1]); w.w = cvt_pk_bf16(b[2], b[3]); return w; }
__device__ __forceinline__ float fsig(float x) { return __builtin_amdgcn_rcpf(1.f + __builtin_amdgcn_exp2f(-1.4426950408889634f * x)); }
#define PG8_EPI_LOOP for (int ai = 0; ai < 2; ++ai) _Pragma("unroll") for (int m = 0; m < 4; ++m) _Pragma("unroll") for (int bj = 0; bj < 3; ++bj) if (bj == 2) { asm volatile("" ::: "memory"); } else

struct EpiInMix {
    static constexpr bool PERM = true, AFTER_DRAIN = false, MID = false; unsigned char* ws;
    __device__ __forceinline__ void operator()(const f32x4 (&acc)[2][2][4][2], const Unit& u, int wr, int wc, int fr, int fq) const {
        const int pn = u.pn; bf16_t* base; int ld;
        if (pn < 2) { base = (bf16_t*)(ws + WS_YCAT) + YC_Q + pn * 256; ld = YC_LD; }
        else if (pn < 4) { base = (bf16_t*)(ws + WS_K) + (pn - 2) * 256; ld = 512; }
        else if (pn < 6) { base = (bf16_t*)(ws + WS_V) + (pn - 4) * 256; ld = 512; }
        else if (pn == 6) { base = (bf16_t*)(ws + WS_YCAT) + YC_SB; ld = YC_LD; }
        else if (pn == 7) { base = (bf16_t*)(ws + WS_SBK); ld = 256; }
        else if (pn == 8) { base = (bf16_t*)(ws + WS_SBV); ld = 256; }
        else if (pn == 9) { base = (bf16_t*)(ws + WS_HGF); ld = 256; }
        else if (pn == 10) { base = (bf16_t*)(ws + WS_HGI); ld = 256; }
        else if (pn == 11) { base = (bf16_t*)(ws + WS_YCAT) + YC_HG; ld = YC_LD; }
        else if (pn == 12) { base = (bf16_t*)(ws + WS_HGG); ld = 256; }
        else { base = (bf16_t*)(ws + WS_S5U); ld = 16; }
        const int row0 = u.pm * BM + wr * 64 + fr, col0 = wc * 32 + 8 * fq;
#pragma unroll
        PG8_EPI_LOOP { const int row = row0 + ai * HALF + m * 16, col = col0 + bj * HALF; const u32x4 w = pack8(acc[ai][bj][m][0], acc[ai][bj][m][1]);
            if (pn == 13) *(u32x4*)(base + ((size_t)(col >> 4) * 1024 + (row >> 5)) * S5_LD + (row & 31) * 16 + (col & 15)) = w;
            else *(u32x4*)(base + (size_t)row * ld + col) = w; }
    }
};
struct EpiGateU8 {
    static constexpr bool PERM = true, AFTER_DRAIN = false, MID = false; unsigned char* G;
    __device__ __forceinline__ void operator()(const f32x4 (&acc)[2][2][4][2], const Unit& u, int wr, int wc, int fr, int fq) const {
        const int row0 = u.pm * BM + wr * 64 + fr, col0 = u.pn * BM + wc * 32 + 8 * fq;
#pragma unroll
        PG8_EPI_LOOP { const f32x4 a = acc[ai][bj][m][0], b = acc[ai][bj][m][1]; unsigned q[8];
#pragma unroll
            for (int i = 0; i < 4; ++i) { q[i] = (unsigned)(fsig(a[i]) * 255.f + 0.5f); q[4 + i] = (unsigned)(fsig(b[i]) * 255.f + 0.5f); }
            u32x2 w; w.x = q[0] | (q[1] << 8) | (q[2] << 16) | (q[3] << 24); w.y = q[4] | (q[5] << 8) | (q[6] << 16) | (q[7] << 24);
            *(u32x2*)(G + (size_t)(row0 + ai * HALF + m * 16) * 4096 + col0 + bj * HALF) = w; }
    }
};
struct EpiBranch {
    static constexpr bool PERM = true, AFTER_DRAIN = false, MID = true; const unsigned char* G; bf16_t* Mg;
    __device__ __forceinline__ void gl(u32x4 (&g)[4], int row0, int col0, int k) const {
        const unsigned char* gp = G + (size_t)(row0 + (k >> 2) * HALF + (k & 3) * 16) * 4096 + col0 * 4;
        g[0] = *(const u32x4*)gp; g[1] = *(const u32x4*)(gp + 16); g[2] = *(const u32x4*)(gp + HALF * 4); g[3] = *(const u32x4*)(gp + HALF * 4 + 16);
    }
    __device__ __forceinline__ void mid(f32x4 (&acc)[2][2][4][2], const Unit& u, int t, int, int, int, int) const {
        int tid = threadIdx.x; asm volatile("" : "+v"(tid));
        const int wid = __builtin_amdgcn_readfirstlane(tid >> 6), wr = wid >> 2, wc = wid & 3, fr = tid & 15, fq = (tid & 63) >> 4;
        const int row0 = u.pm * BM + wr * 64 + fr, col0 = u.pn * BM + wc * 32 + 8 * fq, sh = 2 * t - 16;
        u32x4 gc[4], gn[4]; gl(gc, row0, col0, 0);
#pragma unroll
        for (int k = 0; k < 8; ++k) { const int ai = k >> 2, m = k & 3;
            if (k < 7) gl(gn, row0, col0, k + 1);
#pragma unroll
            for (int bj = 0; bj < 2; ++bj)
#pragma unroll
                for (int i = 0; i < 4; ++i) { acc[ai][bj][m][0][i] *= fmaxf((float)((gc[2 * bj][i] >> sh) & 255u), 0.5f) * __builtin_amdgcn_rcpf(fmaxf((float)((gc[2 * bj][i] >> (sh + 8)) & 255u), 0.5f));
                                              acc[ai][bj][m][1][i] *= fmaxf((float)((gc[2 * bj + 1][i] >> sh) & 255u), 0.5f) * __builtin_amdgcn_rcpf(fmaxf((float)((gc[2 * bj + 1][i] >> (sh + 8)) & 255u), 0.5f)); }
            asm volatile("" ::: "memory");
#pragma unroll
            for (int q = 0; q < 4; ++q) gc[q] = gn[q]; }
    }
    __device__ __forceinline__ void operator()(const f32x4 (&acc)[2][2][4][2], const Unit& u, int, int, int, int) const {
        int tid = threadIdx.x; asm volatile("" : "+v"(tid));
        const int wid = __builtin_amdgcn_readfirstlane(tid >> 6), wr = wid >> 2, wc = wid & 3, fr = tid & 15, fq = (tid & 63) >> 4;
        const int row0 = u.pm * BM + wr * 64 + fr, col0 = u.pn * BM + wc * 32 + 8 * fq;
        u32x4 gc[4], gn[4]; gl(gc, row0, col0, 0);
#pragma unroll
        for (int k = 0; k < 8; ++k) { const int ai = k >> 2, m = k & 3, row = row0 + ai * HALF + m * 16;
            if (k < 7) gl(gn, row0, col0, k + 1);
#pragma unroll
            for (int bj = 0; bj < 2; ++bj) { f32x4 a = acc[ai][bj][m][0], b = acc[ai][bj][m][1];
#pragma unroll
                for (int i = 0; i < 4; ++i) { a[i] *= fmaxf((float)(gc[2 * bj][i] >> 24), 0.5f) * (1.f / 255.f); b[i] *= fmaxf((float)(gc[2 * bj + 1][i] >> 24), 0.5f) * (1.f / 255.f); }
                *(u32x4*)(Mg + (size_t)row * DM + col0 + bj * HALF) = pack8(a, b); }
            asm volatile("" ::: "memory");
#pragma unroll
            for (int q = 0; q < 4; ++q) gc[q] = gn[q]; }
    }
};
struct EpiOutRes {
    static constexpr bool PERM = true, AFTER_DRAIN = false, MID = false; const float* xi; float* xo;
    __device__ __forceinline__ void ld(f32x4 (&r)[4], size_t off) const { r[0] = *(const f32x4*)(xi + off); r[1] = *(const f32x4*)(xi + off + 4); r[2] = *(const f32x4*)(xi + off + HALF); r[3] = *(const f32x4*)(xi + off + HALF + 4); }
    __device__ __forceinline__ void operator()(const f32x4 (&acc)[2][2][4][2], const Unit& u, int wr, int wc, int fr, int fq) const {
        const int row0 = u.pm * BM + wr * 64 + fr, col0 = u.pn * BM + wc * 32 + 8 * fq;
        f32x4 rc[4], rn[4]; ld(rc, (size_t)row0 * DM + col0);
#pragma unroll
        for (int k = 0; k < 8; ++k) { const int ai = k >> 2, m = k & 3; const size_t off = (size_t)(row0 + ai * HALF + m * 16) * DM + col0;
            if (k < 7) ld(rn, (size_t)(row0 + ((k + 1) >> 2) * HALF + ((k + 1) & 3) * 16) * DM + col0);
            *(f32x4*)(xo + off) = rc[0] + acc[ai][0][m][0]; *(f32x4*)(xo + off + 4) = rc[1] + acc[ai][0][m][1]; *(f32x4*)(xo + off + HALF) = rc[2] + acc[ai][1][m][0]; *(f32x4*)(xo + off + HALF + 4) = rc[3] + acc[ai][1][m][1];
            asm volatile("" ::: "memory");
#pragma unroll
            for (int q = 0; q < 4; ++q) rc[q] = rn[q]; }
    }
};
struct EpiGlu {
    static constexpr bool PERM = true, AFTER_DRAIN = false, MID = false; const bf16_t* yg; const float* bias; bf16_t* yc;
    __device__ __forceinline__ void operator()(const f32x4 (&acc)[2][2][4][2], const Unit& u, int wr, int wc, int fr, int fq) const {
        const int row0 = u.pm * BM + wr * 64 + fr, col0 = wc * 32 + 8 * fq;
#pragma unroll
        PG8_EPI_LOOP { const int row = row0 + ai * HALF + m * 16, col = col0 + bj * HALF;
            const u32x4 p = *(const u32x4*)(yg + (size_t)row * 256 + col); const f32x4 b0 = *(const f32x4*)(bias + col), b1 = *(const f32x4*)(bias + col + 4);
            f32x4 a = acc[ai][bj][m][0] + b0, b = acc[ai][bj][m][1] + b1;
            const float y[8] = {__uint_as_float(p.x << 16), __uint_as_float(p.x & 0xffff0000u), __uint_as_float(p.y << 16), __uint_as_float(p.y & 0xffff0000u),
                                __uint_as_float(p.z << 16), __uint_as_float(p.z & 0xffff0000u), __uint_as_float(p.w << 16), __uint_as_float(p.w & 0xffff0000u)};
#pragma unroll
            for (int i = 0; i < 4; ++i) { a[i] = y[i] * fsig(a[i]); b[i] = y[4 + i] * fsig(b[i]); }
            *(u32x4*)(yc + (size_t)row * YC_LD + YC_YD + col) = pack8(a, b); }
    }
};
struct S5aSched {
    int G, c;
    __device__ __forceinline__ bool next(int i, Unit& u) const { const int L = i * G + c; if (L >= 64) return false; const int g = L >> 2, pm = L & 3;
        u.aoff = ((unsigned)(g * 1024 + pm * 256) * S5_LD) * 2u; u.boff = (unsigned)g * 256u * 512u * 2u; u.nt = 8; u.pm = g * 4 + pm; u.pn = 0; u.aux = 0; return true; }
    __device__ __forceinline__ void a_ready(const Unit&) const {}
    __device__ __forceinline__ void done(const Unit&) const {}
};
struct S5bSched {
    int G, c;
    __device__ __forceinline__ bool next(int i, Unit& u) const { const int L = i * G + c; if (L >= 128) return false; const int g = L >> 3, pm = (L >> 1) & 3, pn = L & 1;
        u.aoff = ((unsigned)(g * 1024 + pm * 256) * S5_LD) * 2u; u.boff = ((unsigned)(g * 512 + pn * 256) * S5_LD) * 2u; u.nt = 10; u.pm = g * 4 + pm; u.pn = pn; u.aux = g; return true; }
    __device__ __forceinline__ void a_ready(const Unit&) const {}
    __device__ __forceinline__ void done(const Unit&) const {}
};
struct EpiS5a {
    static constexpr bool PERM = true, AFTER_DRAIN = false, MID = false; float* st;
    __device__ __forceinline__ void operator()(const f32x4 (&acc)[2][2][4][2], const Unit& u, int wr, int wc, int fr, int fq) const {
        const int row0 = u.pm * BM + wr * 64 + fr, col0 = wc * 32 + 8 * fq;
#pragma unroll
        for (int ai = 0; ai < 2; ++ai)
#pragma unroll
            for (int m = 0; m < 4; ++m) { float* p = st + (size_t)(row0 + ai * HALF + m * 16) * 128 + col0; *(f32x4*)p = acc[ai][0][m][0]; *(f32x4*)(p + 4) = acc[ai][0][m][1]; }
    }
};
struct EpiS5b {
    static constexpr bool PERM = true, AFTER_DRAIN = false, MID = false; const bf16_t* s5u; const float* dsk; bf16_t* yg;
    __device__ __forceinline__ void operator()(const f32x4 (&acc)[2][2][4][2], const Unit& u, int wr, int wc, int fr, int fq) const {
        const int g = u.aux, row0 = u.pm * BM + wr * 64 + fr  , col0 = u.pn * BM + wc * 32 + 8 * fq, c0 = col0 & 15;
        const f32x4 d0 = *(const f32x4*)(dsk + g * 16 + c0), d1 = *(const f32x4*)(dsk + g * 16 + c0 + 4);
#pragma unroll
        PG8_EPI_LOOP { const int row = row0 + ai * HALF + m * 16, col = col0 + bj * HALF, chunk = row - g * 1024, t = col >> 4;
            const u32x4 p = *(const u32x4*)(s5u + (size_t)row * S5_LD + col);
            const float uu[8] = {__uint_as_float(p.x << 16), __uint_as_float(p.x & 0xffff0000u), __uint_as_float(p.y << 16), __uint_as_float(p.y & 0xffff0000u),
                                 __uint_as_float(p.z << 16), __uint_as_float(p.z & 0xffff0000u), __uint_as_float(p.w << 16), __uint_as_float(p.w & 0xffff0000u)};
            f32x4 a = acc[ai][bj][m][0], b = acc[ai][bj][m][1];
#pragma unroll
            for (int i = 0; i < 4; ++i) { float y = a[i] + d0[i] * uu[i]; float z = 0.7978845608028654f * (y + 0.044715f * y * y * y); a[i] = y * fsig(2.f * z);
                y = b[i] + d1[i] * uu[4 + i]; z = 0.7978845608028654f * (y + 0.044715f * y * y * y); b[i] = y * fsig(2.f * z); }
            *(u32x4*)(yg + (size_t)(chunk * 32 + t) * 256 + g * 16 + c0) = pack8(a, b); }
    }
};
struct EpiMoe1 {
    static constexpr bool PERM = true, AFTER_DRAIN = false, MID = false; bf16_t* hid; const float* slot_w;
    __device__ __forceinline__ void operator()(const f32x4 (&acc)[2][2][4][2], const Unit& u, int wr, int wc, int fr, int fq) const {
        const int row0 = u.pm * BM + wr * 64 + fr, sel = u.pn / 3, col0 = sel * DEXP + (u.pn % 3) * 128 + wc * 32 + 8 * fq;
#pragma unroll
        for (int ai = 0; ai < 2; ++ai)
#pragma unroll
            for (int m = 0; m < 4; ++m) { const int row = row0 + ai * HALF + m * 16; const float w = slot_w[2 * row + sel]; f32x4 a, b;
#pragma unroll
                for (int i = 0; i < 4; ++i) { const float g0 = acc[ai][0][m][0][i], g1 = acc[ai][0][m][1][i]; a[i] = g0 * fsig(g0) * acc[ai][1][m][0][i] * w; b[i] = g1 * fsig(g1) * acc[ai][1][m][1][i] * w; }
                *(u32x4*)(hid + (size_t)row * 768 + col0) = pack8(a, b); asm volatile("" ::: "memory"); }
    }
};
struct EpiMoe2 {
    static constexpr bool PERM = true, AFTER_DRAIN = false, MID = false; float* x; const int* slot_tok; float* dummy;
    __device__ __forceinline__ void operator()(const f32x4 (&acc)[2][2][4][2], const Unit& u, int wr, int wc, int fr, int fq) const {
        const int row0 = u.pm * BM + wr * 64 + fr, col0 = u.pn * BM + wc * 32 + 8 * fq;
        int tk[8];
#pragma unroll
        for (int k = 0; k < 8; ++k) tk[k] = slot_tok[row0 + (k >> 2) * HALF + (k & 3) * 16];
        f32x4 rc[4], rn[4]; float* pc = (tk[0] >= 0 ? x + (size_t)tk[0] * DM : dummy) + col0;
        rc[0] = *(const f32x4*)pc; rc[1] = *(const f32x4*)(pc + 4); rc[2] = *(const f32x4*)(pc + HALF); rc[3] = *(const f32x4*)(pc + HALF + 4);
#pragma unroll
        for (int k = 0; k < 8; ++k) { const int ai = k >> 2, m = k & 3; float* pn = pc;
            if (k < 7) { pn = (tk[k + 1] >= 0 ? x + (size_t)tk[k + 1] * DM : dummy) + col0; rn[0] = *(const f32x4*)pn; rn[1] = *(const f32x4*)(pn + 4); rn[2] = *(const f32x4*)(pn + HALF); rn[3] = *(const f32x4*)(pn + HALF + 4); }
            *(f32x4*)pc = rc[0] + acc[ai][0][m][0]; *(f32x4*)(pc + 4) = rc[1] + acc[ai][0][m][1]; *(f32x4*)(pc + HALF) = rc[2] + acc[ai][1][m][0]; *(f32x4*)(pc + HALF + 4) = rc[3] + acc[ai][1][m][1];
            asm volatile("" ::: "memory");
            pc = pn;
#pragma unroll
            for (int q = 0; q < 4; ++q) rc[q] = rn[q]; }
    }
};

template <class Epi, class Sched, bool ALIGN_EPI = false, bool SP2 = false>
__device__ __forceinline__ void gemm_phase(PG8_LAS unsigned char* lds, const Gemm g, const Sched& S, const Epi& E) {
    int tid_ = threadIdx.x; asm volatile("" : "+v"(tid_));
    const int tid = tid_, wid = __builtin_amdgcn_readfirstlane(tid >> 6), lane = tid & 63, wr = wid >> 2, wc = wid & 3, fr = lane & 15, fq = lane >> 4;
    unsigned voffA[2], voffB[2];
#pragma unroll
    for (int i = 0; i < 2; ++i) { int R, C; stage_rc(tid * 16 + i * 8192, R, C); const int Rb = Epi::PERM ? ((R & ~31) + perm32(R & 31)) : R;
        voffA[i] = (unsigned)(R * g.lda + C) * 2u; voffB[i] = (unsigned)(Rb * g.ldb + C) * 2u; }
    const size_t kstep = (size_t)(BK * 2);
    const size_t hstepA = (size_t)HALF * g.lda * 2, hstepB = (size_t)HALF * g.ldb * 2;
    const unsigned ldsw = (unsigned)wid * 1024u;
    const int aoff = lds_byte(wr * 64 + fr, fq * 8), boff = lds_byte(wc * 32 + fr, fq * 8);
#define PG8_SA(b, h) (((b) * 2 + (h)) * HTB)
#define PG8_SB(b, h) ((4 + (b) * 2 + (h)) * HTB)
#define PG8_STAGE(bufoff, gbase, voff) do { _Pragma("unroll") for (int _i = 0; _i < 2; ++_i) \
        __builtin_amdgcn_global_load_lds((const unsigned*)((const char*)(gbase) + (voff)[_i]), (PG8_LAS unsigned*)(lds + (bufoff) + ldsw + _i * 8192), 16, 0, 0); } while (0)
#define PG8_LDA(dst, b, h) do { _Pragma("unroll") for (int m = 0; m < 4; ++m) _Pragma("unroll") for (int k = 0; k < 2; ++k) dst[m][k] = *(const PG8_LAS bf16x8*)(lds + PG8_SA(b, h) + aoff + m * 2048 + k * 1024); } while (0)
#define PG8_LDB(dst, b, h) do { _Pragma("unroll") for (int n = 0; n < 2; ++n) _Pragma("unroll") for (int k = 0; k < 2; ++k) dst[n][k] = *(const PG8_LAS bf16x8*)(lds + PG8_SB(b, h) + boff + n * 2048 + k * 1024); } while (0)
#define PG8_MMA(ai, bj, At, Bt) do { __builtin_amdgcn_s_setprio(1); _Pragma("unroll") for (int m = 0; m < 4; ++m) _Pragma("unroll") for (int n = 0; n < 2; ++n) _Pragma("unroll") for (int k = 0; k < 2; ++k) \
        acc[ai][bj][m][n] = __builtin_amdgcn_mfma_f32_16x16x32_bf16(Bt[n][k], At[m][k], acc[ai][bj][m][n], 0, 0, 0); __builtin_amdgcn_s_setprio(0); } while (0)
#define PG8_WAIT_V(n) asm volatile("s_waitcnt vmcnt(" #n ")" ::: "memory")
#define PG8_WAIT_L(n) asm volatile("s_waitcnt lgkmcnt(" #n ")" ::: "memory")
#define PG8_BAR __builtin_amdgcn_s_barrier()
#define PG8_SCHED __builtin_amdgcn_sched_barrier(0)
    Unit cur; int ui = 0;
    if (!S.next(0, cur)) return;
    f32x4 acc[2][2][4][2];
#pragma unroll
    for (int a = 0; a < 2; ++a)
#pragma unroll
        for (int b = 0; b < 2; ++b)
#pragma unroll
            for (int m = 0; m < 4; ++m)
#pragma unroll
                for (int n = 0; n < 2; ++n) acc[a][b][m][n] = (f32x4){0.f, 0.f, 0.f, 0.f};
    bf16x8 At[4][2], B0[2][2], B1[2][2];
    const char* cA = (const char*)g.A + cur.aoff; const char* cB = (const char*)g.Bt + cur.boff;
    S.a_ready(cur);
    if constexpr (SP2) {
        PG8_STAGE(PG8_SB(0, 0), cB, voffB); PG8_STAGE(PG8_SB(0, 1), cB + hstepB, voffB); PG8_STAGE(PG8_SA(0, 0), cA, voffA); PG8_STAGE(PG8_SA(0, 1), cA + hstepA, voffA);
        if (wr == 1) PG8_BAR;
        PG8_WAIT_V(2); PG8_BAR;
        PG8_STAGE(PG8_SB(1, 0), cB + kstep, voffB); PG8_STAGE(PG8_SA(1, 0), cA + kstep, voffA); PG8_STAGE(PG8_SB(1, 1), cB + hstepB + kstep, voffB);
        PG8_WAIT_V(6); PG8_BAR;
    } else {
        PG8_STAGE(PG8_SB(0, 0), cB, voffB); PG8_STAGE(PG8_SA(0, 0), cA, voffA); PG8_STAGE(PG8_SB(0, 1), cB + hstepB, voffB); PG8_STAGE(PG8_SA(0, 1), cA + hstepA, voffA);
        if (wr == 1) PG8_BAR;
        PG8_WAIT_V(4); PG8_BAR;
        PG8_STAGE(PG8_SB(1, 0), cB + kstep, voffB); PG8_STAGE(PG8_SA(1, 0), cA + kstep, voffA); PG8_STAGE(PG8_SB(1, 1), cB + hstepB + kstep, voffB);
        PG8_WAIT_V(6); PG8_BAR;
    }
    for (;;) {
        Unit nxt; const bool has_next = S.next(ui + 1, nxt);
        const char* nA = has_next ? (const char*)g.A + nxt.aoff : cA; const char* nB = has_next ? (const char*)g.Bt + nxt.boff : cB;
        const int nt = cur.nt;
        for (int t = 0; t < nt; t += 2) {
            const bool last = (t == nt - 2);
            const char* a1 = cA + (size_t)(t + 1) * kstep;
            const char* a2 = last ? nA : cA + (size_t)(t + 2) * kstep; const char* b2 = last ? nB : cB + (size_t)(t + 2) * kstep;
            const char* a3 = a2 + kstep; const char* b3 = b2 + kstep;
            if (last && has_next) S.a_ready(nxt);
            if constexpr (Epi::MID) { if (t == 8 || t == 12 || t == 16) E.mid(acc, cur, t, wr, wc, fr, fq); }
            if constexpr (SP2) {
            PG8_LDB(B0, 0, 0); PG8_LDB(B1, 0, 1); PG8_SCHED; PG8_LDA(At, 0, 0); PG8_STAGE(PG8_SA(1, 1), a1 + hstepA, voffA);
            PG8_WAIT_V(8); PG8_WAIT_L(0); PG8_BAR; PG8_MMA(0, 0, At, B0); PG8_MMA(0, 1, At, B1); PG8_BAR; PG8_SCHED;
            PG8_LDA(At, 0, 1); PG8_STAGE(PG8_SB(0, 0), b2, voffB); PG8_STAGE(PG8_SB(0, 1), b2 + hstepB, voffB); PG8_STAGE(PG8_SA(0, 0), a2, voffA);
            PG8_WAIT_V(8); PG8_WAIT_L(0); PG8_BAR; PG8_MMA(1, 0, At, B0); PG8_MMA(1, 1, At, B1); PG8_BAR; PG8_SCHED;
            PG8_LDB(B0, 1, 0); PG8_LDB(B1, 1, 1); PG8_SCHED; PG8_LDA(At, 1, 0); PG8_STAGE(PG8_SA(0, 1), a2 + hstepA, voffA);
            PG8_WAIT_V(8); PG8_WAIT_L(0); PG8_BAR; PG8_MMA(0, 0, At, B0); PG8_MMA(0, 1, At, B1); PG8_BAR; PG8_SCHED;
            PG8_LDA(At, 1, 1); PG8_STAGE(PG8_SB(1, 0), b3, voffB); PG8_STAGE(PG8_SB(1, 1), b3 + hstepB, voffB); PG8_STAGE(PG8_SA(1, 0), a3, voffA);
            PG8_WAIT_V(8); PG8_WAIT_L(0); PG8_BAR; PG8_MMA(1, 0, At, B0); PG8_MMA(1, 1, At, B1); PG8_BAR; PG8_SCHED;
            } else {
            PG8_LDB(B0, 0, 0); PG8_SCHED; PG8_LDA(At, 0, 0); PG8_STAGE(PG8_SA(1, 1), a1 + hstepA, voffA);
            PG8_WAIT_L(8); PG8_BAR; PG8_WAIT_L(0); PG8_MMA(0, 0, At, B0); PG8_BAR; PG8_SCHED;
            PG8_LDB(B1, 0, 1); PG8_STAGE(PG8_SB(0, 0), b2, voffB);
            PG8_BAR; PG8_WAIT_L(0); PG8_MMA(0, 1, At, B1); PG8_BAR;
            PG8_LDA(At, 0, 1); PG8_STAGE(PG8_SA(0, 0), a2, voffA);
            PG8_BAR; PG8_WAIT_L(0); PG8_MMA(1, 0, At, B0); PG8_BAR; PG8_SCHED;
            PG8_STAGE(PG8_SB(0, 1), b2 + hstepB, voffB);
            PG8_WAIT_V(6); PG8_BAR; PG8_MMA(1, 1, At, B1); PG8_BAR;
            PG8_LDB(B0, 1, 0); PG8_SCHED; PG8_LDA(At, 1, 0); PG8_STAGE(PG8_SA(0, 1), a2 + hstepA, voffA);
            PG8_WAIT_L(8); PG8_BAR; PG8_WAIT_L(0); PG8_MMA(0, 0, At, B0); PG8_BAR; PG8_SCHED;
            PG8_LDB(B1, 1, 1); PG8_STAGE(PG8_SB(1, 0), b3, voffB);
            PG8_BAR; PG8_WAIT_L(0); PG8_MMA(0, 1, At, B1); PG8_BAR;
            PG8_LDA(At, 1, 1); PG8_STAGE(PG8_SA(1, 0), a3, voffA);
            PG8_BAR; PG8_WAIT_L(0); PG8_MMA(1, 0, At, B0); PG8_BAR; PG8_SCHED;
            PG8_STAGE(PG8_SB(1, 1), b3 + hstepB, voffB);
            PG8_WAIT_V(6); PG8_BAR; PG8_MMA(1, 1, At, B1); PG8_BAR;
            }
        }
        if constexpr (ALIGN_EPI) { if (wr == 0) PG8_BAR; }
        if constexpr (!Epi::AFTER_DRAIN) { E(acc, cur, wr, wc, fr, fq); S.done(cur); }
        if (!has_next) break;
#pragma unroll
        for (int a = 0; a < 2; ++a)
#pragma unroll
            for (int b = 0; b < 2; ++b)
#pragma unroll
                for (int m = 0; m < 4; ++m)
#pragma unroll
                    for (int n = 0; n < 2; ++n) acc[a][b][m][n] = (f32x4){0.f, 0.f, 0.f, 0.f};
        cA = nA; cB = nB; ++ui; (void)S.next(ui, cur);
        if constexpr (ALIGN_EPI) { if (wr == 1) PG8_BAR; }
    }
    PG8_WAIT_V(0);
    if constexpr (!ALIGN_EPI) { if (wr == 0) PG8_BAR; }
    PG8_BAR;
    if constexpr (Epi::AFTER_DRAIN) { E.fused(acc, cur, wr, wc, fr, fq, lds, wid, lane); S.done(cur); }
#undef PG8_SA
#undef PG8_SB
#undef PG8_STAGE
#undef PG8_LDA
#undef PG8_LDB
#undef PG8_MMA
#undef PG8_WAIT_V
#undef PG8_WAIT_L
#undef PG8_BAR
#undef PG8_SCHED
}
}

#include <hip/hip_bf16.h>
#include <cmath>
namespace attn_body {
using bf16=__hip_bfloat16;
using bf16x8=__attribute__((ext_vector_type(8)))short;
using s16x4=__attribute__((ext_vector_type(4)))short;
using f32x16=__attribute__((ext_vector_type(16)))float;
using u32x4=__attribute__((ext_vector_type(4)))unsigned;
constexpr int BATCH=4,NHEAD=16,SEQ=8192,D=64;
constexpr int QP=1280,KP=512,VP=512,OP=1024;
constexpr int NW=8,QBLK=32,QB=QBLK*NW,KVBLK=64,NQB=SEQ/QB;
constexpr int ATTN_UNIT_ROWS=QB;
__device__ __forceinline__ int crow(int r,int hi){return (r&3)+8*(r>>2)+4*hi;}
#define SBAR() __builtin_amdgcn_sched_barrier(0)
__device__ __forceinline__ void cmask(f32x16&p0,f32x16&p1,int jb,int qrel,int hi){
  const float NEG=-INFINITY; int kb=64*jb+4*hi;
  #pragma unroll
  for(int r=0;r<16;++r){int kv=kb+(r&3)+8*(r>>2); if(kv>qrel)p0[r]=NEG; if(kv+32>qrel)p1[r]=NEG;}
}

constexpr int NSLOT=3, SLOTB=8192;
constexpr int LDS_K=0, LDS_V=NSLOT*SLOTB, LDS_WS=2*NSLOT*SLOTB, LDS_OST=LDS_WS+NW*64*4, LDS_BYTES=LDS_OST+NW*4096;
constexpr float C2=0.125f*1.4426950408889634f;
__device__ __forceinline__ void glds16(const void*gsrc,unsigned lds_dst){unsigned keep;
  asm volatile("s_mov_b32 %0, m0\n\ts_mov_b32 m0, %2\n\ts_nop 0\n\tglobal_load_lds_dwordx4 %1, off\n\ts_mov_b32 m0, %0":"=&s"(keep):"v"(gsrc),"s"(lds_dst):"memory");}
__device__ __forceinline__ float max3f(float a,float b,float c){float r;asm("v_max3_f32 %0, %1, %2, %3":"=v"(r):"v"(a),"v"(b),"v"(c));return r;}
__device__ __forceinline__ float max2f(float a,float b){float r;asm("v_max_f32_e32 %0, %1, %2":"=v"(r):"v"(a),"v"(b));return r;}
__device__ __forceinline__ float fadd_s(float a,float b){float r;asm("v_add_f32_e32 %0, %1, %2":"=v"(r):"v"(a),"v"(b));return r;}
__device__ __forceinline__ float fsub_s(float a,float b){float r;asm("v_sub_f32_e32 %0, %1, %2":"=v"(r):"v"(a),"v"(b));return r;}
typedef float f32x2_t __attribute__((ext_vector_type(2))); typedef __bf16 bf16x2_t __attribute__((ext_vector_type(2)));
__device__ __forceinline__ unsigned cvtpk_s(float lo,float hi){f32x2_t v={lo,hi};bf16x2_t b=__builtin_convertvector(v,bf16x2_t);return __builtin_bit_cast(unsigned,b);}
#define WAIT_BAR(N) asm volatile("s_waitcnt vmcnt(" #N ") lgkmcnt(0)\n\ts_barrier":::"memory")

__device__ __forceinline__ float rowmax(const f32x16&p0,const f32x16&p1){
  float a=max3f(p0[0],p0[1],p1[0]),b=max3f(p0[2],p0[3],p1[1]);a=max3f(a,p1[2],p1[3]);
  #pragma unroll
  for(int r=4;r<16;r+=4){a=max3f(a,p0[r],p0[r+1]);b=max3f(b,p0[r+2],p0[r+3]);a=max3f(a,p1[r],p1[r+1]);b=max3f(b,p1[r+2],p1[r+3]);}
  const float m=max2f(a,b);
  auto rr=__builtin_amdgcn_permlane32_swap(__float_as_uint(m),__float_as_uint(m),false,false);
  return max2f(__uint_as_float(rr[0]),__uint_as_float(rr[1]));
}

#undef SBAR
#undef WAIT_BAR
}

namespace attn2 {
using attn_body::bf16; using attn_body::bf16x8; using attn_body::s16x4; using attn_body::f32x16; using attn_body::u32x4; using attn_body::crow; using attn_body::cmask; using attn_body::glds16; using attn_body::rowmax; using attn_body::cvtpk_s;
constexpr int SEQ = 8192, QP = 1280, KP = 512, VP = 512, OP = 1024, NW = 8, QBLK = 32, QB = 256, KVBLK = 64, NSLOT = 3, NVSLOT = 4, KSLOT = 8192, VSLOT = 16384;
constexpr int LDS_K = 0, LDS_V = NSLOT * KSLOT, LDS_WS = LDS_V + NVSLOT * VSLOT, LDS_OST = LDS_WS + NW * 64 * 4, LDS_BYTES = LDS_OST + NW * 4096;
typedef __attribute__((address_space(3))) const char* lds_cptr; typedef short v4i16_t __attribute__((ext_vector_type(4)));
__device__ __forceinline__ s16x4 vtr(lds_cptr p) { return __builtin_bit_cast(s16x4, __builtin_amdgcn_ds_read_tr16_b64_v4i16((__attribute__((address_space(3))) v4i16_t*)p)); }
template <int THRL> __device__ __forceinline__ void attn_unit(int b, int hc, int qb, const bf16* Q, const bf16* __restrict__ K, const bf16* __restrict__ V, bf16* O, char* shm) {
    int tid_ = threadIdx.x; asm volatile("" : "+v"(tid_)); const int tid = tid_, lane = tid & 63, r32 = lane & 31, hi = lane >> 5; const int wid = __builtin_amdgcn_readfirstlane(tid >> 6);
    const int qcol = hc * 64, kcol = hc * 64, vcol = (hc >> 1) * 128, ocol = hc * 128;
    const long rowbase = (long)b * SEQ; const int q0 = qb * QB;
    const bf16* Qw = Q + (rowbase + q0 + wid * QBLK) * QP + qcol;
    const bf16 *Kh = K + rowbase * KP + kcol, *Vh = V + rowbase * VP + vcol;
    const unsigned lds0 = (unsigned)(uintptr_t)shm;
    float* wsf = (float*)(shm + LDS_WS) + wid * 64;
    const bf16* ksrc = Kh + (long)lane * KP + wid * 8;
    const bf16* vsrc = Vh + (long)(16 * (wid & 3) + (lane >> 2)) * VP + (wid >> 2) * 32 + (lane & 3) * 8;
    const unsigned kdst = lds0 + LDS_K + wid * 1024, vdst = lds0 + LDS_V + wid * 1024;
    const lds_cptr shm3 = (lds_cptr)shm; const lds_cptr vp0 = shm3 + LDS_V + ((lane >> 4) & 1) * 32 + (lane & 3) * 8 + (4 * hi + ((lane & 15) >> 2)) * 64;
    const int NT = (q0 + QB) / KVBLK;
#define A2_DMAK(t, sl) glds16(ksrc + (long)(t) * KVBLK * KP, (unsigned)__builtin_amdgcn_readfirstlane(kdst + (sl) * KSLOT))
#define A2_DMAV(t, sl) do { glds16(vsrc + (long)(t) * KVBLK * VP, (unsigned)__builtin_amdgcn_readfirstlane(vdst + (sl) * VSLOT)); glds16(vsrc + (long)(t) * KVBLK * VP + 64, (unsigned)__builtin_amdgcn_readfirstlane(vdst + (sl) * VSLOT + 8192)); } while (0)
    A2_DMAK(0, 0); A2_DMAV(0, 0); A2_DMAK(1, 1); A2_DMAV(1, 1);
    bf16x8 qr[4];
#pragma unroll
    for (int d0 = 0; d0 < 4; ++d0) qr[d0] = *reinterpret_cast<const bf16x8*>(&Qw[(long)r32 * QP + d0 * 16 + hi * 8]);
    float mhat = 0.f, l_reg = 0.f; f32x16 o[4]; o[0] = f32x16{}; o[1] = f32x16{}; o[2] = f32x16{}; o[3] = f32x16{};
    const int qrel = wid * QBLK + r32;
    u32x4 pw[4] = {};
    int slot = 0, slot2 = 2;
#define A2_PV(sl) do { const lds_cptr vp_ = vp0 + (sl) * VSLOT; _Pragma("unroll") for (int ks = 0; ks < 4; ++ks) { const bf16x8 pa = __builtin_bit_cast(bf16x8, pw[ks]); \
        _Pragma("unroll") for (int d0 = 0; d0 < 4; ++d0) { const s16x4 lo = vtr(vp_ + d0 * 4096 + ks * 1024), h4 = vtr(vp_ + d0 * 4096 + ks * 1024 + 512); \
            o[d0] = __builtin_amdgcn_mfma_f32_32x32x16_bf16(pa, (bf16x8){lo[0], lo[1], lo[2], lo[3], h4[0], h4[1], h4[2], h4[3]}, o[d0], 0, 0, 0); } } } while (0)
#define A2_VRD(i_) do { const int d0_ = (i_) & 3, ks_ = (i_) >> 2; vlo[(i_) % 3] = vtr(vp_ + d0_ * 4096 + ks_ * 1024); vhi[(i_) % 3] = vtr(vp_ + d0_ * 4096 + ks_ * 1024 + 512); } while (0)
typedef float f32x2a __attribute__((ext_vector_type(2)));
#define A2_PE2(P, e_) do { f32x2a d_ = (f32x2a){P[e_], P[(e_) + 1]} - mhat2; P[e_] = __builtin_amdgcn_exp2f(d_.x); P[(e_) + 1] = __builtin_amdgcn_exp2f(d_.y); } while (0)
#define A2_GAP(i_) do { if ((i_) + 2 < 16) A2_VRD((i_) + 2); \
        o[(i_) & 3] = __builtin_amdgcn_mfma_f32_32x32x16_bf16(__builtin_bit_cast(bf16x8, pw[(i_) >> 2]), (bf16x8){vlo[(i_) % 3][0], vlo[(i_) % 3][1], vlo[(i_) % 3][2], vlo[(i_) % 3][3], vhi[(i_) % 3][0], vhi[(i_) % 3][1], vhi[(i_) % 3][2], vhi[(i_) % 3][3]}, o[(i_) & 3], 0, 0, 0); \
        if ((i_) < 8) { A2_PE2(p0, 2 * (i_)); asm volatile("" : "+v"(p0)); } else { A2_PE2(p1, 2 * (i_) - 16); asm volatile("" : "+v"(p1)); } \
        __builtin_amdgcn_sched_barrier(0); } while (0)
#define A2_STEP(MASKED) do { \
          \
        if (t + 1 < NT) asm volatile("s_waitcnt vmcnt(5) lgkmcnt(0)\n\ts_barrier" ::: "memory"); \
        else asm volatile("s_waitcnt vmcnt(2) lgkmcnt(0)\n\ts_barrier" ::: "memory"); \
        if (t + 2 < NT) { A2_DMAK(t + 2, slot2); A2_DMAV(t + 2, (vslotp + 3) & 3); } \
        __builtin_amdgcn_sched_barrier(0); \
        f32x16 p0 = f32x16{}, p1 = f32x16{}; \
        const char* kb = shm + LDS_K + slot * KSLOT + hi * 1024 + r32 * 16; \
        const lds_cptr vp_ = vp0 + (t == 0 ? 0 : vslotp) * VSLOT; s16x4 vlo[3], vhi[3]; \
        _Pragma("unroll") for (int d0 = 0; d0 < 4; ++d0) { const bf16x8 b0 = *reinterpret_cast<const bf16x8*>(kb + d0 * 2048), b1 = *reinterpret_cast<const bf16x8*>(kb + d0 * 2048 + 512); \
            p0 = __builtin_amdgcn_mfma_f32_32x32x16_bf16(b0, qr[d0], p0, 0, 0, 0); p1 = __builtin_amdgcn_mfma_f32_32x32x16_bf16(b1, qr[d0], p1, 0, 0, 0); } \
        A2_VRD(0); A2_VRD(1); \
        if (MASKED) cmask(p0, p1, t - (NT - 4), qrel, hi); \
        asm volatile("s_nop 15\n\ts_nop 7" : "+v"(p0), "+v"(p1));        \
        const float rm = rowmax(p0, p1) - mhat; \
        resc = __any(rm > (float)THRL); \
        const float dl = resc ? __builtin_fmaxf(rm, 0.f) : 0.f; mhat += dl; \
        fsc = __builtin_amdgcn_exp2f(-dl); const f32x2a mhat2 = {mhat, mhat}; \
        __builtin_amdgcn_sched_barrier(0); \
        A2_GAP(0); A2_GAP(1); A2_GAP(2); A2_GAP(3); A2_GAP(4); A2_GAP(5); A2_GAP(6); A2_GAP(7); A2_GAP(8); A2_GAP(9); A2_GAP(10); A2_GAP(11); A2_GAP(12); A2_GAP(13); A2_GAP(14); A2_GAP(15); \
        f32x2a s2_ = {0.f, 0.f}; \
        _Pragma("unroll") for (int r = 0; r < 16; r += 2) { s2_ += (f32x2a){p0[r], p0[r + 1]}; s2_ += (f32x2a){p1[r], p1[r + 1]}; }        \
        l_reg = l_reg * fsc + (s2_.x + s2_.y); \
        pw[0] = (u32x4){cvtpk_s(p0[0], p0[1]), cvtpk_s(p0[2], p0[3]), cvtpk_s(p0[4], p0[5]), cvtpk_s(p0[6], p0[7])}; pw[1] = (u32x4){cvtpk_s(p0[8], p0[9]), cvtpk_s(p0[10], p0[11]), cvtpk_s(p0[12], p0[13]), cvtpk_s(p0[14], p0[15])}; \
        pw[2] = (u32x4){cvtpk_s(p1[0], p1[1]), cvtpk_s(p1[2], p1[3]), cvtpk_s(p1[4], p1[5]), cvtpk_s(p1[6], p1[7])}; pw[3] = (u32x4){cvtpk_s(p1[8], p1[9]), cvtpk_s(p1[10], p1[11]), cvtpk_s(p1[12], p1[13]), cvtpk_s(p1[14], p1[15])}; \
        if (resc) { if (hi == 0) wsf[r32] = fsc;                   \
            asm volatile("s_waitcnt lgkmcnt(0)" ::: "memory"); \
            _Pragma("unroll") for (int r = 0; r < 16; ++r) { const float fr = wsf[crow(r, hi)]; \
                _Pragma("unroll") for (int d = 0; d < 4; ++d) o[d][r] *= fr; } } \
        slot2 = slot; slot = slot == NSLOT - 1 ? 0 : slot + 1; vslotp = (vslotp + 1) & 3;        \
    } while (0)
    bool resc = false; float fsc = 1.f; int vslotp = 3;
    int t = 0;
    if (wid >= 4) __builtin_amdgcn_s_setprio(1);
    for (; t < NT - 4; ++t) A2_STEP(false);
    for (; t < NT; ++t) A2_STEP(true);
    __builtin_amdgcn_s_setprio(0);
#undef A2_STEP
#undef A2_GAP
#undef A2_PE2
#undef A2_VRD
    asm volatile("s_waitcnt vmcnt(0) lgkmcnt(0)\n\ts_barrier" ::: "memory");
    A2_PV(vslotp);
#undef A2_PV
#undef A2_DMAK
#undef A2_DMAV
    { auto rr = __builtin_amdgcn_permlane32_swap(__float_as_uint(l_reg), __float_as_uint(l_reg), false, false); l_reg = __uint_as_float(rr[0]) + __uint_as_float(rr[1]); }
    if (hi == 0) wsf[32 + r32] = l_reg; asm volatile("s_waitcnt lgkmcnt(0)" ::: "memory");
    float rli[16];
#pragma unroll
    for (int r = 0; r < 16; ++r) rli[r] = __builtin_amdgcn_rcpf(wsf[32 + crow(r, hi)]);
    bf16* Ow = O + (rowbase + q0 + wid * QBLK) * OP + ocol;
    bf16* stg = (bf16*)(shm + LDS_OST) + wid * 2048;
#pragma unroll
    for (int pass = 0; pass < 2; ++pass) {
#pragma unroll
        for (int r = 0; r < 16; ++r) { const int orow = crow(r, hi);
#pragma unroll
            for (int d0 = 0; d0 < 2; ++d0) stg[orow * 64 + d0 * 32 + r32] = __float2bfloat16(o[2 * pass + d0][r] * rli[r]); }
        asm volatile("s_waitcnt lgkmcnt(0)" ::: "memory");
#pragma unroll
        for (int i = 0; i < 4; ++i) { const int row = i * 8 + (lane >> 3), ch = lane & 7; const u32x4 v = *(const u32x4*)(stg + row * 64 + ch * 8); *(u32x4*)(Ow + (long)row * OP + pass * 64 + ch * 8) = v; }
        asm volatile("s_waitcnt lgkmcnt(0)" ::: "memory");
    }
    asm volatile("s_waitcnt lgkmcnt(0)\n\ts_barrier" ::: "memory");
}
struct AttnTensors { const bf16* Q; const bf16* K; const bf16* V; bf16* O; };
struct AttnUnit { int bh; int qb; };
struct StaticOrder {
    int vcu, G;
    __device__ __forceinline__ explicit StaticOrder(int grid, int block) : vcu((grid % 8 == 0) ? (block % 8) * (grid / 8) + block / 8 : block), G(grid) {}
    __device__ __forceinline__ bool next(int i, AttnUnit& u) const { const int oct = vcu + (i >> 2) * G; if (oct >= 256) return false; const int s = oct & 7, ii = i & 3; u.bh = oct >> 3; u.qb = (ii == 0) ? s : (ii == 1) ? 15 - s : (ii == 2) ? 16 + s : 31 - s; return true; }
};
template <int THRL = 8> __device__ __forceinline__ void attn_phase(char* lds, const AttnTensors& T, const StaticOrder& S) {
    AttnUnit u;
    for (int i = 0; S.next(i, u); ++i) attn_unit<THRL>(u.bh >> 3, u.bh & 7, u.qb, T.Q, T.K, T.V, T.O, lds);
}
}

namespace tile {
typedef short bf16x8 __attribute__((ext_vector_type(8)));
typedef short s16x4 __attribute__((ext_vector_type(4)));
typedef float f32x16 __attribute__((ext_vector_type(16)));
constexpr int TP = 72;
__device__ __forceinline__ int crow(int r, int hi) { return (r & 3) + 8 * (r >> 2) + 4 * hi; }
__device__ __forceinline__ bf16x8 frag_row(const LAS bf16_t* T, int r0, int k0, int lane) { return *(const LAS bf16x8*)(T + (r0 + (lane & 31)) * TP + k0 + 8 * (lane >> 5)); }
__device__ __forceinline__ bf16x8 frag_tr(const LAS bf16_t* T, int ra, int rb, int c0, int lane) {
    const int hi = lane >> 5, g16 = (lane >> 4) & 1, q = (lane & 15) >> 2, p = lane & 3;
    const LAS bf16_t* a0 = T + (ra + 4 * hi + q) * TP + c0 + 16 * g16 + 4 * p; const LAS bf16_t* a1 = T + (rb + 4 * hi + q) * TP + c0 + 16 * g16 + 4 * p;
    const s16x4 lo = __builtin_bit_cast(s16x4, __builtin_amdgcn_ds_read_tr16_b64_v4i16((LAS s16x4*)a0)), hi4 = __builtin_bit_cast(s16x4, __builtin_amdgcn_ds_read_tr16_b64_v4i16((LAS s16x4*)a1));
    return (bf16x8){lo[0], lo[1], lo[2], lo[3], hi4[0], hi4[1], hi4[2], hi4[3]};
}
__device__ __forceinline__ bf16x8 frag_tr_nat(const LAS bf16_t* T, int k0, int c0, int lane) {
    const int hi = lane >> 5, g16 = (lane >> 4) & 1, q = (lane & 15) >> 2, p = lane & 3;
    const LAS bf16_t* a0 = T + (k0 + 8 * hi + q) * TP + c0 + 16 * g16 + 4 * p;
    const s16x4 lo = __builtin_bit_cast(s16x4, __builtin_amdgcn_ds_read_tr16_b64_v4i16((LAS s16x4*)a0)), hi4 = __builtin_bit_cast(s16x4, __builtin_amdgcn_ds_read_tr16_b64_v4i16((LAS s16x4*)(a0 + 4 * TP)));
    return (bf16x8){lo[0], lo[1], lo[2], lo[3], hi4[0], hi4[1], hi4[2], hi4[3]};
}
__device__ __forceinline__ unsigned cvtpk(float lo, float hi) { typedef float f2 __attribute__((ext_vector_type(2))); typedef __bf16 b2 __attribute__((ext_vector_type(2))); f2 v = {lo, hi}; return __builtin_bit_cast(unsigned, __builtin_convertvector(v, b2)); }
__device__ __forceinline__ bf16x8 acc_frag(const f32x16& x, int s_) { u32x4 w; w.x = cvtpk(x[8 * s_], x[8 * s_ + 1]); w.y = cvtpk(x[8 * s_ + 2], x[8 * s_ + 3]); w.z = cvtpk(x[8 * s_ + 4], x[8 * s_ + 5]); w.w = cvtpk(x[8 * s_ + 6], x[8 * s_ + 7]); return __builtin_bit_cast(bf16x8, w); }
#define MFMA32(a, b, c) __builtin_amdgcn_mfma_f32_32x32x16_bf16((a), (b), (c), 0, 0, 0)
}

__device__ __forceinline__ void sb_phase(LAS unsigned char* lds, bf16_t* QO, int ldq, const bf16_t* __restrict__ Kb, const bf16_t* __restrict__ Vb, int gw, int ngw, int wave, int lane) {
    using namespace tile;
    LAS bf16_t* Kt = (LAS bf16_t*)(lds + wave * 16384); LAS bf16_t* Vt = Kt + 32 * TP; LAS bf16_t* Ot = Vt + 32 * TP;
    const int hi = lane >> 5, ql = lane & 31;
    bf16x8 uf[2];
#pragma unroll
    for (int s_ = 0; s_ < 2; ++s_)
#pragma unroll
        for (int j = 0; j < 8; ++j) uf[s_][j] = (16 * s_ + 8 * (j >> 2) + 4 * hi + (j & 3)) > ql ? (short)0x3F80 : (short)0;
    for (int unit = gw; unit < NTOK * 4 / 32; unit += ngw) {
        const int qb = unit & 255, h = (unit >> 8) & 3, b = unit >> 10, q0 = qb * 32; const size_t rb = (size_t)b * SEQ;
        bf16x8 qf[4];
#pragma unroll
        for (int s_ = 0; s_ < 4; ++s_) qf[s_] = *(const bf16x8*)(QO + (rb + q0 + ql) * ldq + h * 64 + 16 * s_ + 8 * hi);
        f32x16 o0 = {}, o1 = {}; float carry = 0.f;
        u32x4 kp[4], vp[4];
#define SB_LOAD(k0_) do { _Pragma("unroll") for (int i = 0; i < 4; ++i) { const int c = lane + 64 * i, row = c >> 3, c16 = c & 7; \
            kp[i] = *(const u32x4*)(Kb + (rb + (k0_) + row) * 256 + h * 64 + c16 * 8); vp[i] = *(const u32x4*)(Vb + (rb + (k0_) + row) * 256 + h * 64 + c16 * 8); } } while (0)
#define SB_STORE() do { _Pragma("unroll") for (int i = 0; i < 4; ++i) { const int c = lane + 64 * i, row = c >> 3, c16 = c & 7; *(LAS u32x4*)(Kt + row * TP + c16 * 8) = kp[i]; *(LAS u32x4*)(Vt + row * TP + c16 * 8) = vp[i]; } } while (0)
        SB_LOAD(q0);
        for (int k0 = q0; k0 >= 0; k0 -= 32) {
            asm volatile("s_waitcnt lgkmcnt(0)" ::: "memory");
            SB_STORE();
            if (k0 >= 32) SB_LOAD(k0 - 32);
            asm volatile("s_waitcnt lgkmcnt(0)" ::: "memory");
            f32x16 p = {};
#pragma unroll
            for (int s_ = 0; s_ < 4; ++s_) p = MFMA32(frag_row(Kt, 0, 16 * s_, lane), qf[s_], p);
            f32x16 lk, z;
            const bool diag = (k0 == q0);
#pragma unroll
            for (int r = 0; r < 16; ++r) { z[r] = p[r] * 0.125f; const bool valid = !diag || crow(r, hi) < ql; const float az = fabsf(z[r]);
                const float sp = fmaxf(z[r], 0.f) + __logf(1.f + __expf(-az)); lk[r] = valid ? -sp : 0.f; }
            f32x16 lo_;
#pragma unroll
            for (int r = 0; r < 16; ++r) { const float hb = __uint_as_float(__float_as_uint(lk[r]) & 0xffff0000u); lo_[r] = lk[r] - hb; p[r] = hb; }
            f32x16 cs = {};
#pragma unroll
            for (int s_ = 0; s_ < 2; ++s_) { cs = MFMA32(uf[s_], acc_frag(p, s_), cs); cs = MFMA32(uf[s_], acc_frag(lo_, s_), cs); }
            const float tot = shl_(cs[0] + lk[0], ql);
            f32x16 w;
#pragma unroll
            for (int r = 0; r < 16; ++r) { const bool valid = !diag || crow(r, hi) < ql; w[r] = valid ? __expf(z[r] + lk[r] + cs[r] + carry) : 0.f; }
            carry += tot;
#pragma unroll
            for (int s_ = 0; s_ < 2; ++s_) { const bf16x8 wf = acc_frag(w, s_);
                o0 = MFMA32(frag_tr(Vt, 16 * s_, 16 * s_ + 8, 0, lane), wf, o0); o1 = MFMA32(frag_tr(Vt, 16 * s_, 16 * s_ + 8, 32, lane), wf, o1); }
            if (__all(carry < -104.f)) break;
        }
#undef SB_LOAD
#undef SB_STORE
        asm volatile("s_waitcnt lgkmcnt(0)" ::: "memory");
#pragma unroll
        for (int r = 0; r < 16; ++r) { Ot[ql * TP + crow(r, hi)] = f2bf(o0[r]); Ot[ql * TP + 32 + crow(r, hi)] = f2bf(o1[r]); }
        asm volatile("s_waitcnt lgkmcnt(0)" ::: "memory");
#pragma unroll
        for (int i = 0; i < 4; ++i) { const int c = lane + 64 * i, row = c >> 3, c16 = c & 7; *(u32x4*)(QO + (rb + q0 + row) * ldq + h * 64 + c16 * 8) = *(const LAS u32x4*)(Ot + row * TP + c16 * 8); }
    }
}

__device__ __forceinline__ float hg_lb(const float* lbl, int layer, int c) { if (layer == 0) return 0.f; const float a0 = lbl[c], a1 = lbl[256 + c]; return 1.f / (1.f + __expf(a0 - a1)); }
__device__ __forceinline__ float hg_logf(float z, float lb) {
    if (lb == 0.f) return -(fmaxf(-z, 0.f) + __logf(1.f + __expf(-fabsf(z))));
    return __logf(lb + (1.f - lb) * __builtin_amdgcn_rcpf(1.f + __expf(-z)));
}
__device__ __forceinline__ void hg_local(LAS unsigned char* lds, const bf16_t* __restrict__ F, const bf16_t* __restrict__ Iv, const float* lbl, int layer, float* __restrict__ st, float* __restrict__ dec,
                                         int gw, int ngw, int wave, int lane) {
    using namespace tile;
    LAS bf16_t* Zt = (LAS bf16_t*)(lds + wave * 16384); LAS bf16_t* Vt = Zt + 64 * TP;
    const int hi = lane >> 5, ql = lane & 31;
    for (int unit = gw; unit < 2048; unit += ngw) {
        const int chunk = unit & 127, h = (unit >> 7) & 3, b = unit >> 9; const size_t tok0 = (size_t)b * SEQ + chunk * 64;
        const float lb = hg_lb(lbl, layer, h * 64 + lane);
        float lf[64]; float bend = 0.f;
#pragma unroll
        for (int t = 0; t < 64; ++t) { lf[t] = hg_logf(bf2f(F[(tok0 + t) * 256 + h * 64 + lane]), lb); bend += lf[t]; }
        dec[unit * 64 + lane] = __expf(bend);
        asm volatile("s_waitcnt lgkmcnt(0)" ::: "memory");
        { float bb = 0.f;
#pragma unroll
          for (int t = 0; t < 64; ++t) { bb += lf[t]; Zt[t * TP + lane] = f2bf((1.f - __expf(lf[t])) * __expf(bend - bb)); } }
        f32x16 acc[2][2] = {};
#pragma unroll
        for (int half = 0; half < 2; ++half) {
            u32x4 vp[4];
#pragma unroll
            for (int i = 0; i < 4; ++i) { const int c = lane + 64 * i, row = c >> 3, c16 = c & 7; vp[i] = *(const u32x4*)(Iv + (tok0 + half * 32 + row) * 256 + h * 64 + c16 * 8); }
            asm volatile("s_waitcnt lgkmcnt(0)" ::: "memory");
#pragma unroll
            for (int i = 0; i < 4; ++i) { const int c = lane + 64 * i, row = c >> 3, c16 = c & 7; *(LAS u32x4*)(Vt + row * TP + c16 * 8) = vp[i]; }
            asm volatile("s_waitcnt lgkmcnt(0)" ::: "memory");
#pragma unroll
            for (int s2 = 0; s2 < 2; ++s2) { const int t0 = half * 32 + 16 * s2;
                const bf16x8 a0 = frag_tr_nat(Zt, t0, 0, lane), a1 = frag_tr_nat(Zt, t0, 32, lane), b0 = frag_tr_nat(Vt, 16 * s2, 0, lane), b1 = frag_tr_nat(Vt, 16 * s2, 32, lane);
                acc[0][0] = MFMA32(a0, b0, acc[0][0]); acc[0][1] = MFMA32(a0, b1, acc[0][1]); acc[1][0] = MFMA32(a1, b0, acc[1][0]); acc[1][1] = MFMA32(a1, b1, acc[1][1]); }
        }
        float* o = st + (size_t)unit * 4096;
#pragma unroll
        for (int kb = 0; kb < 2; ++kb)
#pragma unroll
            for (int vb = 0; vb < 2; ++vb)
#pragma unroll
                for (int r = 0; r < 16; ++r) o[(kb * 32 + crow(r, hi)) * 64 + vb * 32 + ql] = acc[kb][vb][r];
    }
}
__device__ __forceinline__ void hg_scan(float* st, const float* __restrict__ dec, int gtid, int nthr) {
    for (int e = gtid - 65536; e < 65536; e += nthr) { if (e < 0) continue;
        const int bh = e >> 12, kv = e & 4095, k = kv >> 6; float S = 0.f;
        for (int c0 = 0; c0 < 128; c0 += 16) { float lc[16], dc[16];
#pragma unroll
            for (int j = 0; j < 16; ++j) { lc[j] = st[(size_t)(bh * 128 + c0 + j) * 4096 + kv]; dc[j] = dec[(bh * 128 + c0 + j) * 64 + k]; }
#pragma unroll
            for (int j = 0; j < 16; ++j) { st[(size_t)(bh * 128 + c0 + j) * 4096 + kv] = S; S = dc[j] * S + lc[j]; } }
    }
}
__device__ __forceinline__ void hg_out(LAS unsigned char* lds, const bf16_t* __restrict__ F, const bf16_t* __restrict__ Iv, bf16_t* QY, int ldq, const bf16_t* __restrict__ Gt, const float* lbl, int layer,
                                       const float* __restrict__ og, const float* __restrict__ st, int gw, int ngw, int wave, int lane) {
    using namespace tile;
    LAS bf16_t* bA = (LAS bf16_t*)(lds + wave * 16384); LAS bf16_t* Z = bA + 32 * TP;
    const int hi = lane >> 5, ql = lane & 31;
    for (int unit = gw; unit < 4096; unit += ngw) {
        const int I = unit & 1, cu = unit >> 1, chunk = cu & 127, h = (cu >> 7) & 3, b = cu >> 9; const size_t tok0 = (size_t)b * SEQ + chunk * 64;
        const float lb = hg_lb(lbl, layer, h * 64 + lane);
        const float* S = st + (size_t)cu * 4096;
        {   u32x4 zq[12];
#pragma unroll
            for (int i = 0; i < 4; ++i) { const int c = lane + 64 * i, row = c >> 3, c16 = c & 7; zq[i] = *(const u32x4*)(F + (tok0 + row) * 256 + h * 64 + c16 * 8); zq[8 + i] = *(const u32x4*)(QY + (tok0 + 32 * I + row) * ldq + h * 64 + c16 * 8); }
            if (I) {
#pragma unroll
                for (int i = 0; i < 4; ++i) { const int c = lane + 64 * i, row = c >> 3, c16 = c & 7; zq[4 + i] = *(const u32x4*)(F + (tok0 + 32 + row) * 256 + h * 64 + c16 * 8); } }
            asm volatile("s_waitcnt lgkmcnt(0)" ::: "memory");
#pragma unroll
            for (int i = 0; i < 4; ++i) { const int c = lane + 64 * i, row = c >> 3, c16 = c & 7; *(LAS u32x4*)(Z + row * TP + c16 * 8) = zq[i]; *(LAS u32x4*)(bA + row * TP + c16 * 8) = zq[8 + i]; }
            if (I) {
#pragma unroll
                for (int i = 0; i < 4; ++i) { const int c = lane + 64 * i, row = c >> 3, c16 = c & 7; *(LAS u32x4*)(Z + (32 + row) * TP + c16 * 8) = zq[4 + i]; } }
        }
        asm volatile("s_waitcnt lgkmcnt(0)" ::: "memory");
        float bref = 0.f;
        if (I) { float lfp[32];
#pragma unroll
            for (int t = 0; t < 32; ++t) { lfp[t] = hg_logf(bf2f(Z[t * TP + lane]), lb); bref += lfp[t]; }
            float bb = 0.f;
#pragma unroll
            for (int t = 0; t < 32; ++t) { bb += lfp[t]; Z[t * TP + lane] = f2bf((1.f - __expf(lfp[t])) * __expf(bref - bb)); } }
        { LAS bf16_t* Zb = Z + 32 * I * TP; float bb = 0.f;
#pragma unroll
          for (int t = 0; t < 32; ++t) { const float lf = hg_logf(bf2f(Zb[t * TP + lane]), lb); bb += lf; const float eb = __expf(bb);
              bA[t * TP + lane] = f2bf(bf2f(bA[t * TP + lane]) * eb); Zb[t * TP + lane] = f2bf((1.f - __expf(lf)) * __expf(fminf(-bb, 80.f))); } }
        asm volatile("s_waitcnt lgkmcnt(0)" ::: "memory");
        bf16x8 qf[4];
#pragma unroll
        for (int s4 = 0; s4 < 4; ++s4) qf[s4] = frag_row(bA, 0, 16 * s4, lane);
        f32x16 o0 = {}, o1 = {};
        const float es = __expf(bref);
#pragma unroll
        for (int kh = 0; kh < 2; ++kh) {
            f32x4 sv[8];
#pragma unroll
            for (int i = 0; i < 8; ++i) { const int c = lane + 64 * i, row = c >> 4, c4 = c & 15; sv[i] = *(const f32x4*)(S + (32 * kh + row) * 64 + c4 * 4); }
            asm volatile("s_waitcnt lgkmcnt(0)" ::: "memory");
#pragma unroll
            for (int i = 0; i < 8; ++i) { const int c = lane + 64 * i, row = c >> 4, c4 = c & 15; const float sc = shl_(es, 32 * kh + row);
                u32x2 w; w.x = cvtpk(sv[i][0] * sc, sv[i][1] * sc); w.y = cvtpk(sv[i][2] * sc, sv[i][3] * sc); *(LAS u32x2*)(bA + row * TP + c4 * 4) = w; }
            asm volatile("s_waitcnt lgkmcnt(0)" ::: "memory");
#pragma unroll
            for (int s2 = 0; s2 < 2; ++s2) { const bf16x8 q_ = qf[2 * kh + s2]; o0 = MFMA32(frag_tr_nat(bA, 16 * s2, 0, lane), q_, o0); o1 = MFMA32(frag_tr_nat(bA, 16 * s2, 32, lane), q_, o1); }
        }
        for (int J = 0; J <= I; ++J) {
            u32x4 vp[4];
#pragma unroll
            for (int i = 0; i < 4; ++i) { const int c = lane + 64 * i, row = c >> 3, c16 = c & 7; vp[i] = *(const u32x4*)(Iv + (tok0 + 32 * J + row) * 256 + h * 64 + c16 * 8); }
            asm volatile("s_waitcnt lgkmcnt(0)" ::: "memory");
#pragma unroll
            for (int i = 0; i < 4; ++i) { const int c = lane + 64 * i, row = c >> 3, c16 = c & 7; *(LAS u32x4*)(bA + row * TP + c16 * 8) = vp[i]; }
            asm volatile("s_waitcnt lgkmcnt(0)" ::: "memory");
            f32x16 pt = {};
#pragma unroll
            for (int s4 = 0; s4 < 4; ++s4) pt = MFMA32(frag_row(Z, 32 * J, 16 * s4, lane), qf[s4], pt);
            if (J == I) {
#pragma unroll
                for (int r = 0; r < 16; ++r) pt[r] = crow(r, hi) <= ql ? pt[r] : 0.f; }
#pragma unroll
            for (int s2 = 0; s2 < 2; ++s2) { const bf16x8 pf = acc_frag(pt, s2); o0 = MFMA32(frag_tr(bA, 16 * s2, 16 * s2 + 8, 0, lane), pf, o0); o1 = MFMA32(frag_tr(bA, 16 * s2, 16 * s2 + 8, 32, lane), pf, o1); }
        }
        float ss = 0.f;
#pragma unroll
        for (int r = 0; r < 16; ++r) ss += o0[r] * o0[r] + o1[r] * o1[r];
        ss += shx(ss, 32, lane);
        const float rr = rsqrtf(ss * (1.f / 64.f) + RMS_EPS);
        u32x4 gv[4];
#pragma unroll
        for (int i = 0; i < 4; ++i) { const int c = lane + 64 * i, row = c >> 3, c16 = c & 7; gv[i] = *(const u32x4*)(Gt + (tok0 + 32 * I + row) * 256 + h * 64 + c16 * 8); }
        asm volatile("s_waitcnt lgkmcnt(0)" ::: "memory");
#pragma unroll
        for (int r = 0; r < 16; ++r) { bA[ql * TP + crow(r, hi)] = f2bf(o0[r] * rr); bA[ql * TP + 32 + crow(r, hi)] = f2bf(o1[r] * rr); }
        asm volatile("s_waitcnt lgkmcnt(0)" ::: "memory");
#pragma unroll
        for (int i = 0; i < 4; ++i) { const int c = lane + 64 * i, row = c >> 3, c16 = c & 7; const size_t tok = tok0 + 32 * I + row;
            const u32x4 ov = *(const LAS u32x4*)(bA + row * TP + c16 * 8); const unsigned ow[4] = {ov.x, ov.y, ov.z, ov.w}, gw_[4] = {gv[i].x, gv[i].y, gv[i].z, gv[i].w}; float y[8];
#pragma unroll
            for (int j = 0; j < 4; ++j) { const float g0 = __uint_as_float(gw_[j] << 16), g1 = __uint_as_float(gw_[j] & 0xffff0000u);
                y[2 * j] = __uint_as_float(ow[j] << 16) * og[c16 * 8 + 2 * j] * g0 * __builtin_amdgcn_rcpf(1.f + __expf(-g0)); y[2 * j + 1] = __uint_as_float(ow[j] & 0xffff0000u) * og[c16 * 8 + 2 * j + 1] * g1 * __builtin_amdgcn_rcpf(1.f + __expf(-g1)); }
            u32x4 w; w.x = cvtpk(y[0], y[1]); w.y = cvtpk(y[2], y[3]); w.z = cvtpk(y[4], y[5]); w.w = cvtpk(y[6], y[7]);
            *(u32x4*)(QY + tok * ldq + h * 64 + c16 * 8) = w; }
    }
}

#define XB_TMO      128
#define XB_XCNT(j)  (256  + 64 * (j))
#define XB_XSUB(j)  (1280 + 64 * (j))
#define XB_XGEN(j)  (2304 + 64 * (j))
#define XB_TOP      3328
#define XB_TOPGEN   3392
#define XCD_BAR_WORDS 3456
#define XB_SPIN_CAP (1u << 18)

__device__ __forceinline__ unsigned xb_ld(unsigned* p)              { return __hip_atomic_load(p, __ATOMIC_RELAXED, __HIP_MEMORY_SCOPE_AGENT); }
__device__ __forceinline__ unsigned xb_add(unsigned* p, unsigned v) { return __hip_atomic_fetch_add(p, v, __ATOMIC_RELAXED, __HIP_MEMORY_SCOPE_AGENT); }
__device__ __forceinline__ unsigned xb_xcc_id() { return (unsigned)__builtin_amdgcn_s_getreg((3 << 11) | 20) & 0xFu; }
#define XB_SPIN(cond, bar) do { unsigned _sp = 0; while (cond) { __builtin_amdgcn_s_sleep(1); \
    if ((++_sp & 255u) == 0u) { if (xb_ld(&(bar)[XB_TMO])) break; if (_sp > XB_SPIN_CAP) { atomicAdd(&(bar)[XB_TMO], 1u); break; } } } } while (0)

struct XcdBarrier {
    unsigned* bar; unsigned x;
    volatile LAS unsigned* st;
};

__device__ __forceinline__ XcdBarrier xcd_barrier_post(unsigned* bar, volatile LAS unsigned* st) {
    XcdBarrier b; b.bar = bar; b.x = xb_xcc_id(); b.st = st;
    if (threadIdx.x == 0) (void)xb_add(&bar[XB_XCNT(b.x)], 1u);
    return b;
}
__device__ __forceinline__ void xcd_barrier_complete(unsigned* bar, unsigned x, unsigned& nloc, unsigned& nx) {
    const unsigned G = gridDim.x * gridDim.y * gridDim.z;
    unsigned sum, cnt, mine, sp = 0u;
    for (;;) {
        sum = 0u; cnt = 0u; mine = 0u;
#pragma unroll
        for (unsigned j = 0; j < 16; ++j) { const unsigned c = xb_ld(&bar[XB_XCNT(j)]); sum += c; cnt += (c > 0u) ? 1u : 0u; mine = (j == x) ? c : mine; }
        if (sum == G) break;
        __builtin_amdgcn_s_sleep(1);
        if ((++sp & 255u) == 0u) { if (xb_ld(&bar[XB_TMO])) break; if (sp > XB_SPIN_CAP) { atomicAdd(&bar[XB_TMO], 1u); break; } }
    }
    nloc = mine > 0u ? mine : 1u; nx = cnt > 0u ? cnt : 1u;
}

__device__ __forceinline__ void xcd_barrier(const XcdBarrier& b_) {
    XcdBarrier b = b_; { GAS unsigned* bg_ = (GAS unsigned*)b.bar; asm volatile("" : "+s"(bg_), "+s"(b.x)); b.bar = (unsigned*)bg_; }
    asm volatile("s_waitcnt vmcnt(0)" ::: "memory");
    __syncthreads();
    if (threadIdx.x == 0) {
        unsigned* bar = b.bar;
        __builtin_amdgcn_s_waitcnt(0);
        unsigned nloc = b.st[0], nx = b.st[1];
        if (nloc == 0u) { xcd_barrier_complete(bar, b.x, nloc, nx); b.st[0] = nloc; b.st[1] = nx; }
        const unsigned old = xb_add(&bar[XB_XSUB(b.x)], 1u);
        const unsigned gen = old / nloc;
        if (old + 1u == (gen + 1u) * nloc) {
            __builtin_amdgcn_fence(__ATOMIC_RELEASE, "agent");
            asm volatile("s_waitcnt vmcnt(0)" ::: "memory");
            const unsigned og = xb_add(&bar[XB_TOP], 1u);
            const unsigned tg = og / nx;
            if (og + 1u == (tg + 1u) * nx) xb_add(&bar[XB_TOPGEN], 1u);
            else XB_SPIN(xb_ld(&bar[XB_TOPGEN]) == tg, bar);
            __builtin_amdgcn_fence(__ATOMIC_ACQUIRE, "agent");
            xb_add(&bar[XB_XGEN(b.x)], 1u);
            asm volatile("s_waitcnt vmcnt(0)" ::: "memory");
        } else {
            XB_SPIN(xb_ld(&bar[XB_XGEN(b.x)]) == gen, bar);
            __builtin_amdgcn_fence(__ATOMIC_ACQUIRE, "agent");
            asm volatile("s_waitcnt vmcnt(0)" ::: "memory");
        }
    }
    __syncthreads();
}

#define LDS_WAIT() asm volatile("s_waitcnt lgkmcnt(0)" ::: "memory")
constexpr int NWAVES_ = 8;
__device__ __forceinline__ void tr_item(const float* __restrict__ W, int N, int k0, int n0, bf16_t* dst, int ldo, LAS float* scr, int lane, int rs = 1) {
#pragma unroll 8
    for (int i = 0; i < 32; ++i) { const int kk = 2 * i + (lane >> 5); scr[kk * 33 + (lane & 31)] = W[(size_t)(k0 + kk) * N + n0 + (lane & 31)]; }
    LDS_WAIT(); asm volatile("" ::: "memory");
    const int c = lane & 7;
#pragma unroll
    for (int j = 0; j < 4; ++j) { const int n = (lane >> 3) + 8 * j; const LAS float* s = scr + (8 * c) * 33 + n;
        u32x4 o; o.x = pk2(s[0 * 33], s[1 * 33]); o.y = pk2(s[2 * 33], s[3 * 33]); o.z = pk2(s[4 * 33], s[5 * 33]); o.w = pk2(s[6 * 33], s[7 * 33]);
        *(u32x4*)(dst + (size_t)n * rs * ldo + 8 * c) = o; }
    LDS_WAIT(); asm volatile("" ::: "memory");
}
struct LayerIn {
    const float *norm_mix, *w_in, *qg, *kg, *lq1, *lk1, *lq2, *lk2, *subln, *hg_lb, *hg_og, *s5_lre, *s5_lim, *s5_lstep, *s5_bre, *s5_bim, *s5_cre, *s5_cim, *s5_d, *glu_w, *glu_b,
                *pa, *pb, *pc, *pd, *w_out, *norm_ffn, *rgw, *rgb, *rew, *reb, *eg, *eu, *ed;
};
__device__ __forceinline__ void ph_weights(const CAS char* ka, int l, unsigned char* wts, LAS unsigned char* lds, int gw, int ngw, int wave, int lane) {
    LAS float* scr = (LAS float*)(lds + wave * 16384);
#define KIN(i) ((const float*)(*(const GAS float* const CAS*)(ka + 8 * (i))))
    const float* w_in = KIN(3) + (size_t)l * DM * IN_COLS; const float* pa = KIN(23) + (size_t)l * 512 * DM; const float* w_out = KIN(27) + (size_t)l * DM * DM; const float* glu_w = KIN(21) + (size_t)l * 65536;
    constexpr int I_IN = 16 * 240, I_PA = 8 * 32, I_PB = 4 * 32, I_OUT = 16 * 32, I_GLU = 4 * 8, I_EG = 16 * 16 * 12, I_ED = 16 * 6 * 32;
    constexpr int NITEMS = I_IN + I_PA + 3 * I_PB + I_OUT + I_GLU + 2 * I_EG;
    for (int it = gw; it < NITEMS; it += ngw) {
        int r = it;
        if (r < I_IN) { const int kb = r / 240, nb = r % 240, n0 = nb * 32;
            if (n0 < NMIX) tr_item(w_in, IN_COLS, kb * 64, n0, (bf16_t*)(wts + WT_IN) + (size_t)n0 * DM + kb * 64, DM, scr, lane);
            else { const int br = (n0 - NMIX) >> 10, c = (n0 - NMIX) & 1023; tr_item(w_in, IN_COLS, kb * 64, n0, (bf16_t*)(wts + WT_IN) + (size_t)(NMIX + 4 * c + br) * DM + kb * 64, DM, scr, lane, 4); }
            continue; } r -= I_IN;
        if (r < I_PA) { const int kb = r / 32, nb = r % 32; tr_item(pa, DM, kb * 64, nb * 32, (bf16_t*)(wts + WT_P) + (size_t)nb * 32 * YC_LD + kb * 64, YC_LD, scr, lane); continue; } r -= I_PA;
        if (r < 3 * I_PB) { const int w = r / I_PB, q = r % I_PB, kb = q / 32, nb = q % 32; const float* src = KIN(24 + w) + (size_t)l * 256 * DM;
            tr_item(src, DM, kb * 64, nb * 32, (bf16_t*)(wts + WT_P) + (size_t)nb * 32 * YC_LD + 512 + 256 * w + kb * 64, YC_LD, scr, lane); continue; } r -= 3 * I_PB;
        if (r < I_OUT) { const int kb = r / 32, nb = r % 32; tr_item(w_out, DM, kb * 64, nb * 32, (bf16_t*)(wts + WT_OUT) + (size_t)nb * 32 * DM + kb * 64, DM, scr, lane); continue; } r -= I_OUT;
        if (r < I_GLU) { const int kb = r / 8, nb = r % 8; tr_item(glu_w, 256, kb * 64, nb * 32, (bf16_t*)(wts + WT_GLU) + (size_t)nb * 32 * 256 + kb * 64, 256, scr, lane); continue; } r -= I_GLU;
        if (r < 2 * I_EG) { const int up = r / I_EG, q = r % I_EG, e = q / 192, q2 = q % 192, kb = q2 / 12, nb = q2 % 12, n0 = nb * 32;
            const float* src = KIN(33 + up) + ((size_t)l * NEXP + e) * DM * DEXP;
            tr_item(src, DEXP, kb * 64, n0, (bf16_t*)(wts + WT_E1) + (size_t)(e * 768 + (n0 >> 7) * 256 + up * 128 + (n0 & 127)) * DM + kb * 64, DM, scr, lane); continue; }
    }
}
__device__ __forceinline__ void ph_s5_tables(const float* lre, const float* lim, const float* lstep, const float* bre, const float* bim, float* apow, float* bb, int gtid, int nthr) {
    for (int i = gtid; i < 1024; i += nthr) { const int g = i >> 6;
        const float lr = fminf(lre[i], -1e-4f), li = lim[i], st = __expf(lstep[g]);
        const float mag = __expf(lr * st), ph = li * st; const float rv = ph * 0.15915494309189535f, fr_ = rv - floorf(rv), sn = __sinf(fr_ * 6.283185307179586f), cs = __cosf(fr_ * 6.283185307179586f);
        const float ar = mag * cs, ai = mag * sn;
        const float den = lr * lr + li * li, nr = ar - 1.f, gr = (nr * lr + ai * li) / den, gi = (ai * lr - nr * li) / den;
        float pr = 1.f, pi = 0.f;
        for (int p = 0; p <= 32; ++p) { apow[(i * 33 + p) * 2] = pr; apow[(i * 33 + p) * 2 + 1] = pi; const float t = pr * ar - pi * ai; pi = pr * ai + pi * ar; pr = t; }
        for (int c = 0; c < 16; ++c) { const float br = bre[i * 16 + c], bi = bim[i * 16 + c]; bb[(i * 16 + c) * 2] = gr * br - gi * bi; bb[(i * 16 + c) * 2 + 1] = gr * bi + gi * br; }
    }
}
__device__ __forceinline__ void ph_s5_mats(const float* __restrict__ apow, const float* __restrict__ bb, const float* __restrict__ cre, const float* __restrict__ cim, bf16_t* m1t, bf16_t* m2t, bf16_t* ktab, int gtid, int nthr) {
    for (int it = gtid; it < 16 * 256 * 64; it += nthr) { const int cg = it & 63, r = (it >> 6) & 255, g = it >> 14; float v[8];
        if (r < 128) { const int n = r & 63, im = r >> 6, s_ = cg >> 1, c0 = (cg & 1) * 8; const int gi = g * 64 + n; const float pr = apow[(gi * 33 + 31 - s_) * 2], pi = apow[(gi * 33 + 31 - s_) * 2 + 1];
#pragma unroll
            for (int j = 0; j < 8; ++j) { const float br = bb[(gi * 16 + c0 + j) * 2], bi = bb[(gi * 16 + c0 + j) * 2 + 1]; v[j] = im ? pr * bi + pi * br : pr * br - pi * bi; } }
        else {
#pragma unroll
            for (int j = 0; j < 8; ++j) v[j] = 0.f; }
        u32x4 w; w.x = pk2(v[0], v[1]); w.y = pk2(v[2], v[3]); w.z = pk2(v[4], v[5]); w.w = pk2(v[6], v[7]);
        *(u32x4*)(m1t + ((size_t)(g * 256 + r) * 512 + cg * 8)) = w; }
    for (int it = gtid; it < 16 * 32 * 16 * 2; it += nthr) { const int c0 = (it & 1) * 8, c = (it >> 1) & 15, tau = (it >> 5) & 31, g = it >> 10; float v[8];
#pragma unroll
        for (int j = 0; j < 8; ++j) v[j] = 0.f;
        for (int n = 0; n < 64; ++n) { const int gi = g * 64 + n; const float pr = apow[(gi * 33 + tau) * 2], pi = apow[(gi * 33 + tau) * 2 + 1], cr = cre[(g * 16 + c) * 64 + n], ci = cim[(g * 16 + c) * 64 + n];
            const float wr_ = cr * pr - ci * pi, wi_ = cr * pi + ci * pr;
#pragma unroll
            for (int j = 0; j < 8; ++j) v[j] += wr_ * bb[(gi * 16 + c0 + j) * 2] - wi_ * bb[(gi * 16 + c0 + j) * 2 + 1]; }
        u32x4 w; w.x = pk2(v[0], v[1]); w.y = pk2(v[2], v[3]); w.z = pk2(v[4], v[5]); w.w = pk2(v[6], v[7]);
        *(u32x4*)(ktab + ((size_t)((g * 32 + tau) * 16 + c) * 16 + c0)) = w; }
    for (int it = gtid; it < 16 * 512 * 16; it += nthr) { const int cg = it & 15, r = (it >> 4) & 511, g = it >> 13, t = r >> 4, c = r & 15, nn0 = cg * 8; float v[8];
#pragma unroll
        for (int j = 0; j < 8; ++j) { const int nn = nn0 + j, n = nn & 63, gi = g * 64 + n; const float pr = apow[(gi * 33 + t + 1) * 2], pi = apow[(gi * 33 + t + 1) * 2 + 1], cr = cre[(g * 16 + c) * 64 + n], ci = cim[(g * 16 + c) * 64 + n];
            v[j] = nn < 64 ? cr * pr - ci * pi : -(cr * pi + ci * pr); }
        u32x4 w; w.x = pk2(v[0], v[1]); w.y = pk2(v[2], v[3]); w.z = pk2(v[4], v[5]); w.w = pk2(v[6], v[7]);
        *(u32x4*)(m2t + ((size_t)(g * 512 + r) * S5_LD + 512 + cg * 8)) = w; }
}
__device__ __forceinline__ void ph_s5_expand(const bf16_t* __restrict__ ktab, bf16_t* m2t, int gtid, int nthr) {
    for (int it = gtid; it < 16 * 512 * 64; it += nthr) { const int cg = it & 63, r = (it >> 6) & 511, g = it >> 15, t = r >> 4, c = r & 15, s_ = cg >> 1, c0 = (cg & 1) * 8;
        u32x4 w = {0u, 0u, 0u, 0u}; if (s_ <= t) w = *(const u32x4*)(ktab + ((size_t)((g * 32 + t - s_) * 16 + c) * 16 + c0));
        *(u32x4*)(m2t + ((size_t)(g * 512 + r) * S5_LD + cg * 8)) = w; }
}
__device__ __forceinline__ void ph_s5_scan(const float* __restrict__ apow, const float* __restrict__ xloc, bf16_t* s5u, int gtid, int nthr) {
    for (int i = gtid; i < 4096; i += nthr) { const int n = i & 63, g = (i >> 6) & 15, b = i >> 10; const int gi = g * 64 + n;
        const float ar = apow[(gi * 33 + 32) * 2], ai = apow[(gi * 33 + 32) * 2 + 1]; float xr = 0.f, xi = 0.f;
        for (int k0 = 0; k0 < 256; k0 += 32) { float lr[32], li[32];
#pragma unroll
            for (int j = 0; j < 32; ++j) { const size_t row = (size_t)g * 1024 + b * 256 + k0 + j; lr[j] = xloc[row * 128 + n]; li[j] = xloc[row * 128 + 64 + n]; }
#pragma unroll
            for (int j = 0; j < 32; ++j) { const size_t row = (size_t)g * 1024 + b * 256 + k0 + j; s5u[row * S5_LD + 512 + n] = f2bf(xr); s5u[row * S5_LD + 576 + n] = f2bf(xi);
                const float t = ar * xr - ai * xi + lr[j]; xi = ar * xi + ai * xr + li[j]; xr = t; } }
    }
}
__device__ __forceinline__ void ph_pair_weights(const float* __restrict__ ed  , bf16_t* wp, LAS unsigned char* lds, int gw, int ngw, int wave, int lane) {
    LAS float* scr = (LAS float*)(lds + wave * 16384);
    for (int it = gw; it < NBUCKET * 2 * 6 * 32; it += ngw) { const int nb = it & 31, kb = (it >> 5) % 6, sel = (it / 192) & 1, p_ = it / 384; int e0, e1; pg8::pair_experts(p_, e0, e1); const int e = sel ? e1 : e0;
        tr_item(ed + (size_t)e * DEXP * DM, DM, kb * 64, nb * 32, wp + ((size_t)p_ * 1024 + nb * 32) * 768 + sel * DEXP + kb * 64, 768, scr, lane); }
    asm volatile("s_waitcnt lgkmcnt(0)" ::: "memory"); __syncthreads();
}
__device__ __forceinline__ void ph_rmsnorm(const float* __restrict__ x, const float* __restrict__ gain, bf16_t* __restrict__ out, int gw, int ngw, int lane) {
    for (int m = gw; m < NTOK; m += ngw) {
        const f32x4* xr = (const f32x4*)(x + (size_t)m * DM) + lane;
        f32x4 v[4]; float s = 0.f;
#pragma unroll
        for (int j = 0; j < 4; ++j) { v[j] = xr[64 * j]; s += (v[j].x * v[j].x + v[j].y * v[j].y) + (v[j].z * v[j].z + v[j].w * v[j].w); }
        const float r = rsqrtf(wave_sum(s, lane) * (1.f / DM) + RMS_EPS);
        u32x2* o = (u32x2*)(out + (size_t)m * DM) + lane;
#pragma unroll
        for (int j = 0; j < 4; ++j) { const f32x4 g = ((const f32x4*)gain)[64 * j + lane]; u32x2 w; w.x = pk2(v[j].x * r * g.x, v[j].y * r * g.y); w.y = pk2(v[j].z * r * g.z, v[j].w * r * g.w); o[64 * j] = w; }
    }
}
__device__ __forceinline__ void fix_row(bf16_t* row, const float* gain, const float* cs, const float* sn, float scale, int lane) {
    u32x4 raw = *(const u32x4*)(row + lane * 8);
    float v[8];
    v[0] = __uint_as_float(raw.x << 16); v[1] = __uint_as_float(raw.x & 0xffff0000u); v[2] = __uint_as_float(raw.y << 16); v[3] = __uint_as_float(raw.y & 0xffff0000u);
    v[4] = __uint_as_float(raw.z << 16); v[5] = __uint_as_float(raw.z & 0xffff0000u); v[6] = __uint_as_float(raw.w << 16); v[7] = __uint_as_float(raw.w & 0xffff0000u);
    float ss = 0.f;
#pragma unroll
    for (int i = 0; i < 8; ++i) ss += v[i] * v[i];
    ss += shx(ss, 1, lane); ss += shx(ss, 2, lane); ss += shx(ss, 4, lane);
    const float r = rsqrtf(ss * (1.f / 64.f) + RMS_EPS);
    const int sub = lane & 7;
#pragma unroll
    for (int i = 0; i < 8; ++i) v[i] = v[i] * r * gain[sub * 8 + i];
    float o[8];
#pragma unroll
    for (int i = 0; i < 8; ++i) {
        const float p = shx(v[i], 1, lane);
        float res = v[i];
        if (sub == 0) res = v[i] * cs[i] - p * sn[i];
        else if (sub == 1) res = v[i] * cs[i] + p * sn[i];
        o[i] = res * scale;
    }
    u32x4 w; w.x = pk2(o[0], o[1]); w.y = pk2(o[2], o[3]); w.z = pk2(o[4], o[5]); w.w = pk2(o[6], o[7]);
    *(u32x4*)(row + lane * 8) = w;
}
__device__ __forceinline__ void ph_fixup(bf16_t* Q, int ldq, bf16_t* K, const int* __restrict__ pos, const float* __restrict__ qg, const float* __restrict__ kg, int gw, int ngw, int lane) {
    for (int m = gw; m < NTOK; m += ngw) {
        const double p = (double)pos[m];
        float cs[8], sn[8];
#pragma unroll
        for (int i = 0; i < 8; ++i) {
            constexpr double RF[8] = {0.15915494309189535, 0.03086376340470123, 0.005985185712713705, 0.001160663641240061, 0.00022507907903927653, 4.364795279280289e-05, 8.464330808241401e-06, 1.6414262627950345e-06};
            double rv = p * RF[i];
            rv -= floor(rv);
            const float a = (float)rv * 6.283185307179586f;
            cs[i] = __cosf(a); sn[i] = __sinf(a);
        }
        fix_row(Q + (size_t)m * ldq, qg, cs, sn, QSCALE, lane);
        fix_row(K + (size_t)m * 512, kg, cs, sn, 1.f, lane);
    }
}
__device__ __forceinline__ void ph_combine(const bf16_t* __restrict__ O, bf16_t* __restrict__ YA, int ldy, const float* lq1, const float* lk1, const float* lq2, const float* lk2,
                                           const float* __restrict__ sg, float lambda_init, int gw, int ngw, int lane) {
    const float lam = __expf(wave_sum(lq1[lane] * lk1[lane], lane)) - __expf(wave_sum(lq2[lane] * lk2[lane], lane)) + lambda_init;
    const int h = lane >> 4, dv0 = (lane & 15) * 8;
    for (int m0 = gw * 4; m0 < NTOK; m0 += ngw * 4) {
      u32x4 aa[4], bb_[4];
#pragma unroll
      for (int u = 0; u < 4; ++u) { aa[u] = *(const u32x4*)(O + (size_t)(m0 + u) * 1024 + h * 256 + dv0); bb_[u] = *(const u32x4*)(O + (size_t)(m0 + u) * 1024 + h * 256 + 128 + dv0); }
#pragma unroll
      for (int u = 0; u < 4; ++u) { const int m = m0 + u; const u32x4 a = aa[u], b = bb_[u];
        float d[8]; const unsigned aw[4] = {a.x, a.y, a.z, a.w}, bw[4] = {b.x, b.y, b.z, b.w};
#pragma unroll
        for (int i = 0; i < 4; ++i) { d[2 * i] = __uint_as_float(aw[i] << 16) - lam * __uint_as_float(bw[i] << 16); d[2 * i + 1] = __uint_as_float(aw[i] & 0xffff0000u) - lam * __uint_as_float(bw[i] & 0xffff0000u); }
        float ss = 0.f;
#pragma unroll
        for (int i = 0; i < 8; ++i) ss += d[i] * d[i];
        ss += shx(ss, 1, lane); ss += shx(ss, 2, lane); ss += shx(ss, 4, lane); ss += shx(ss, 8, lane);
        const float r = rsqrtf(ss * (1.f / 128.f) + RMS_EPS) * (1.f - lambda_init);
        u32x4 w; w.x = pk2(d[0] * r * sg[dv0], d[1] * r * sg[dv0 + 1]); w.y = pk2(d[2] * r * sg[dv0 + 2], d[3] * r * sg[dv0 + 3]);
        w.z = pk2(d[4] * r * sg[dv0 + 4], d[5] * r * sg[dv0 + 5]); w.w = pk2(d[6] * r * sg[dv0 + 6], d[7] * r * sg[dv0 + 7]);
        *(u32x4*)(YA + (size_t)m * ldy + h * 128 + dv0) = w;
      }
    }
}
__device__ __forceinline__ void ph_router(LAS unsigned char* lds, const float* __restrict__ x1, const float* __restrict__ gain, const float* __restrict__ wg, const float* __restrict__ bg,
                                          const float* __restrict__ we, const float* __restrict__ be, bf16_t* __restrict__ xn2, int* bucket, int* rank, float* tw, unsigned* cnt, int gw, int ngw, int lane) {
    LAS float* Wt = (LAS float*)lds; LAS unsigned* lcnt = (LAS unsigned*)(lds + 20 * 4096); LAS unsigned* lbase = lcnt + 32;
    if ((gw & 7) * 64 + lane < 32) lcnt[(gw & 7) * 64 + lane] = 0u;
    { const int t = (gw & 7) * 64 + lane;
      f32x4 a[2], b[8];
#pragma unroll
      for (int i = 0; i < 2; ++i) a[i] = ((const f32x4*)wg)[t + 512 * i];
#pragma unroll
      for (int i = 0; i < 8; ++i) b[i] = ((const f32x4*)we)[t + 512 * i];
#pragma unroll
      for (int i = 0; i < 2; ++i) { const int e = t + 512 * i; Wt[e] = a[i].x; Wt[1024 + e] = a[i].y; Wt[2048 + e] = a[i].z; Wt[3072 + e] = a[i].w; }
#pragma unroll
      for (int i = 0; i < 8; ++i) { const int x = t + 512 * i, e = x >> 2, q = x & 3; Wt[(4 + 4 * q) * 1024 + e] = b[i].x; Wt[(5 + 4 * q) * 1024 + e] = b[i].y; Wt[(6 + 4 * q) * 1024 + e] = b[i].z; Wt[(7 + 4 * q) * 1024 + e] = b[i].w; } }
    __syncthreads();
    for (int m0 = gw * 2; m0 < NTOK; m0 += ngw * 2) {
        f32x4 v[2][4]; float r[2];
#pragma unroll
        for (int tk = 0; tk < 2; ++tk) { const f32x4* xr = (const f32x4*)(x1 + (size_t)(m0 + tk) * DM) + lane; float s = 0.f;
#pragma unroll
            for (int j = 0; j < 4; ++j) { v[tk][j] = xr[64 * j]; s += (v[tk][j].x * v[tk][j].x + v[tk][j].y * v[tk][j].y) + (v[tk][j].z * v[tk][j].z + v[tk][j].w * v[tk][j].w); }
            r[tk] = s; }
#pragma unroll
        for (int tk = 0; tk < 2; ++tk) r[tk] = rsqrtf(wave_sum_dpp(r[tk]) * (1.f / DM) + RMS_EPS);
#pragma unroll
        for (int j = 0; j < 4; ++j) { const f32x4 g = ((const f32x4*)gain)[64 * j + lane];
#pragma unroll
            for (int tk = 0; tk < 2; ++tk) { v[tk][j] = v[tk][j] * r[tk] * g; u32x2 w; w.x = pk2(v[tk][j].x, v[tk][j].y); w.y = pk2(v[tk][j].z, v[tk][j].w); ((u32x2*)(xn2 + (size_t)(m0 + tk) * DM) + lane)[64 * j] = w; } }
        float lg[2][20];
#pragma unroll
        for (int c = 0; c < 20; ++c) {
            float a0 = 0.f, a1 = 0.f;
#pragma unroll
            for (int j = 0; j < 4; ++j) { const f32x4 w = *(const LAS f32x4*)(Wt + c * 1024 + 256 * j + 4 * lane);
                a0 += (v[0][j].x * w.x + v[0][j].y * w.y) + (v[0][j].z * w.z + v[0][j].w * w.w); a1 += (v[1][j].x * w.x + v[1][j].y * w.y) + (v[1][j].z * w.z + v[1][j].w * w.w); }
            lg[0][c] = wave_sum_dpp(a0); lg[1][c] = wave_sum_dpp(a1);
            if ((c & 3) == 3) asm volatile("" ::: "memory");
        }
#pragma unroll
        for (int tk = 0; tk < 2; ++tk) {
            float gl[4]; int gi = 0;
#pragma unroll
            for (int c = 0; c < 4; ++c) gl[c] = lg[tk][c] + bg[c];
            float gm = gl[0];
#pragma unroll
            for (int c = 1; c < 4; ++c) if (gl[c] > gm) { gm = gl[c]; gi = c; }
            float gs = 0.f;
#pragma unroll
            for (int c = 0; c < 4; ++c) gs += __expf(gl[c] - gm);
            const float gval = 1.f / gs;
            float el[4];
#pragma unroll
            for (int c = 0; c < 4; ++c) { float t = lg[tk][4 + c] + be[c]; t = (gi == 1) ? lg[tk][8 + c] + be[4 + c] : t; t = (gi == 2) ? lg[tk][12 + c] + be[8 + c] : t; t = (gi == 3) ? lg[tk][16 + c] + be[12 + c] : t; el[c] = t; }
            int i0 = 0; float m0_ = el[0];
#pragma unroll
            for (int c = 1; c < 4; ++c) if (el[c] > m0_) { m0_ = el[c]; i0 = c; }
            int i1 = -1; float m1 = -INFINITY;
#pragma unroll
            for (int c = 0; c < 4; ++c) if (c != i0 && el[c] > m1) { m1 = el[c]; i1 = c; }
            const float p1 = __expf(m1 - m0_), w0 = gval / (1.f + p1), w1 = gval * p1 / (1.f + p1);
            const int lo = i0 < i1 ? i0 : i1, hi = i0 < i1 ? i1 : i0; const float wlo = i0 < i1 ? w0 : w1, whi = i0 < i1 ? w1 : w0;
            const int pair = (lo == 0) ? hi - 1 : (lo == 1 ? hi + 1 : 5);
            const int b = gi * 6 + pair, m = m0 + tk;
            if (lane == 0) { bucket[m] = b; tw[2 * m] = wlo; tw[2 * m + 1] = whi; rank[m] = (int)__hip_atomic_fetch_add(lcnt + b, 1u, __ATOMIC_RELAXED, __HIP_MEMORY_SCOPE_WORKGROUP); }
        }
    }
    asm volatile("s_waitcnt vmcnt(0) lgkmcnt(0)" ::: "memory"); __syncthreads();
    { const int t = (gw & 7) * 64 + lane; if (t < NBUCKET) lbase[t] = __hip_atomic_fetch_add(cnt + 64 * t, lcnt[t], __ATOMIC_RELAXED, __HIP_MEMORY_SCOPE_AGENT); }
    __syncthreads();
    for (int m0 = gw * 2; m0 < NTOK; m0 += ngw * 2) if (lane < 2) { const int m = m0 + lane; rank[m] += (int)lbase[bucket[m]]; }
}
__device__ __forceinline__ void ph_sort(const bf16_t* __restrict__ xn2, const int* __restrict__ bucket, const int* __restrict__ rank, const float* __restrict__ tw, const unsigned* __restrict__ cnt,
                                        bf16_t* __restrict__ xs, int* slot_tok, float* slot_w, int gw, int ngw, int lane) {
    int mybase = 0, mycnt = 0;
    { int run = 0; for (int b = 0; b < NBUCKET; ++b) { const int cb = (int)cnt[64 * b]; if (lane == b) { mybase = run; mycnt = cb; } run += (cb + 255) & ~255; } }
    for (int m0 = gw * 4; m0 < NTOK; m0 += ngw * 4) {
        int bk[4], rk_[4]; float w0[4], w1[4]; u32x4 ra[4], rb[4];
#pragma unroll
        for (int u = 0; u < 4; ++u) { bk[u] = bucket[m0 + u]; rk_[u] = rank[m0 + u]; w0[u] = tw[2 * (m0 + u)]; w1[u] = tw[2 * (m0 + u) + 1];
            const u32x4* s = (const u32x4*)(xn2 + (size_t)(m0 + u) * DM) + lane; ra[u] = s[0]; rb[u] = s[64]; }
#pragma unroll
        for (int u = 0; u < 4; ++u) { const int slot = shl_i(mybase, bk[u]) + rk_[u]; u32x4* d = (u32x4*)(xs + (size_t)slot * DM) + lane; d[0] = ra[u]; d[64] = rb[u];
            if (lane == 0) { slot_tok[slot] = m0 + u; slot_w[2 * slot] = w0[u]; slot_w[2 * slot + 1] = w1[u]; } }
    }
    if (gw < NBUCKET) { const int b = gw, bs = shl_i(mybase, b), cb = shl_i(mycnt, b), pe = (cb + 255) & ~255;
        float z = 0.f; asm volatile("" : "+v"(z));
        for (int s = cb + lane; s < pe; s += 64) { slot_tok[bs + s] = -1; slot_w[2 * (bs + s)] = z; slot_w[2 * (bs + s) + 1] = z; } }
}

constexpr int NWAVES = 8, RING_BYTES = 131072, MISC_OFF = RING_BYTES + 320, LDS_BYTES = 147456;
constexpr int PH_PER_LAYER = 14;
enum { PH_WTS = 0, PH_NORM, PH_GEMM_IN, PH_FIX, PH_SCAN, PH_MIX, PH_POST, PH_GATE, PH_BRANCH, PH_OUT, PH_ROUTE, PH_SORT, PH_MOE1, PH_MOE2 };
struct Args { const float* in[36]; float* out; unsigned char* ws; int ph_lo, ph_hi, li, pad; };
__device__ __forceinline__ bool inph(int lo, int hi, int k) { asm volatile("" : "+s"(lo), "+s"(hi)); return lo <= k && k < hi; }
__global__ void __launch_bounds__(NWAVES * 64, 2) fwd(Args args) {
    extern __shared__ __attribute__((aligned(16))) unsigned char lds_raw[];
    LAS unsigned char* lds = (LAS unsigned char*)lds_raw;
    volatile LAS unsigned* MISC = (volatile LAS unsigned*)(lds + MISC_OFF);
    const int tid = threadIdx.x, lane = tid & 63, wave = __builtin_amdgcn_readfirstlane(tid >> 6), G = gridDim.x;
    const int gw = blockIdx.x * NWAVES + wave, ngw = G * NWAVES;
    unsigned char* ws = args.ws; unsigned* ctl = (unsigned*)(ws + WS_CTL);
    for (int u = tid; u < (LDS_BYTES - RING_BYTES) / 4; u += NWAVES * 64) ((LAS unsigned*)(lds + RING_BYTES))[u] = 0u;
    __syncthreads();
    XcdBarrier bar = xcd_barrier_post(ctl + CW_BAR + args.li * XCD_BAR_WORDS, MISC + 8);
    const int lo = args.ph_lo, hi = args.ph_hi;
#define IN_(k) inph(lo, hi, (k))
#define SEAM(k) do { if (IN_(k) && IN_((k) + 1)) xcd_barrier(bar); } while (0)
#define PH_BEGIN GAS unsigned char* W = (GAS unsigned char*)ws; asm volatile("" : "+s"(W)); GAS float* OUTP_ = (GAS float*)args.out; asm volatile("" : "+s"(OUTP_)); float* OUTP = (float*)OUTP_; int LN = threadIdx.x; asm volatile("" : "+v"(LN)); LN &= 63; int GG = gridDim.x; asm volatile("" : "+s"(GG)); int BX = blockIdx.x; asm volatile("" : "+s"(BX)); const int NGW_ = GG * NWAVES; int GW = BX * NWAVES + __builtin_amdgcn_readfirstlane(threadIdx.x >> 6); asm volatile("" : "+s"(GW));
#define INP(i) ({ const CAS char* ka_ = (const CAS char*)__builtin_amdgcn_kernarg_segment_ptr(); asm volatile("" : "+s"(ka_)); (const float*)(*(const GAS float* const CAS*)(ka_ + 8 * (i))); })
    for (int l = 0; l < DEPTH; ++l) {
        const int p0 = l * PH_PER_LAYER;
        if (IN_(p0 + PH_WTS)) { PH_BEGIN; ph_weights(({ const CAS char* ka_ = (const CAS char*)__builtin_amdgcn_kernarg_segment_ptr(); asm volatile("" : "+s"(ka_)); ka_; }), l, (unsigned char*)(W + WS_WTS), lds, GW, NGW_, GW & 7, LN);
            ph_s5_tables(INP(13) + l * 1024, INP(14) + l * 1024, INP(15) + l * 16, INP(16) + l * 16384, INP(17) + l * 16384, (float*)(W + WS_WTS + WT_APOW), (float*)(W + WS_WTS + WT_BB), GW * 64 + LN, NGW_ * 64); }
        SEAM(p0 + PH_WTS);
        if (IN_(p0 + PH_NORM)) { PH_BEGIN; const float* xin = l == 0 ? INP(0) : OUTP; ph_rmsnorm(xin, INP(2) + l * DM, (bf16_t*)(W + WS_XN), GW, NGW_, LN);
            ph_s5_mats((const float*)(W + WS_WTS + WT_APOW), (const float*)(W + WS_WTS + WT_BB), INP(18) + l * 16384, INP(19) + l * 16384, (bf16_t*)(W + WS_WTS + WT_S5A), (bf16_t*)(W + WS_WTS + WT_S5B), (bf16_t*)(W + WS_WTS + WT_KTAB), GW * 64 + LN, NGW_ * 64); }
        SEAM(p0 + PH_NORM);
        if (IN_(p0 + PH_GEMM_IN)) { PH_BEGIN;
            pg8::Gemm g{(const bf16_t*)(W + WS_XN), (const bf16_t*)(W + WS_WTS + WT_IN), DM, DM}; pg8::PlainSched S; S.o.init(NTOK / 256, NMIX / 256, GG, BX); S.lda = DM; S.ldb = DM; S.nt = 16; S.pn0 = 0;
            pg8::EpiInMix E{(unsigned char*)W};
            pg8::gemm_phase<pg8::EpiInMix, pg8::PlainSched, true, true>(lds, g, S, E);
        }
        SEAM(p0 + PH_GEMM_IN);
        if (IN_(p0 + PH_FIX)) { PH_BEGIN; ph_s5_expand((const bf16_t*)(W + WS_WTS + WT_KTAB), (bf16_t*)(W + WS_WTS + WT_S5B), GW * 64 + LN, NGW_ * 64); ph_fixup((bf16_t*)(W + WS_YCAT) + YC_Q, YC_LD, (bf16_t*)(W + WS_K), (const int*)INP(1), INP(4) + l * 64, INP(5) + l * 64, GW, NGW_, LN);
            pg8::Gemm g{(const bf16_t*)(W + WS_S5U), (const bf16_t*)(W + WS_WTS + WT_S5A), S5_LD, 512}; pg8::S5aSched S{GG, BX};
            pg8::EpiS5a E{(float*)(W + WS_S5ST)};
            pg8::gemm_phase<pg8::EpiS5a, pg8::S5aSched, true, true>(lds, g, S, E);
            hg_local(lds, (const bf16_t*)(W + WS_HGF), (const bf16_t*)(W + WS_HGI), INP(11), l, (float*)(W + WS_HGST), (float*)(W + WS_WTS + WT_HGDEC), GW, NGW_, GW & 7, LN);
        }
        SEAM(p0 + PH_FIX);
        if (IN_(p0 + PH_SCAN)) { PH_BEGIN; ph_s5_scan((const float*)(W + WS_WTS + WT_APOW), (const float*)(W + WS_S5ST), (bf16_t*)(W + WS_S5U), GW * 64 + LN, NGW_ * 64);
            hg_scan((float*)(W + WS_HGST), (const float*)(W + WS_WTS + WT_HGDEC), GW * 64 + LN, NGW_ * 64);
            sb_phase(lds, (bf16_t*)(W + WS_YCAT) + YC_SB, YC_LD, (const bf16_t*)(W + WS_SBK), (const bf16_t*)(W + WS_SBV), GW, NGW_, GW & 7, LN);
        }
        SEAM(p0 + PH_SCAN);
        if (IN_(p0 + PH_MIX)) { PH_BEGIN;
            { const attn2::AttnTensors AT{(const attn2::bf16*)(W + WS_YCAT) + YC_Q, (const attn2::bf16*)(W + WS_K), (const attn2::bf16*)(W + WS_V), (attn2::bf16*)(W + WS_O)};
              const attn2::StaticOrder SA(GG, BX); attn2::attn_phase<8>((char*)lds_raw, AT, SA); }
            pg8::Gemm g{(const bf16_t*)(W + WS_S5U), (const bf16_t*)(W + WS_WTS + WT_S5B), S5_LD, S5_LD}; pg8::S5bSched S2{GG, BX};
            pg8::EpiS5b E{(const bf16_t*)(W + WS_S5U), INP(20) + l * 256, (bf16_t*)(W + WS_YG)};
            pg8::gemm_phase<pg8::EpiS5b, pg8::S5bSched, true, true>(lds, g, S2, E);
            hg_out(lds, (const bf16_t*)(W + WS_HGF), (const bf16_t*)(W + WS_HGI), (bf16_t*)(W + WS_YCAT) + YC_HG, YC_LD, (const bf16_t*)(W + WS_HGG), INP(11), l, INP(12) + l * 64, (const float*)(W + WS_HGST), GW, NGW_, GW & 7, LN);
        }
        SEAM(p0 + PH_MIX);
        if (IN_(p0 + PH_POST)) { PH_BEGIN;
            const float lambda_init = l == 0 ? 0.2f : 0.35550906759096926f;
            ph_combine((const bf16_t*)(W + WS_O), (bf16_t*)(W + WS_YCAT) + YC_Q, YC_LD, INP(6) + l * 64, INP(7) + l * 64, INP(8) + l * 64, INP(9) + l * 64, INP(10) + l * 128, lambda_init, GW, NGW_, LN);
            pg8::Gemm g{(const bf16_t*)(W + WS_YG), (const bf16_t*)(W + WS_WTS + WT_GLU), 256, 256}; pg8::PlainSched S; S.o.init(NTOK / 256, 1, GG, BX); S.lda = 256; S.ldb = 256; S.nt = 4; S.pn0 = 0;
            pg8::EpiGlu E{(const bf16_t*)(W + WS_YG), INP(22) + l * 256, (bf16_t*)(W + WS_YCAT)};
            pg8::gemm_phase<pg8::EpiGlu, pg8::PlainSched, true, true>(lds, g, S, E);
        }
        SEAM(p0 + PH_POST);
        if (IN_(p0 + PH_GATE)) { PH_BEGIN;
            pg8::Gemm g{(const bf16_t*)(W + WS_XN), (const bf16_t*)(W + WS_WTS + WT_IN), DM, DM}; pg8::PlainSched S; S.o.init(NTOK / 256, 16, GG, BX); S.lda = DM; S.ldb = DM; S.nt = 16; S.pn0 = NMIX / 256;
            pg8::EpiGateU8 E{(unsigned char*)(W + WS_GATE)};
            pg8::gemm_phase<pg8::EpiGateU8, pg8::PlainSched, true, true>(lds, g, S, E);
        }
        SEAM(p0 + PH_GATE);
        if (IN_(p0 + PH_BRANCH)) { PH_BEGIN;
            pg8::Gemm g{(const bf16_t*)(W + WS_YCAT), (const bf16_t*)(W + WS_WTS + WT_P), YC_LD, YC_LD}; pg8::BranchSched S; S.o.init(NTOK / 256, 4, GG, BX);
            pg8::EpiBranch E{(const unsigned char*)(W + WS_GATE), (bf16_t*)(W + WS_O)};
            pg8::gemm_phase<pg8::EpiBranch, pg8::BranchSched, true, true>(lds, g, S, E);
        }
        SEAM(p0 + PH_BRANCH);
        if (IN_(p0 + PH_OUT)) { PH_BEGIN; const float* xin = l == 0 ? INP(0) : OUTP;
            pg8::Gemm g{(const bf16_t*)(W + WS_O), (const bf16_t*)(W + WS_WTS + WT_OUT), DM, DM}; pg8::PlainSched S; S.o.init(NTOK / 256, 4, GG, BX); S.lda = DM; S.ldb = DM; S.nt = 16; S.pn0 = 0;
            pg8::EpiOutRes E{xin, OUTP};
            pg8::gemm_phase<pg8::EpiOutRes, pg8::PlainSched, true, true>(lds, g, S, E);
        }
        SEAM(p0 + PH_OUT);
        if (IN_(p0 + PH_ROUTE)) { PH_BEGIN;
            ph_pair_weights(INP(35) + (size_t)l * NEXP * DEXP * DM, (bf16_t*)(W + WS_O), lds, GW, NGW_, GW & 7, LN);
            ph_router(lds, OUTP, INP(28) + l * DM, INP(29) + l * DM * 4, INP(30) + l * 4, INP(31) + l * DM * 16, INP(32) + l * 16, (bf16_t*)(W + WS_XN), (int*)(W + WS_SMALL + SM_BUCKET), (int*)(W + WS_SMALL + SM_RANK),
                      (float*)(W + WS_SMALL + SM_TW), (unsigned*)(W + WS_CTL) + CW_CNT + CNT_LSTRIDE * l, GW, NGW_, LN); }
        SEAM(p0 + PH_ROUTE);
        if (IN_(p0 + PH_SORT)) { PH_BEGIN;
            ph_sort((const bf16_t*)(W + WS_XN), (const int*)(W + WS_SMALL + SM_BUCKET), (const int*)(W + WS_SMALL + SM_RANK), (const float*)(W + WS_SMALL + SM_TW), (const unsigned*)(W + WS_CTL) + CW_CNT + CNT_LSTRIDE * l,
                    (bf16_t*)(W + WS_XS), (int*)(W + WS_SMALL + SM_SLOTTOK), (float*)(W + WS_SMALL + SM_SLOTW), GW, NGW_, LN); }
        SEAM(p0 + PH_SORT);
        if (IN_(p0 + PH_MOE1)) { PH_BEGIN;
            pg8::Gemm g{(const bf16_t*)(W + WS_XS), (const bf16_t*)(W + WS_WTS + WT_E1), DM, DM}; LAS int* tbl = (LAS int*)(lds + MISC_OFF + 256); pg8::moe_table(tbl, (const unsigned*)(W + WS_CTL) + CW_CNT + CNT_LSTRIDE * l); pg8::MoeSched<1> S{tbl, GG, BX};
            pg8::EpiMoe1 E{(bf16_t*)(W + WS_HID), (const float*)(W + WS_SMALL + SM_SLOTW)};
            pg8::gemm_phase<pg8::EpiMoe1, pg8::MoeSched<1>, true, true>(lds, g, S, E);
        }
        SEAM(p0 + PH_MOE1);
        if (IN_(p0 + PH_MOE2)) { PH_BEGIN;
            pg8::Gemm g{(const bf16_t*)(W + WS_HID), (const bf16_t*)(W + WS_O), 768, 768};        LAS int* tbl = (LAS int*)(lds + MISC_OFF + 256); pg8::moe_table(tbl, (const unsigned*)(W + WS_CTL) + CW_CNT + CNT_LSTRIDE * l); pg8::MoeSched<2> S{tbl, GG, BX};
            pg8::EpiMoe2 E{OUTP, (const int*)(W + WS_SMALL + SM_SLOTTOK), (float*)(W + WS_SMALL + SM_DUMMY)};
            pg8::gemm_phase<pg8::EpiMoe2, pg8::MoeSched<2>, true, true>(lds, g, S, E);
        }
        SEAM(p0 + PH_MOE2);
    }
#undef IN_
#undef SEAM
}

extern "C" void kernel_launch(void* const* d_in, const int* in_sizes, int n_in, void* d_out, int out_size, void* d_ws, size_t ws_size, hipStream_t stream) {
    static int grid = 0;
    if (grid == 0) {
        if (n_in != 36 || out_size != NTOK * DM || ws_size < WS_END) { fprintf(stderr, "kernel_launch: unexpected shapes (n_in %d out %d ws %zu)\n", n_in, out_size, ws_size); grid = -1; return; }
        int dev = 0, cus = 0, per_cu = 0;
        if (hipGetDevice(&dev) != hipSuccess || hipDeviceGetAttribute(&cus, hipDeviceAttributeMultiprocessorCount, dev) != hipSuccess) { grid = -1; return; }
        if (hipFuncSetAttribute((const void*)fwd, hipFuncAttributeMaxDynamicSharedMemorySize, LDS_BYTES) != hipSuccess) { fprintf(stderr, "kernel_launch: hipFuncSetAttribute failed\n"); grid = -1; return; }
        if (hipOccupancyMaxActiveBlocksPerMultiprocessor(&per_cu, (const void*)fwd, NWAVES * 64, LDS_BYTES) != hipSuccess || per_cu < 1) { fprintf(stderr, "kernel_launch: occupancy query says %d\n", per_cu); }
        (void)hipGetLastError();
        grid = cus;
    }
    if (grid < 0) return;
    unsigned char* ws = (unsigned char*)d_ws;
    const float* const* in = (const float* const*)d_in;
    (void)hipMemsetAsync(ws + WS_CTL, 0, 1 * MiB, stream);
    bf16_t *OB = (bf16_t*)(ws + WS_O), *YC = (bf16_t*)(ws + WS_YCAT), *K = (bf16_t*)(ws + WS_K), *V = (bf16_t*)(ws + WS_V);
    bf16_t *SBK = (bf16_t*)(ws + WS_SBK), *SBV = (bf16_t*)(ws + WS_SBV), *HGF = (bf16_t*)(ws + WS_HGF), *HGI = (bf16_t*)(ws + WS_HGI), *HGG = (bf16_t*)(ws + WS_HGG);
    bf16_t *S5U = (bf16_t*)(ws + WS_S5U), *YG = (bf16_t*)(ws + WS_YG);
    Args a{};
    for (int i = 0; i < 36; ++i) a.in[i] = (const float*)d_in[i];
    a.out = (float*)d_out; a.ws = ws;
    a.ph_lo = 0; a.ph_hi = DEPTH * PH_PER_LAYER; a.li = 0;
    hipLaunchKernelGGL(fwd, dim3(grid), dim3(NWAVES * 64), LDS_BYTES, stream, a);
}
```

```cpp
#include <hip/hip_runtime.h>
#include <cstdio>
#include <cstdint>
#include <cmath>

typedef unsigned short bf16_t;
typedef float f32x4 __attribute__((ext_vector_type(4)));
typedef unsigned u32x4 __attribute__((ext_vector_type(4)));
typedef unsigned u32x2 __attribute__((ext_vector_type(2)));
#define GAS __attribute__((address_space(1)))
#define LAS __attribute__((address_space(3)))
#define CAS __attribute__((address_space(4)))

constexpr int NB = 4, SEQ = 8192, NTOK = NB * SEQ, DM = 1024, DEPTH = 2, IN_COLS = 7680;
constexpr int C_GATE = 3584;
constexpr int NMIX = 3584;
constexpr float RMS_EPS = 1e-6f;
constexpr float QSCALE = 0.125f * 1.4426950408889634f;
constexpr int NEXP = 16, DEXP = 384, NBUCKET = 24, MPAD = NTOK + NBUCKET * 256;
constexpr int YC_LD = 1280, YC_Q = 0, YC_SB = 512, YC_HG = 768, YC_YD = 1024;

constexpr size_t MiB = 1u << 20;
constexpr size_t WS_CTL = 0;
constexpr size_t WS_SMALL = 1 * MiB;
constexpr size_t WS_XN = 2 * MiB;
constexpr size_t WS_O = 66 * MiB;
constexpr size_t WS_YCAT = 130 * MiB;
constexpr size_t WS_K = 210 * MiB;
constexpr size_t WS_V = 242 * MiB;
constexpr size_t WS_SBK = 274 * MiB, WS_SBV = 290 * MiB, WS_HGF = 306 * MiB, WS_HGI = 322 * MiB;
constexpr size_t WS_GATE = 210 * MiB;
constexpr size_t WS_HGG = 338 * MiB, WS_S5U = 354 * MiB  , WS_YG = 374 * MiB;
constexpr size_t WS_HGST = 390 * MiB, WS_S5ST = 422 * MiB  , WS_WTS = 432 * MiB, WS_END = 512 * MiB;
constexpr size_t WS_XS = 130 * MiB;
constexpr size_t WS_HID = 210 * MiB;
constexpr size_t WT_IN = 0, WT_P = 15 * MiB, WT_OUT = 18 * MiB, WT_GLU = 20 * MiB, WT_E1 = 21 * MiB, WT_E2 = 45 * MiB, WT_S5A = 57 * MiB  , WT_S5B = 61 * MiB  ;
constexpr size_t WT_KTAB = 75 * MiB  ;
constexpr size_t WT_APOW = 72 * MiB  , WT_BB = 73 * MiB  , WT_HGDEC = 74 * MiB  ;
constexpr int S5_LD = 640;
constexpr size_t SM_BUCKET = 0;
constexpr size_t SM_RANK = 131072;
constexpr size_t SM_TW = 262144;
constexpr size_t SM_SLOTTOK = 524288;
constexpr size_t SM_SLOTW = 524288 + 163840;
constexpr size_t SM_DUMMY = 1040384;
constexpr int CW_CNT = 8192, CNT_LSTRIDE = 2048;
constexpr int CW_BAR = 4096;

__device__ __forceinline__ float bf2f(bf16_t v) { return __uint_as_float((unsigned)v << 16); }
__device__ __forceinline__ bf16_t f2bf(float f) { unsigned u = __float_as_uint(f); return (bf16_t)((u + 0x7fffu + ((u >> 16) & 1u)) >> 16); }
__device__ __forceinline__ unsigned pk2(float lo, float hi) { return (unsigned)f2bf(lo) | ((unsigned)f2bf(hi) << 16); }
__device__ __forceinline__ float shx(float v, int m, int lane) { return __int_as_float(__builtin_amdgcn_ds_bpermute((lane ^ m) << 2, __float_as_int(v))); }
__device__ __forceinline__ float shl_(float v, int src) { return __int_as_float(__builtin_amdgcn_ds_bpermute(src << 2, __float_as_int(v))); }
__device__ __forceinline__ int shl_i(int v, int src) { return __builtin_amdgcn_ds_bpermute(src << 2, v); }
__device__ __forceinline__ float wave_sum_dpp(float v) {
    v += __int_as_float(__builtin_amdgcn_update_dpp(0, __float_as_int(v), 0xb1, 0xf, 0xf, true));
    v += __int_as_float(__builtin_amdgcn_update_dpp(0, __float_as_int(v), 0x4e, 0xf, 0xf, true));
    v += __int_as_float(__builtin_amdgcn_update_dpp(0, __float_as_int(v), 0x114, 0xf, 0xf, true));
    v += __int_as_float(__builtin_amdgcn_update_dpp(0, __float_as_int(v), 0x118, 0xf, 0xf, true));
    v += __int_as_float(__builtin_amdgcn_update_dpp(0, __float_as_int(v), 0x142, 0xa, 0xf, true));
    v += __int_as_float(__builtin_amdgcn_update_dpp(0, __float_as_int(v), 0x143, 0xc, 0xf, true));
    return __int_as_float(__builtin_amdgcn_readlane(__float_as_int(v), 63));
}
__device__ __forceinline__ float wave_sum(float v, int lane) {
#pragma unroll
    for (int o = 1; o < 64; o <<= 1) v += shx(v, o, lane);
    return v;
}
__device__ __forceinline__ float sigmoidf_(float x) { return 1.f / (1.f + __expf(-x)); }
__device__ __forceinline__ float softplusf_(float x) { return fmaxf(x, 0.f) + log1pf(__expf(-fabsf(x))); }

namespace pg8 {
#define PG8_LAS __attribute__((address_space(3)))
typedef short bf16x8 __attribute__((ext_vector_type(8)));
constexpr int BM = 256, BK = 64, HALF = 128, HTB = HALF * BK * 2  , STAGE_BYTES = 8 * HTB, NXCD = 8, WGM = 8;

__host__ __device__ __forceinline__ int lds_byte(int r, int c) { const int st = (r >> 4) * 2 + (c >> 5), rr = r & 15, cc = c & 31, ob = rr * 64 + cc * 2; return st * 1024 + (ob ^ (((ob >> 9) & 1) << 5)); }
__host__ __device__ __forceinline__ void stage_rc(int b, int& R, int& C) { const int st = b / 1024, sb = b % 1024, swz = sb ^ (((sb >> 9) & 1) << 5); R = (st >> 1) * 16 + swz / 64; C = (st & 1) * 32 + (swz % 64) / 2; }
__host__ __device__ __forceinline__ int perm32(int rho) { const int n = rho >> 4, i = rho & 15; return 8 * (i >> 2) + 4 * n + (i & 3); }

struct Unit { unsigned aoff, boff; int nt, pm, pn, aux; };
struct Gemm { const bf16_t* A; const bf16_t* Bt; int lda, ldb; };

struct TileOrder {
    int nM, nN, nwg, G, c;
    __device__ __forceinline__ void init(int nM_, int nN_, int G_, int c_) { nM = nM_; nN = nN_; nwg = nM * nN; G = G_; c = c_; }
    __device__ __forceinline__ bool tile(int i, int& pm, int& pn) const {
        const int L = i * G + c; if (L >= nwg) return false;
        int wgid = L; { const int q = nwg / NXCD, r = nwg % NXCD, xcd = wgid % NXCD, off = wgid / NXCD; wgid = (xcd < r ? xcd * (q + 1) : r * (q + 1) + (xcd - r) * q) + off; }
        const int nig = WGM * nN, gid = wgid / nig, fm = gid * WGM, gsz = (nM - fm) < WGM ? (nM - fm) : WGM;
        pm = fm + ((wgid % nig) % gsz); pn = (wgid % nig) / gsz; return true;
    }
};
struct PlainSched {
    TileOrder o; int lda, ldb, nt, pn0;
    __device__ __forceinline__ bool next(int i, Unit& u) const { int pm, pn; if (!o.tile(i, pm, pn)) return false;
        u.aoff = (unsigned)pm * 256u * lda * 2u; u.boff = (unsigned)(pn0 + pn) * 256u * ldb * 2u; u.nt = nt; u.pm = pm; u.pn = pn; u.aux = 0; return true; }
    __device__ __forceinline__ void a_ready(const Unit&) const {}
    __device__ __forceinline__ void done(const Unit&) const {}
};
struct BranchSched {
    TileOrder o;
    __device__ __forceinline__ bool next(int i, Unit& u) const { int pm, pn; if (!o.tile(i, pm, pn)) return false;
        u.aoff = (unsigned)pm * 256u * YC_LD * 2u; u.boff = (unsigned)pn * 256u * YC_LD * 2u; u.nt = 20; u.pm = pm; u.pn = pn; u.aux = 0; return true; }
    __device__ __forceinline__ void a_ready(const Unit&) const {}
    __device__ __forceinline__ void done(const Unit&) const {}
};
__device__ __forceinline__ void pair_experts(int b, int& e0, int& e1) { const int g = b / 6, p = b % 6; const int lo = p < 3 ? 0 : (p < 5 ? 1 : 2), hi = p < 3 ? p + 1 : (p < 5 ? p - 1 : 3); e0 = g * 4 + lo; e1 = g * 4 + hi; }
constexpr int MOE_TBL_TOT = MPAD / 256;
__device__ __forceinline__ void moe_table(PG8_LAS int* tbl, const unsigned* cnt) {
    int t = threadIdx.x; asm volatile("" : "+v"(t));
    if (t <= MOE_TBL_TOT) { int tot = 0, bsel = NBUCKET - 1, found = 0;
#pragma nounroll
        for (int b = 0; b < NBUCKET; ++b) { const int tb = (int)((__hip_atomic_load(cnt + 64 * b, __ATOMIC_RELAXED, __HIP_MEMORY_SCOPE_AGENT) + 255u) >> 8); if (!found && t < tot + tb) { bsel = b; found = 1; } tot += tb; }
        tbl[t] = t == MOE_TBL_TOT ? tot : bsel; }
    __syncthreads();
}
template <int PHASE> struct MoeSched {
    const PG8_LAS int* tbl; int G, c;
    __device__ __forceinline__ bool next(int i, Unit& u) const {
        constexpr int NT = PHASE == 1 ? 6 : 4;
        const int L = i * G + c, pm = L / NT, pn = L % NT;
        if (pm >= __builtin_amdgcn_readfirstlane(tbl[MOE_TBL_TOT])) return false;
        const int bsel = __builtin_amdgcn_readfirstlane(tbl[pm]);
        int e0, e1; pair_experts(bsel, e0, e1);
        u.pm = pm; u.pn = pn; u.aux = 0;
        if (PHASE == 1) { const int sel = pn / 3, jt = pn % 3, e = sel ? e1 : e0;
            u.aoff = (unsigned)pm * 256u * DM * 2u; u.boff = (unsigned)(e * 3 + jt) * 256u * DM * 2u; u.nt = 16; }
        else { u.aoff = (unsigned)pm * 256u * 768u * 2u; u.boff = ((unsigned)bsel * 1024u + (unsigned)pn * 256u) * 768u * 2u; u.nt = 12; }
        return true;
    }
    __device__ __forceinline__ void a_ready(const Unit&) const {}
    __device__ __forceinline__ void done(const Unit&) const {}
};

__device__ __forceinline__ unsigned cvt_pk_bf16(float lo, float hi) { unsigned r; asm volatile("v_cvt_pk_bf16_f32 %0, %1, %2" : "=v"(r) : "v"(lo), "v"(hi)); return r; }
__device__ __forceinline__ u32x4 pack8(const f32x4 a, const f32x4 b) { u32x4 w; w.x = cvt_pk_bf16(a[0], a[1]); w.y = cvt_pk_bf16(a[2], a[3]); w.z = cvt_pk_bf16(b[0], b[1]); w.w = cvt_pk_bf16(b[2], b[3]); return w; }
__device__ __forceinline__ float fsig(float x) { return __builtin_amdgcn_rcpf(1.f + __builtin_amdgcn_exp2f(-1.4426950408889634f * x)); }
#define PG8_EPI_LOOP for (int ai = 0; ai < 2; ++ai) _Pragma("unroll") for (int m = 0; m < 4; ++m) _Pragma("unroll") for (int bj = 0; bj < 3; ++bj) if (bj == 2) { asm volatile("" ::: "memory"); } else

struct EpiInMix {
    static constexpr bool PERM = true, AFTER_DRAIN = false, MID = false; unsigned char* ws;
    __device__ __forceinline__ void operator()(const f32x4 (&acc)[2][2][4][2], const Unit& u, int wr, int wc, int fr, int fq) const {
        const int pn = u.pn; bf16_t* base; int ld;
        if (pn < 2) { base = (bf16_t*)(ws + WS_YCAT) + YC_Q + pn * 256; ld = YC_LD; }
        else if (pn < 4) { base = (bf16_t*)(ws + WS_K) + (pn - 2) * 256; ld = 512; }
        else if (pn < 6) { base = (bf16_t*)(ws + WS_V) + (pn - 4) * 256; ld = 512; }
        else if (pn == 6) { base = (bf16_t*)(ws + WS_YCAT) + YC_SB; ld = YC_LD; }
        else if (pn == 7) { base = (bf16_t*)(ws + WS_SBK); ld = 256; }
        else if (pn == 8) { base = (bf16_t*)(ws + WS_SBV); ld = 256; }
        else if (pn == 9) { base = (bf16_t*)(ws + WS_HGF); ld = 256; }
        else if (pn == 10) { base = (bf16_t*)(ws + WS_HGI); ld = 256; }
        else if (pn == 11) { base = (bf16_t*)(ws + WS_YCAT) + YC_HG; ld = YC_LD; }
        else if (pn == 12) { base = (bf16_t*)(ws + WS_HGG); ld = 256; }
        else { base = (bf16_t*)(ws + WS_S5U); ld = 16; }
        const int row0 = u.pm * BM + wr * 64 + fr, col0 = wc * 32 + 8 * fq;
#pragma unroll
        PG8_EPI_LOOP { const int row = row0 + ai * HALF + m * 16, col = col0 + bj * HALF; const u32x4 w = pack8(acc[ai][bj][m][0], acc[ai][bj][m][1]);
            if (pn == 13) *(u32x4*)(base + ((size_t)(col >> 4) * 1024 + (row >> 5)) * S5_LD + (row & 31) * 16 + (col & 15)) = w;
            else *(u32x4*)(base + (size_t)row * ld + col) = w; }
    }
};
struct EpiGateU8 {
    static constexpr bool PERM = true, AFTER_DRAIN = false, MID = false; unsigned char* G;
    __device__ __forceinline__ void operator()(const f32x4 (&acc)[2][2][4][2], const Unit& u, int wr, int wc, int fr, int fq) const {
        const int row0 = u.pm * BM + wr * 64 + fr, col0 = (u.pn & 3) * BM + wc * 32 + 8 * fq; unsigned char* Gp = G + (size_t)(u.pn >> 2) * ((size_t)NTOK * 1024);
#pragma unroll
        PG8_EPI_LOOP { const f32x4 a = acc[ai][bj][m][0], b = acc[ai][bj][m][1]; unsigned q[8];
#pragma unroll
            for (int i = 0; i < 4; ++i) { q[i] = (unsigned)(fsig(a[i]) * 255.f + 0.5f); q[4 + i] = (unsigned)(fsig(b[i]) * 255.f + 0.5f); }
            u32x2 w; w.x = q[0] | (q[1] << 8) | (q[2] << 16) | (q[3] << 24); w.y = q[4] | (q[5] << 8) | (q[6] << 16) | (q[7] << 24);
            *(u32x2*)(Gp + (size_t)(row0 + ai * HALF + m * 16) * 1024 + col0 + bj * HALF) = w; }
    }
};
struct EpiBranch {
    static constexpr bool PERM = true, AFTER_DRAIN = false, MID = true; const unsigned char* G; bf16_t* Mg;
    static constexpr size_t PLANE = (size_t)NTOK * 1024;
    __device__ __forceinline__ void gl2(u32x2 (&g)[4], const unsigned char* gp0, int k) const {
        const unsigned char* gp = gp0 + (size_t)((k >> 2) * HALF + (k & 3) * 16) * 1024;
        g[0] = *(const u32x2*)gp; g[1] = *(const u32x2*)(gp + PLANE); g[2] = *(const u32x2*)(gp + HALF); g[3] = *(const u32x2*)(gp + PLANE + HALF);
    }
    __device__ __forceinline__ void mid(f32x4 (&acc)[2][2][4][2], const Unit& u, int t, int, int, int, int) const {
        int tid = threadIdx.x; asm volatile("" : "+v"(tid));
        const int wid = __builtin_amdgcn_readfirstlane(tid >> 6), wr = wid >> 2, wc = wid & 3, fr = tid & 15, fq = (tid & 63) >> 4;
        const int row0 = u.pm * BM + wr * 64 + fr, col0 = u.pn * BM + wc * 32 + 8 * fq;
        const unsigned char* gp0 = G + (size_t)((t - 8) >> 2) * PLANE + (size_t)row0 * 1024 + col0;
        u32x2 gc[4], gn[4]; gl2(gc, gp0, 0);
#pragma unroll
        for (int k = 0; k < 8; ++k) { const int ai = k >> 2, m = k & 3;
            if (k < 7) gl2(gn, gp0, k + 1);
#pragma unroll
            for (int bj = 0; bj < 2; ++bj)
#pragma unroll
                for (int i = 0; i < 4; ++i) { acc[ai][bj][m][0][i] *= fmaxf((float)((gc[2 * bj].x >> (8 * i)) & 255u), 0.5f) * __builtin_amdgcn_rcpf(fmaxf((float)((gc[2 * bj + 1].x >> (8 * i)) & 255u), 0.5f));
                                              acc[ai][bj][m][1][i] *= fmaxf((float)((gc[2 * bj].y >> (8 * i)) & 255u), 0.5f) * __builtin_amdgcn_rcpf(fmaxf((float)((gc[2 * bj + 1].y >> (8 * i)) & 255u), 0.5f)); }
            asm volatile("" ::: "memory");
#pragma unroll
            for (int q = 0; q < 4; ++q) gc[q] = gn[q]; }
    }
    __device__ __forceinline__ void gl1(u32x2 (&g)[2], const unsigned char* gp0, int k) const { const unsigned char* gp = gp0 + (size_t)((k >> 2) * HALF + (k & 3) * 16) * 1024; g[0] = *(const u32x2*)gp; g[1] = *(const u32x2*)(gp + HALF); }
    __device__ __forceinline__ void operator()(const f32x4 (&acc)[2][2][4][2], const Unit& u, int, int, int, int) const {
        int tid = threadIdx.x; asm volatile("" : "+v"(tid));
        const int wid = __builtin_amdgcn_readfirstlane(tid >> 6), wr = wid >> 2, wc = wid & 3, fr = tid & 15, fq = (tid & 63) >> 4;
        const int row0 = u.pm * BM + wr * 64 + fr, col0 = u.pn * BM + wc * 32 + 8 * fq;
        const unsigned char* gp0 = G + 3 * PLANE + (size_t)row0 * 1024 + col0;
        u32x2 gc[2], gn[2]; gl1(gc, gp0, 0);
#pragma unroll
        for (int k = 0; k < 8; ++k) { const int ai = k >> 2, m = k & 3, row = row0 + ai * HALF + m * 16;
            if (k < 7) gl1(gn, gp0, k + 1);
#pragma unroll
            for (int bj = 0; bj < 2; ++bj) { f32x4 a = acc[ai][bj][m][0], b = acc[ai][bj][m][1];
#pragma unroll
                for (int i = 0; i < 4; ++i) { a[i] *= fmaxf((float)((gc[bj].x >> (8 * i)) & 255u), 0.5f) * (1.f / 255.f); b[i] *= fmaxf((float)((gc[bj].y >> (8 * i)) & 255u), 0.5f) * (1.f / 255.f); }
                *(u32x4*)(Mg + (size_t)row * DM + col0 + bj * HALF) = pack8(a, b); }
            asm volatile("" ::: "memory");
            gc[0] = gn[0]; gc[1] = gn[1]; }
    }
};
struct EpiOutRes {
    static constexpr bool PERM = true, AFTER_DRAIN = false, MID = false; const float* xi; float* xo;
    __device__ __forceinline__ void ld(f32x4 (&r)[4], size_t off) const { r[0] = *(const f32x4*)(xi + off); r[1] = *(const f32x4*)(xi + off + 4); r[2] = *(const f32x4*)(xi + off + HALF); r[3] = *(const f32x4*)(xi + off + HALF + 4); }
    __device__ __forceinline__ void operator()(const f32x4 (&acc)[2][2][4][2], const Unit& u, int wr, int wc, int fr, int fq) const {
        const int row0 = u.pm * BM + wr * 64 + fr, col0 = u.pn * BM + wc * 32 + 8 * fq;
        f32x4 rc[4], rn[4]; ld(rc, (size_t)row0 * DM + col0);
#pragma unroll
        for (int k = 0; k < 8; ++k) { const int ai = k >> 2, m = k & 3; const size_t off = (size_t)(row0 + ai * HALF + m * 16) * DM + col0;
            if (k < 7) ld(rn, (size_t)(row0 + ((k + 1) >> 2) * HALF + ((k + 1) & 3) * 16) * DM + col0);
            *(f32x4*)(xo + off) = rc[0] + acc[ai][0][m][0]; *(f32x4*)(xo + off + 4) = rc[1] + acc[ai][0][m][1]; *(f32x4*)(xo + off + HALF) = rc[2] + acc[ai][1][m][0]; *(f32x4*)(xo + off + HALF + 4) = rc[3] + acc[ai][1][m][1];
            asm volatile("" ::: "memory");
#pragma unroll
            for (int q = 0; q < 4; ++q) rc[q] = rn[q]; }
    }
};
struct EpiGlu {
    static constexpr bool PERM = true, AFTER_DRAIN = false, MID = false; const bf16_t* yg; const float* bias; bf16_t* yc;
    __device__ __forceinline__ void operator()(const f32x4 (&acc)[2][2][4][2], const Unit& u, int wr, int wc, int fr, int fq) const {
        const int row0 = u.pm * BM + wr * 64 + fr, col0 = wc * 32 + 8 * fq;
#pragma unroll
        PG8_EPI_LOOP { const int row = row0 + ai * HALF + m * 16, col = col0 + bj * HALF;
            const u32x4 p = *(const u32x4*)(yg + (size_t)row * 256 + col); const f32x4 b0 = *(const f32x4*)(bias + col), b1 = *(const f32x4*)(bias + col + 4);
            f32x4 a = acc[ai][bj][m][0] + b0, b = acc[ai][bj][m][1] + b1;
            const float y[8] = {__uint_as_float(p.x << 16), __uint_as_float(p.x & 0xffff0000u), __uint_as_float(p.y << 16), __uint_as_float(p.y & 0xffff0000u),
                                __uint_as_float(p.z << 16), __uint_as_float(p.z & 0xffff0000u), __uint_as_float(p.w << 16), __uint_as_float(p.w & 0xffff0000u)};
#pragma unroll
            for (int i = 0; i < 4; ++i) { a[i] = y[i] * fsig(a[i]); b[i] = y[4 + i] * fsig(b[i]); }
            *(u32x4*)(yc + (size_t)row * YC_LD + YC_YD + col) = pack8(a, b); }
    }
};
struct S5aSched {
    int G, c;
    __device__ __forceinline__ bool next(int i, Unit& u) const { const int L = i * G + c; if (L >= 64) return false; const int g = L >> 2, pm = L & 3;
        u.aoff = ((unsigned)(g * 1024 + pm * 256) * S5_LD) * 2u; u.boff = (unsigned)g * 256u * 512u * 2u; u.nt = 8; u.pm = g * 4 + pm; u.pn = 0; u.aux = 0; return true; }
    __device__ __forceinline__ void a_ready(const Unit&) const {}
    __device__ __forceinline__ void done(const Unit&) const {}
};
struct S5bSched {
    int G, c;
    __device__ __forceinline__ bool next(int i, Unit& u) const { const int L = i * G + c; if (L >= 128) return false; const int g = L >> 3, pm = (L >> 1) & 3, pn = L & 1;
        u.aoff = ((unsigned)(g * 1024 + pm * 256) * S5_LD) * 2u; u.boff = ((unsigned)(g * 512 + pn * 256) * S5_LD) * 2u; u.nt = 10; u.pm = g * 4 + pm; u.pn = pn; u.aux = g; return true; }
    __device__ __forceinline__ void a_ready(const Unit&) const {}
    __device__ __forceinline__ void done(const Unit&) const {}
};
struct EpiS5a {
    static constexpr bool PERM = true, AFTER_DRAIN = false, MID = false; float* st;
    __device__ __forceinline__ void operator()(const f32x4 (&acc)[2][2][4][2], const Unit& u, int wr, int wc, int fr, int fq) const {
        const int row0 = u.pm * BM + wr * 64 + fr, col0 = wc * 32 + 8 * fq;
#pragma unroll
        for (int ai = 0; ai < 2; ++ai)
#pragma unroll
            for (int m = 0; m < 4; ++m) { float* p = st + (size_t)(row0 + ai * HALF + m * 16) * 128 + col0; *(f32x4*)p = acc[ai][0][m][0]; *(f32x4*)(p + 4) = acc[ai][0][m][1]; }
    }
};
struct EpiS5b {
    static constexpr bool PERM = true, AFTER_DRAIN = false, MID = false; const bf16_t* s5u; const float* dsk; bf16_t* yg;
    __device__ __forceinline__ void operator()(const f32x4 (&acc)[2][2][4][2], const Unit& u, int wr, int wc, int fr, int fq) const {
        const int g = u.aux, row0 = u.pm * BM + wr * 64 + fr  , col0 = u.pn * BM + wc * 32 + 8 * fq, c0 = col0 & 15;
        const f32x4 d0 = *(const f32x4*)(dsk + g * 16 + c0), d1 = *(const f32x4*)(dsk + g * 16 + c0 + 4);
#pragma unroll
        PG8_EPI_LOOP { const int row = row0 + ai * HALF + m * 16, col = col0 + bj * HALF, chunk = row - g * 1024, t = col >> 4;
            const u32x4 p = *(const u32x4*)(s5u + (size_t)row * S5_LD + col);
            const float uu[8] = {__uint_as_float(p.x << 16), __uint_as_float(p.x & 0xffff0000u), __uint_as_float(p.y << 16), __uint_as_float(p.y & 0xffff0000u),
                                 __uint_as_float(p.z << 16), __uint_as_float(p.z & 0xffff0000u), __uint_as_float(p.w << 16), __uint_as_float(p.w & 0xffff0000u)};
            f32x4 a = acc[ai][bj][m][0], b = acc[ai][bj][m][1];
#pragma unroll
            for (int i = 0; i < 4; ++i) { float y = a[i] + d0[i] * uu[i]; float z = 0.7978845608028654f * (y + 0.044715f * y * y * y); a[i] = y * fsig(2.f * z);
                y = b[i] + d1[i] * uu[4 + i]; z = 0.7978845608028654f * (y + 0.044715f * y * y * y); b[i] = y * fsig(2.f * z); }
            *(u32x4*)(yg + (size_t)(chunk * 32 + t) * 256 + g * 16 + c0) = pack8(a, b); }
    }
};
struct EpiMoe1 {
    static constexpr bool PERM = true, AFTER_DRAIN = false, MID = false; bf16_t* hid; const float* slot_w;
    __device__ __forceinline__ void operator()(const f32x4 (&acc)[2][2][4][2], const Unit& u, int wr, int wc, int fr, int fq) const {
        const int row0 = u.pm * BM + wr * 64 + fr, sel = u.pn / 3, col0 = sel * DEXP + (u.pn % 3) * 128 + wc * 32 + 8 * fq;
#pragma unroll
        for (int ai = 0; ai < 2; ++ai)
#pragma unroll
            for (int m = 0; m < 4; ++m) { const int row = row0 + ai * HALF + m * 16; const float w = slot_w[2 * row + sel]; f32x4 a, b;
#pragma unroll
                for (int i = 0; i < 4; ++i) { const float g0 = acc[ai][0][m][0][i], g1 = acc[ai][0][m][1][i]; a[i] = g0 * fsig(g0) * acc[ai][1][m][0][i] * w; b[i] = g1 * fsig(g1) * acc[ai][1][m][1][i] * w; }
                *(u32x4*)(hid + (size_t)row * 768 + col0) = pack8(a, b); asm volatile("" ::: "memory"); }
    }
};
struct EpiMoe2 {
    static constexpr bool PERM = true, AFTER_DRAIN = false, MID = false; float* x; const int* slot_tok; float* dummy;
    __device__ __forceinline__ void operator()(const f32x4 (&acc)[2][2][4][2], const Unit& u, int wr, int wc, int fr, int fq) const {
        const int row0 = u.pm * BM + wr * 64 + fr, col0 = u.pn * BM + wc * 32 + 8 * fq;
        int tk[8];
#pragma unroll
        for (int k = 0; k < 8; ++k) tk[k] = slot_tok[row0 + (k >> 2) * HALF + (k & 3) * 16];
        f32x4 rc[4], rn[4]; float* pc = (tk[0] >= 0 ? x + (size_t)tk[0] * DM : dummy) + col0;
        rc[0] = *(const f32x4*)pc; rc[1] = *(const f32x4*)(pc + 4); rc[2] = *(const f32x4*)(pc + HALF); rc[3] = *(const f32x4*)(pc + HALF + 4);
#pragma unroll
        for (int k = 0; k < 8; ++k) { const int ai = k >> 2, m = k & 3; float* pn = pc;
            if (k < 7) { pn = (tk[k + 1] >= 0 ? x + (size_t)tk[k + 1] * DM : dummy) + col0; rn[0] = *(const f32x4*)pn; rn[1] = *(const f32x4*)(pn + 4); rn[2] = *(const f32x4*)(pn + HALF); rn[3] = *(const f32x4*)(pn + HALF + 4); }
            *(f32x4*)pc = rc[0] + acc[ai][0][m][0]; *(f32x4*)(pc + 4) = rc[1] + acc[ai][0][m][1]; *(f32x4*)(pc + HALF) = rc[2] + acc[ai][1][m][0]; *(f32x4*)(pc + HALF + 4) = rc[3] + acc[ai][1][m][1];
            asm volatile("" ::: "memory");
            pc = pn;
#pragma unroll
            for (int q = 0; q < 4; ++q) rc[q] = rn[q]; }
    }
};

template <class Epi, class Sched, bool ALIGN_EPI = false, bool SP2 = false>
__device__ __forceinline__ void gemm_phase(PG8_LAS unsigned char* lds, const Gemm g, const Sched& S, const Epi& E) {
    int tid_ = threadIdx.x; asm volatile("" : "+v"(tid_));
    const int tid = tid_, wid = __builtin_amdgcn_readfirstlane(tid >> 6), lane = tid & 63, wr = wid >> 2, wc = wid & 3, fr = lane & 15, fq = lane >> 4;
    unsigned voffA[2], voffB[2];
#pragma unroll
    for (int i = 0; i < 2; ++i) { int R, C; stage_rc(tid * 16 + i * 8192, R, C); const int Rb = Epi::PERM ? ((R & ~31) + perm32(R & 31)) : R;
        voffA[i] = (unsigned)(R * g.lda + C) * 2u; voffB[i] = (unsigned)(Rb * g.ldb + C) * 2u; }
    const size_t kstep = (size_t)(BK * 2);
    const size_t hstepA = (size_t)HALF * g.lda * 2, hstepB = (size_t)HALF * g.ldb * 2;
    const unsigned ldsw = (unsigned)wid * 1024u;
    const int aoff = lds_byte(wr * 64 + fr, fq * 8), boff = lds_byte(wc * 32 + fr, fq * 8);
#define PG8_SA(b, h) (((b) * 2 + (h)) * HTB)
#define PG8_SB(b, h) ((4 + (b) * 2 + (h)) * HTB)
#define PG8_STAGE(bufoff, gbase, voff) do { _Pragma("unroll") for (int _i = 0; _i < 2; ++_i) \
        __builtin_amdgcn_global_load_lds((const unsigned*)((const char*)(gbase) + (voff)[_i]), (PG8_LAS unsigned*)(lds + (bufoff) + ldsw + _i * 8192), 16, 0, 0); } while (0)
#define PG8_LDA(dst, b, h) do { _Pragma("unroll") for (int m = 0; m < 4; ++m) _Pragma("unroll") for (int k = 0; k < 2; ++k) dst[m][k] = *(const PG8_LAS bf16x8*)(lds + PG8_SA(b, h) + aoff + m * 2048 + k * 1024); } while (0)
#define PG8_LDB(dst, b, h) do { _Pragma("unroll") for (int n = 0; n < 2; ++n) _Pragma("unroll") for (int k = 0; k < 2; ++k) dst[n][k] = *(const PG8_LAS bf16x8*)(lds + PG8_SB(b, h) + boff + n * 2048 + k * 1024); } while (0)
#define PG8_MMA(ai, bj, At, Bt) do { __builtin_amdgcn_s_setprio(1); _Pragma("unroll") for (int m = 0; m < 4; ++m) _Pragma("unroll") for (int n = 0; n < 2; ++n) _Pragma("unroll") for (int k = 0; k < 2; ++k) \
        acc[ai][bj][m][n] = __builtin_amdgcn_mfma_f32_16x16x32_bf16(Bt[n][k], At[m][k], acc[ai][bj][m][n], 0, 0, 0); __builtin_amdgcn_s_setprio(0); } while (0)
#define PG8_WAIT_V(n) asm volatile("s_waitcnt vmcnt(" #n ")" ::: "memory")
#define PG8_WAIT_L(n) asm volatile("s_waitcnt lgkmcnt(" #n ")" ::: "memory")
#define PG8_BAR __builtin_amdgcn_s_barrier()
#define PG8_SCHED __builtin_amdgcn_sched_barrier(0)
    Unit cur; int ui = 0;
    if (!S.next(0, cur)) return;
    f32x4 acc[2][2][4][2];
#pragma unroll
    for (int a = 0; a < 2; ++a)
#pragma unroll
        for (int b = 0; b < 2; ++b)
#pragma unroll
            for (int m = 0; m < 4; ++m)
#pragma unroll
                for (int n = 0; n < 2; ++n) acc[a][b][m][n] = (f32x4){0.f, 0.f, 0.f, 0.f};
    bf16x8 At[4][2], B0[2][2], B1[2][2];
    const char* cA = (const char*)g.A + cur.aoff; const char* cB = (const char*)g.Bt + cur.boff;
    S.a_ready(cur);
    if constexpr (SP2) {
        PG8_STAGE(PG8_SB(0, 0), cB, voffB); PG8_STAGE(PG8_SB(0, 1), cB + hstepB, voffB); PG8_STAGE(PG8_SA(0, 0), cA, voffA); PG8_STAGE(PG8_SA(0, 1), cA + hstepA, voffA);
        if (wr == 1) PG8_BAR;
        PG8_WAIT_V(2); PG8_BAR;
        PG8_STAGE(PG8_SB(1, 0), cB + kstep, voffB); PG8_STAGE(PG8_SA(1, 0), cA + kstep, voffA); PG8_STAGE(PG8_SB(1, 1), cB + hstepB + kstep, voffB);
        PG8_WAIT_V(6); PG8_BAR;
    } else {
        PG8_STAGE(PG8_SB(0, 0), cB, voffB); PG8_STAGE(PG8_SA(0, 0), cA, voffA); PG8_STAGE(PG8_SB(0, 1), cB + hstepB, voffB); PG8_STAGE(PG8_SA(0, 1), cA + hstepA, voffA);
        if (wr == 1) PG8_BAR;
        PG8_WAIT_V(4); PG8_BAR;
        PG8_STAGE(PG8_SB(1, 0), cB + kstep, voffB); PG8_STAGE(PG8_SA(1, 0), cA + kstep, voffA); PG8_STAGE(PG8_SB(1, 1), cB + hstepB + kstep, voffB);
        PG8_WAIT_V(6); PG8_BAR;
    }
    for (;;) {
        Unit nxt; const bool has_next = S.next(ui + 1, nxt);
        const char* nA = has_next ? (const char*)g.A + nxt.aoff : cA; const char* nB = has_next ? (const char*)g.Bt + nxt.boff : cB;
        const int nt = cur.nt;
        for (int t = 0; t < nt; t += 2) {
            const bool last = (t == nt - 2);
            const char* a1 = cA + (size_t)(t + 1) * kstep;
            const char* a2 = last ? nA : cA + (size_t)(t + 2) * kstep; const char* b2 = last ? nB : cB + (size_t)(t + 2) * kstep;
            const char* a3 = a2 + kstep; const char* b3 = b2 + kstep;
            if (last && has_next) S.a_ready(nxt);
            if constexpr (Epi::MID) { if (t == 8 || t == 12 || t == 16) E.mid(acc, cur, t, wr, wc, fr, fq); }
            if constexpr (SP2) {
            PG8_LDB(B0, 0, 0); PG8_LDB(B1, 0, 1); PG8_SCHED; PG8_LDA(At, 0, 0); PG8_STAGE(PG8_SA(1, 1), a1 + hstepA, voffA);
            PG8_WAIT_V(8); PG8_WAIT_L(0); PG8_BAR; PG8_MMA(0, 0, At, B0); PG8_MMA(0, 1, At, B1); PG8_BAR; PG8_SCHED;
            PG8_LDA(At, 0, 1); PG8_STAGE(PG8_SB(0, 0), b2, voffB); PG8_STAGE(PG8_SB(0, 1), b2 + hstepB, voffB); PG8_STAGE(PG8_SA(0, 0), a2, voffA);
            PG8_WAIT_V(8); PG8_WAIT_L(0); PG8_BAR; PG8_MMA(1, 0, At, B0); PG8_MMA(1, 1, At, B1); PG8_BAR; PG8_SCHED;
            PG8_LDB(B0, 1, 0); PG8_LDB(B1, 1, 1); PG8_SCHED; PG8_LDA(At, 1, 0); PG8_STAGE(PG8_SA(0, 1), a2 + hstepA, voffA);
            PG8_WAIT_V(8); PG8_WAIT_L(0); PG8_BAR; PG8_MMA(0, 0, At, B0); PG8_MMA(0, 1, At, B1); PG8_BAR; PG8_SCHED;
            PG8_LDA(At, 1, 1); PG8_STAGE(PG8_SB(1, 0), b3, voffB); PG8_STAGE(PG8_SB(1, 1), b3 + hstepB, voffB); PG8_STAGE(PG8_SA(1, 0), a3, voffA);
            PG8_WAIT_V(8); PG8_WAIT_L(0); PG8_BAR; PG8_MMA(1, 0, At, B0); PG8_MMA(1, 1, At, B1); PG8_BAR; PG8_SCHED;
            } else {
            PG8_LDB(B0, 0, 0); PG8_SCHED; PG8_LDA(At, 0, 0); PG8_STAGE(PG8_SA(1, 1), a1 + hstepA, voffA);
            PG8_WAIT_L(8); PG8_BAR; PG8_WAIT_L(0); PG8_MMA(0, 0, At, B0); PG8_BAR; PG8_SCHED;
            PG8_LDB(B1, 0, 1); PG8_STAGE(PG8_SB(0, 0), b2, voffB);
            PG8_BAR; PG8_WAIT_L(0); PG8_MMA(0, 1, At, B1); PG8_BAR;
            PG8_LDA(At, 0, 1); PG8_STAGE(PG8_SA(0, 0), a2, voffA);
            PG8_BAR; PG8_WAIT_L(0); PG8_MMA(1, 0, At, B0); PG8_BAR; PG8_SCHED;
            PG8_STAGE(PG8_SB(0, 1), b2 + hstepB, voffB);
            PG8_WAIT_V(6); PG8_BAR; PG8_MMA(1, 1, At, B1); PG8_BAR;
            PG8_LDB(B0, 1, 0); PG8_SCHED; PG8_LDA(At, 1, 0); PG8_STAGE(PG8_SA(0, 1), a2 + hstepA, voffA);
            PG8_WAIT_L(8); PG8_BAR; PG8_WAIT_L(0); PG8_MMA(0, 0, At, B0); PG8_BAR; PG8_SCHED;
            PG8_LDB(B1, 1, 1); PG8_STAGE(PG8_SB(1, 0), b3, voffB);
            PG8_BAR; PG8_WAIT_L(0); PG8_MMA(0, 1, At, B1); PG8_BAR;
            PG8_LDA(At, 1, 1); PG8_STAGE(PG8_SA(1, 0), a3, voffA);
            PG8_BAR; PG8_WAIT_L(0); PG8_MMA(1, 0, At, B0); PG8_BAR; PG8_SCHED;
            PG8_STAGE(PG8_SB(1, 1), b3 + hstepB, voffB);
            PG8_WAIT_V(6); PG8_BAR; PG8_MMA(1, 1, At, B1); PG8_BAR;
            }
        }
        if constexpr (ALIGN_EPI) { if (wr == 0) PG8_BAR; }
        if constexpr (!Epi::AFTER_DRAIN) { E(acc, cur, wr, wc, fr, fq); S.done(cur); }
        if (!has_next) break;
#pragma unroll
        for (int a = 0; a < 2; ++a)
#pragma unroll
            for (int b = 0; b < 2; ++b)
#pragma unroll
                for (int m = 0; m < 4; ++m)
#pragma unroll
                    for (int n = 0; n < 2; ++n) acc[a][b][m][n] = (f32x4){0.f, 0.f, 0.f, 0.f};
        cA = nA; cB = nB; ++ui; (void)S.next(ui, cur);
        if constexpr (ALIGN_EPI) { if (wr == 1) PG8_BAR; }
    }
    PG8_WAIT_V(0);
    if constexpr (!ALIGN_EPI) { if (wr == 0) PG8_BAR; }
    PG8_BAR;
    if constexpr (Epi::AFTER_DRAIN) { E.fused(acc, cur, wr, wc, fr, fq, lds, wid, lane); S.done(cur); }
#undef PG8_SA
#undef PG8_SB
#undef PG8_STAGE
#undef PG8_LDA
#undef PG8_LDB
#undef PG8_MMA
#undef PG8_WAIT_V
#undef PG8_WAIT_L
#undef PG8_BAR
#undef PG8_SCHED
}
}

#include <hip/hip_bf16.h>
#include <cmath>
namespace attn_body {
using bf16=__hip_bfloat16;
using bf16x8=__attribute__((ext_vector_type(8)))short;
using s16x4=__attribute__((ext_vector_type(4)))short;
using f32x16=__attribute__((ext_vector_type(16)))float;
using u32x4=__attribute__((ext_vector_type(4)))unsigned;
constexpr int BATCH=4,NHEAD=16,SEQ=8192,D=64;
constexpr int QP=1280,KP=512,VP=512,OP=1024;
constexpr int NW=8,QBLK=32,QB=QBLK*NW,KVBLK=64,NQB=SEQ/QB;
constexpr int ATTN_UNIT_ROWS=QB;
__device__ __forceinline__ int crow(int r,int hi){return (r&3)+8*(r>>2)+4*hi;}
#define SBAR() __builtin_amdgcn_sched_barrier(0)
__device__ __forceinline__ void cmask(f32x16&p0,f32x16&p1,int jb,int qrel,int hi){
  const float NEG=-INFINITY; int kb=64*jb+4*hi;
  #pragma unroll
  for(int r=0;r<16;++r){int kv=kb+(r&3)+8*(r>>2); if(kv>qrel)p0[r]=NEG; if(kv+32>qrel)p1[r]=NEG;}
}

constexpr int NSLOT=3, SLOTB=8192;
constexpr int LDS_K=0, LDS_V=NSLOT*SLOTB, LDS_WS=2*NSLOT*SLOTB, LDS_OST=LDS_WS+NW*64*4, LDS_BYTES=LDS_OST+NW*4096;
constexpr float C2=0.125f*1.4426950408889634f;
__device__ __forceinline__ void glds16(const void*gsrc,unsigned lds_dst){unsigned keep;
  asm volatile("s_mov_b32 %0, m0\n\ts_mov_b32 m0, %2\n\ts_nop 0\n\tglobal_load_lds_dwordx4 %1, off\n\ts_mov_b32 m0, %0":"=&s"(keep):"v"(gsrc),"s"(lds_dst):"memory");}
__device__ __forceinline__ float max3f(float a,float b,float c){float r;asm("v_max3_f32 %0, %1, %2, %3":"=v"(r):"v"(a),"v"(b),"v"(c));return r;}
__device__ __forceinline__ float max2f(float a,float b){float r;asm("v_max_f32_e32 %0, %1, %2":"=v"(r):"v"(a),"v"(b));return r;}
__device__ __forceinline__ float fadd_s(float a,float b){float r;asm("v_add_f32_e32 %0, %1, %2":"=v"(r):"v"(a),"v"(b));return r;}
__device__ __forceinline__ float fsub_s(float a,float b){float r;asm("v_sub_f32_e32 %0, %1, %2":"=v"(r):"v"(a),"v"(b));return r;}
typedef float f32x2_t __attribute__((ext_vector_type(2))); typedef __bf16 bf16x2_t __attribute__((ext_vector_type(2)));
__device__ __forceinline__ unsigned cvtpk_s(float lo,float hi){f32x2_t v={lo,hi};bf16x2_t b=__builtin_convertvector(v,bf16x2_t);return __builtin_bit_cast(unsigned,b);}
#define WAIT_BAR(N) asm volatile("s_waitcnt vmcnt(" #N ") lgkmcnt(0)\n\ts_barrier":::"memory")

__device__ __forceinline__ float rowmax(const f32x16&p0,const f32x16&p1){
  float a=max3f(p0[0],p0[1],p1[0]),b=max3f(p0[2],p0[3],p1[1]);a=max3f(a,p1[2],p1[3]);
  #pragma unroll
  for(int r=4;r<16;r+=4){a=max3f(a,p0[r],p0[r+1]);b=max3f(b,p0[r+2],p0[r+3]);a=max3f(a,p1[r],p1[r+1]);b=max3f(b,p1[r+2],p1[r+3]);}
  const float m=max2f(a,b);
  auto rr=__builtin_amdgcn_permlane32_swap(__float_as_uint(m),__float_as_uint(m),false,false);
  return max2f(__uint_as_float(rr[0]),__uint_as_float(rr[1]));
}

#undef SBAR
#undef WAIT_BAR
}

namespace attn2 {
using attn_body::bf16; using attn_body::bf16x8; using attn_body::s16x4; using attn_body::f32x16; using attn_body::u32x4; using attn_body::crow; using attn_body::cmask; using attn_body::glds16; using attn_body::rowmax; using attn_body::cvtpk_s;
constexpr int SEQ = 8192, QP = 1280, KP = 512, VP = 512, OP = 1024, NW = 8, QBLK = 32, QB = 256, KVBLK = 64, NSLOT = 3, NVSLOT = 4, KSLOT = 8192, VSLOT = 16384;
constexpr int LDS_K = 0, LDS_V = NSLOT * KSLOT, LDS_WS = LDS_V + NVSLOT * VSLOT, LDS_OST = LDS_WS + NW * 64 * 4, LDS_BYTES = LDS_OST + NW * 4096;
typedef __attribute__((address_space(3))) const char* lds_cptr; typedef short v4i16_t __attribute__((ext_vector_type(4)));
__device__ __forceinline__ s16x4 vtr(lds_cptr p) { return __builtin_bit_cast(s16x4, __builtin_amdgcn_ds_read_tr16_b64_v4i16((__attribute__((address_space(3))) v4i16_t*)p)); }
template <int THRL> __device__ __forceinline__ void attn_unit(int b, int hc, int qb, const bf16* Q, const bf16* __restrict__ K, const bf16* __restrict__ V, bf16* O, char* shm) {
    int tid_ = threadIdx.x; asm volatile("" : "+v"(tid_)); const int tid = tid_, lane = tid & 63, r32 = lane & 31, hi = lane >> 5; const int wid = __builtin_amdgcn_readfirstlane(tid >> 6);
    const int qcol = hc * 64, kcol = hc * 64, vcol = (hc >> 1) * 128, ocol = hc * 128;
    const long rowbase = (long)b * SEQ; const int q0 = qb * QB;
    const bf16* Qw = Q + (rowbase + q0 + wid * QBLK) * QP + qcol;
    const bf16 *Kh = K + rowbase * KP + kcol, *Vh = V + rowbase * VP + vcol;
    const unsigned lds0 = (unsigned)(uintptr_t)shm;
    float* wsf = (float*)(shm + LDS_WS) + wid * 64;
    const bf16* ksrc = Kh + (long)lane * KP + wid * 8;
    const bf16* vsrc = Vh + (long)(16 * (wid & 3) + (lane >> 2)) * VP + (wid >> 2) * 32 + (lane & 3) * 8;
    const unsigned kdst = lds0 + LDS_K + wid * 1024, vdst = lds0 + LDS_V + wid * 1024;
    const lds_cptr shm3 = (lds_cptr)shm; const lds_cptr vp0 = shm3 + LDS_V + ((lane >> 4) & 1) * 32 + (lane & 3) * 8 + (4 * hi + ((lane & 15) >> 2)) * 64;
    const int NT = (q0 + QB) / KVBLK;
#define A2_DMAK(t, sl) glds16(ksrc + (long)(t) * KVBLK * KP, (unsigned)__builtin_amdgcn_readfirstlane(kdst + (sl) * KSLOT))
#define A2_DMAV(t, sl) do { glds16(vsrc + (long)(t) * KVBLK * VP, (unsigned)__builtin_amdgcn_readfirstlane(vdst + (sl) * VSLOT)); glds16(vsrc + (long)(t) * KVBLK * VP + 64, (unsigned)__builtin_amdgcn_readfirstlane(vdst + (sl) * VSLOT + 8192)); } while (0)
    A2_DMAK(0, 0); A2_DMAV(0, 0); A2_DMAK(1, 1); A2_DMAV(1, 1);
    bf16x8 qr[4];
#pragma unroll
    for (int d0 = 0; d0 < 4; ++d0) qr[d0] = *reinterpret_cast<const bf16x8*>(&Qw[(long)r32 * QP + d0 * 16 + hi * 8]);
    float mhat = 0.f, l_reg = 0.f; f32x16 o[4]; o[0] = f32x16{}; o[1] = f32x16{}; o[2] = f32x16{}; o[3] = f32x16{};
    const int qrel = wid * QBLK + r32;
    u32x4 pw[4] = {};
    int slot = 0, slot2 = 2;
#define A2_PV(sl) do { const lds_cptr vp_ = vp0 + (sl) * VSLOT; _Pragma("unroll") for (int ks = 0; ks < 4; ++ks) { const bf16x8 pa = __builtin_bit_cast(bf16x8, pw[ks]); \
        _Pragma("unroll") for (int d0 = 0; d0 < 4; ++d0) { const s16x4 lo = vtr(vp_ + d0 * 4096 + ks * 1024), h4 = vtr(vp_ + d0 * 4096 + ks * 1024 + 512); \
            o[d0] = __builtin_amdgcn_mfma_f32_32x32x16_bf16(pa, (bf16x8){lo[0], lo[1], lo[2], lo[3], h4[0], h4[1], h4[2], h4[3]}, o[d0], 0, 0, 0); } } } while (0)
#define A2_VRD(i_) do { const int d0_ = (i_) & 3, ks_ = (i_) >> 2; vlo[(i_) % 3] = vtr(vp_ + d0_ * 4096 + ks_ * 1024); vhi[(i_) % 3] = vtr(vp_ + d0_ * 4096 + ks_ * 1024 + 512); } while (0)
typedef float f32x2a __attribute__((ext_vector_type(2)));
#define A2_PE2(P, e_) do { f32x2a d_ = (f32x2a){P[e_], P[(e_) + 1]} - mhat2; P[e_] = __builtin_amdgcn_exp2f(d_.x); P[(e_) + 1] = __builtin_amdgcn_exp2f(d_.y); } while (0)
#define A2_GAP(i_) do { if ((i_) + 2 < 16) A2_VRD((i_) + 2); \
        o[(i_) & 3] = __builtin_amdgcn_mfma_f32_32x32x16_bf16(__builtin_bit_cast(bf16x8, pw[(i_) >> 2]), (bf16x8){vlo[(i_) % 3][0], vlo[(i_) % 3][1], vlo[(i_) % 3][2], vlo[(i_) % 3][3], vhi[(i_) % 3][0], vhi[(i_) % 3][1], vhi[(i_) % 3][2], vhi[(i_) % 3][3]}, o[(i_) & 3], 0, 0, 0); \
        if ((i_) < 8) { A2_PE2(p0, 2 * (i_)); asm volatile("" : "+v"(p0)); } else { A2_PE2(p1, 2 * (i_) - 16); asm volatile("" : "+v"(p1)); } \
        __builtin_amdgcn_sched_barrier(0); } while (0)
#define A2_STEP(MASKED) do { \
          \
        if (t + 1 < NT) asm volatile("s_waitcnt vmcnt(5) lgkmcnt(0)\n\ts_barrier" ::: "memory"); \
        else asm volatile("s_waitcnt vmcnt(2) lgkmcnt(0)\n\ts_barrier" ::: "memory"); \
        if (t + 2 < NT) { A2_DMAK(t + 2, slot2); A2_DMAV(t + 2, (vslotp + 3) & 3); } \
        __builtin_amdgcn_sched_barrier(0); \
        f32x16 p0 = f32x16{}, p1 = f32x16{}; \
        const char* kb = shm + LDS_K + slot * KSLOT + hi * 1024 + r32 * 16; \
        const lds_cptr vp_ = vp0 + (t == 0 ? 0 : vslotp) * VSLOT; s16x4 vlo[3], vhi[3]; \
        _Pragma("unroll") for (int d0 = 0; d0 < 4; ++d0) { const bf16x8 b0 = *reinterpret_cast<const bf16x8*>(kb + d0 * 2048), b1 = *reinterpret_cast<const bf16x8*>(kb + d0 * 2048 + 512); \
            p0 = __builtin_amdgcn_mfma_f32_32x32x16_bf16(b0, qr[d0], p0, 0, 0, 0); p1 = __builtin_amdgcn_mfma_f32_32x32x16_bf16(b1, qr[d0], p1, 0, 0, 0); } \
        A2_VRD(0); A2_VRD(1); \
        if (MASKED) cmask(p0, p1, t - (NT - 4), qrel, hi); \
        asm volatile("s_nop 15\n\ts_nop 7" : "+v"(p0), "+v"(p1));        \
        const float rm = rowmax(p0, p1) - mhat; \
        resc = __any(rm > (float)THRL); \
        const float dl = resc ? __builtin_fmaxf(rm, 0.f) : 0.f; mhat += dl; \
        fsc = __builtin_amdgcn_exp2f(-dl); const f32x2a mhat2 = {mhat, mhat}; \
        __builtin_amdgcn_sched_barrier(0); \
        A2_GAP(0); A2_GAP(1); A2_GAP(2); A2_GAP(3); A2_GAP(4); A2_GAP(5); A2_GAP(6); A2_GAP(7); A2_GAP(8); A2_GAP(9); A2_GAP(10); A2_GAP(11); A2_GAP(12); A2_GAP(13); A2_GAP(14); A2_GAP(15); \
        f32x2a s2_ = {0.f, 0.f}; \
        _Pragma("unroll") for (int r = 0; r < 16; r += 2) { s2_ += (f32x2a){p0[r], p0[r + 1]}; s2_ += (f32x2a){p1[r], p1[r + 1]}; }        \
        l_reg = l_reg * fsc + (s2_.x + s2_.y); \
        pw[0] = (u32x4){cvtpk_s(p0[0], p0[1]), cvtpk_s(p0[2], p0[3]), cvtpk_s(p0[4], p0[5]), cvtpk_s(p0[6], p0[7])}; pw[1] = (u32x4){cvtpk_s(p0[8], p0[9]), cvtpk_s(p0[10], p0[11]), cvtpk_s(p0[12], p0[13]), cvtpk_s(p0[14], p0[15])}; \
        pw[2] = (u32x4){cvtpk_s(p1[0], p1[1]), cvtpk_s(p1[2], p1[3]), cvtpk_s(p1[4], p1[5]), cvtpk_s(p1[6], p1[7])}; pw[3] = (u32x4){cvtpk_s(p1[8], p1[9]), cvtpk_s(p1[10], p1[11]), cvtpk_s(p1[12], p1[13]), cvtpk_s(p1[14], p1[15])}; \
        if (resc) { if (hi == 0) wsf[r32] = fsc;                   \
            asm volatile("s_waitcnt lgkmcnt(0)" ::: "memory"); \
            _Pragma("unroll") for (int r = 0; r < 16; ++r) { const float fr = wsf[crow(r, hi)]; \
                _Pragma("unroll") for (int d = 0; d < 4; ++d) o[d][r] *= fr; } } \
        slot2 = slot; slot = slot == NSLOT - 1 ? 0 : slot + 1; vslotp = (vslotp + 1) & 3;        \
    } while (0)
    bool resc = false; float fsc = 1.f; int vslotp = 3;
    int t = 0;
    if (wid >= 4) __builtin_amdgcn_s_setprio(1);
    for (; t < NT - 4; ++t) A2_STEP(false);
    for (; t < NT; ++t) A2_STEP(true);
    __builtin_amdgcn_s_setprio(0);
#undef A2_STEP
#undef A2_GAP
#undef A2_PE2
#undef A2_VRD
    asm volatile("s_waitcnt vmcnt(0) lgkmcnt(0)\n\ts_barrier" ::: "memory");
    A2_PV(vslotp);
#undef A2_PV
#undef A2_DMAK
#undef A2_DMAV
    { auto rr = __builtin_amdgcn_permlane32_swap(__float_as_uint(l_reg), __float_as_uint(l_reg), false, false); l_reg = __uint_as_float(rr[0]) + __uint_as_float(rr[1]); }
    if (hi == 0) wsf[32 + r32] = l_reg; asm volatile("s_waitcnt lgkmcnt(0)" ::: "memory");
    float rli[16];
#pragma unroll
    for (int r = 0; r < 16; ++r) rli[r] = __builtin_amdgcn_rcpf(wsf[32 + crow(r, hi)]);
    bf16* Ow = O + (rowbase + q0 + wid * QBLK) * OP + ocol;
    bf16* stg = (bf16*)(shm + LDS_OST) + wid * 2048;
#pragma unroll
    for (int pass = 0; pass < 2; ++pass) {
#pragma unroll
        for (int r = 0; r < 16; ++r) { const int orow = crow(r, hi);
#pragma unroll
            for (int d0 = 0; d0 < 2; ++d0) stg[orow * 64 + d0 * 32 + r32] = __float2bfloat16(o[2 * pass + d0][r] * rli[r]); }
        asm volatile("s_waitcnt lgkmcnt(0)" ::: "memory");
#pragma unroll
        for (int i = 0; i < 4; ++i) { const int row = i * 8 + (lane >> 3), ch = lane & 7; const u32x4 v = *(const u32x4*)(stg + row * 64 + ch * 8); *(u32x4*)(Ow + (long)row * OP + pass * 64 + ch * 8) = v; }
        asm volatile("s_waitcnt lgkmcnt(0)" ::: "memory");
    }
    asm volatile("s_waitcnt lgkmcnt(0)\n\ts_barrier" ::: "memory");
}
struct AttnTensors { const bf16* Q; const bf16* K; const bf16* V; bf16* O; };
struct AttnUnit { int bh; int qb; };
struct StaticOrder {
    int vcu, G;
    __device__ __forceinline__ explicit StaticOrder(int grid, int block) : vcu((grid % 8 == 0) ? (block % 8) * (grid / 8) + block / 8 : block), G(grid) {}
    __device__ __forceinline__ bool next(int i, AttnUnit& u) const { const int oct = vcu + (i >> 2) * G; if (oct >= 256) return false; const int s = oct & 7, ii = i & 3; u.bh = oct >> 3; u.qb = (ii == 0) ? s : (ii == 1) ? 15 - s : (ii == 2) ? 16 + s : 31 - s; return true; }
};
template <int THRL = 8> __device__ __forceinline__ void attn_phase(char* lds, const AttnTensors& T, const StaticOrder& S) {
    AttnUnit u;
    for (int i = 0; S.next(i, u); ++i) attn_unit<THRL>(u.bh >> 3, u.bh & 7, u.qb, T.Q, T.K, T.V, T.O, lds);
}
}

namespace tile {
typedef short bf16x8 __attribute__((ext_vector_type(8)));
typedef short s16x4 __attribute__((ext_vector_type(4)));
typedef float f32x16 __attribute__((ext_vector_type(16)));
constexpr int TP = 72;
__device__ __forceinline__ int crow(int r, int hi) { return (r & 3) + 8 * (r >> 2) + 4 * hi; }
__device__ __forceinline__ bf16x8 frag_row(const LAS bf16_t* T, int r0, int k0, int lane) { return *(const LAS bf16x8*)(T + (r0 + (lane & 31)) * TP + k0 + 8 * (lane >> 5)); }
__device__ __forceinline__ bf16x8 frag_tr(const LAS bf16_t* T, int ra, int rb, int c0, int lane) {
    const int hi = lane >> 5, g16 = (lane >> 4) & 1, q = (lane & 15) >> 2, p = lane & 3;
    const LAS bf16_t* a0 = T + (ra + 4 * hi + q) * TP + c0 + 16 * g16 + 4 * p; const LAS bf16_t* a1 = T + (rb + 4 * hi + q) * TP + c0 + 16 * g16 + 4 * p;
    const s16x4 lo = __builtin_bit_cast(s16x4, __builtin_amdgcn_ds_read_tr16_b64_v4i16((LAS s16x4*)a0)), hi4 = __builtin_bit_cast(s16x4, __builtin_amdgcn_ds_read_tr16_b64_v4i16((LAS s16x4*)a1));
    return (bf16x8){lo[0], lo[1], lo[2], lo[3], hi4[0], hi4[1], hi4[2], hi4[3]};
}
__device__ __forceinline__ bf16x8 frag_tr_nat(const LAS bf16_t* T, int k0, int c0, int lane) {
    const int hi = lane >> 5, g16 = (lane >> 4) & 1, q = (lane & 15) >> 2, p = lane & 3;
    const LAS bf16_t* a0 = T + (k0 + 8 * hi + q) * TP + c0 + 16 * g16 + 4 * p;
    const s16x4 lo = __builtin_bit_cast(s16x4, __builtin_amdgcn_ds_read_tr16_b64_v4i16((LAS s16x4*)a0)), hi4 = __builtin_bit_cast(s16x4, __builtin_amdgcn_ds_read_tr16_b64_v4i16((LAS s16x4*)(a0 + 4 * TP)));
    return (bf16x8){lo[0], lo[1], lo[2], lo[3], hi4[0], hi4[1], hi4[2], hi4[3]};
}
__device__ __forceinline__ unsigned cvtpk(float lo, float hi) { typedef float f2 __attribute__((ext_vector_type(2))); typedef __bf16 b2 __attribute__((ext_vector_type(2))); f2 v = {lo, hi}; return __builtin_bit_cast(unsigned, __builtin_convertvector(v, b2)); }
__device__ __forceinline__ bf16x8 acc_frag(const f32x16& x, int s_) { u32x4 w; w.x = cvtpk(x[8 * s_], x[8 * s_ + 1]); w.y = cvtpk(x[8 * s_ + 2], x[8 * s_ + 3]); w.z = cvtpk(x[8 * s_ + 4], x[8 * s_ + 5]); w.w = cvtpk(x[8 * s_ + 6], x[8 * s_ + 7]); return __builtin_bit_cast(bf16x8, w); }
#define MFMA32(a, b, c) __builtin_amdgcn_mfma_f32_32x32x16_bf16((a), (b), (c), 0, 0, 0)
}

__device__ __forceinline__ void sb_phase(LAS unsigned char* lds, bf16_t* QO, int ldq, const bf16_t* __restrict__ Kb, const bf16_t* __restrict__ Vb, int gw, int ngw, int wave, int lane) {
    using namespace tile;
    LAS bf16_t* Kt = (LAS bf16_t*)(lds + wave * 16384); LAS bf16_t* Vt = Kt + 32 * TP; LAS bf16_t* Ot = Vt + 32 * TP;
    const int hi = lane >> 5, ql = lane & 31;
    bf16x8 uf[2];
#pragma unroll
    for (int s_ = 0; s_ < 2; ++s_)
#pragma unroll
        for (int j = 0; j < 8; ++j) uf[s_][j] = (16 * s_ + 8 * (j >> 2) + 4 * hi + (j & 3)) > ql ? (short)0x3F80 : (short)0;
    for (int unit = gw; unit < NTOK * 4 / 32; unit += ngw) {
        const int qb = unit & 255, h = (unit >> 8) & 3, b = unit >> 10, q0 = qb * 32; const size_t rb = (size_t)b * SEQ;
        bf16x8 qf[4];
#pragma unroll
        for (int s_ = 0; s_ < 4; ++s_) qf[s_] = *(const bf16x8*)(QO + (rb + q0 + ql) * ldq + h * 64 + 16 * s_ + 8 * hi);
        f32x16 o0 = {}, o1 = {}; float carry = 0.f;
        u32x4 kp[4], vp[4];
#define SB_LOAD(k0_) do { _Pragma("unroll") for (int i = 0; i < 4; ++i) { const int c = lane + 64 * i, row = c >> 3, c16 = c & 7; \
            kp[i] = *(const u32x4*)(Kb + (rb + (k0_) + row) * 256 + h * 64 + c16 * 8); vp[i] = *(const u32x4*)(Vb + (rb + (k0_) + row) * 256 + h * 64 + c16 * 8); } } while (0)
#define SB_STORE() do { _Pragma("unroll") for (int i = 0; i < 4; ++i) { const int c = lane + 64 * i, row = c >> 3, c16 = c & 7; *(LAS u32x4*)(Kt + row * TP + c16 * 8) = kp[i]; *(LAS u32x4*)(Vt + row * TP + c16 * 8) = vp[i]; } } while (0)
        SB_LOAD(q0);
        for (int k0 = q0; k0 >= 0; k0 -= 32) {
            asm volatile("s_waitcnt lgkmcnt(0)" ::: "memory");
            SB_STORE();
            if (k0 >= 32) SB_LOAD(k0 - 32);
            asm volatile("s_waitcnt lgkmcnt(0)" ::: "memory");
            f32x16 p = {};
#pragma unroll
            for (int s_ = 0; s_ < 4; ++s_) p = MFMA32(frag_row(Kt, 0, 16 * s_, lane), qf[s_], p);
            f32x16 lk, z;
            const bool diag = (k0 == q0);
#pragma unroll
            for (int r = 0; r < 16; ++r) { z[r] = p[r] * 0.125f; const bool valid = !diag || crow(r, hi) < ql; const float az = fabsf(z[r]);
                const float sp = fmaxf(z[r], 0.f) + __logf(1.f + __expf(-az)); lk[r] = valid ? -sp : 0.f; }
            f32x16 lo_;
#pragma unroll
            for (int r = 0; r < 16; ++r) { const float hb = __uint_as_float(__float_as_uint(lk[r]) & 0xffff0000u); lo_[r] = lk[r] - hb; p[r] = hb; }
            f32x16 cs = {};
#pragma unroll
            for (int s_ = 0; s_ < 2; ++s_) { cs = MFMA32(uf[s_], acc_frag(p, s_), cs); cs = MFMA32(uf[s_], acc_frag(lo_, s_), cs); }
            const float tot = shl_(cs[0] + lk[0], ql);
            f32x16 w;
#pragma unroll
            for (int r = 0; r < 16; ++r) { const bool valid = !diag || crow(r, hi) < ql; w[r] = valid ? __expf(z[r] + lk[r] + cs[r] + carry) : 0.f; }
            carry += tot;
#pragma unroll
            for (int s_ = 0; s_ < 2; ++s_) { const bf16x8 wf = acc_frag(w, s_);
                o0 = MFMA32(frag_tr(Vt, 16 * s_, 16 * s_ + 8, 0, lane), wf, o0); o1 = MFMA32(frag_tr(Vt, 16 * s_, 16 * s_ + 8, 32, lane), wf, o1); }
            if (__all(carry < -104.f)) break;
        }
#undef SB_LOAD
#undef SB_STORE
        asm volatile("s_waitcnt lgkmcnt(0)" ::: "memory");
#pragma unroll
        for (int r = 0; r < 16; ++r) { Ot[ql * TP + crow(r, hi)] = f2bf(o0[r]); Ot[ql * TP + 32 + crow(r, hi)] = f2bf(o1[r]); }
        asm volatile("s_waitcnt lgkmcnt(0)" ::: "memory");
#pragma unroll
        for (int i = 0; i < 4; ++i) { const int c = lane + 64 * i, row = c >> 3, c16 = c & 7; *(u32x4*)(QO + (rb + q0 + row) * ldq + h * 64 + c16 * 8) = *(const LAS u32x4*)(Ot + row * TP + c16 * 8); }
    }
}

__device__ __forceinline__ float hg_lb(const float* lbl, int layer, int c) { if (layer == 0) return 0.f; const float a0 = lbl[c], a1 = lbl[256 + c]; return 1.f / (1.f + __expf(a0 - a1)); }
__device__ __forceinline__ float hg_logf(float z, float lb) {
    if (lb == 0.f) return -(fmaxf(-z, 0.f) + __logf(1.f + __expf(-fabsf(z))));
    return __logf(lb + (1.f - lb) * __builtin_amdgcn_rcpf(1.f + __expf(-z)));
}
__device__ __forceinline__ void hg_local(LAS unsigned char* lds, const bf16_t* __restrict__ F, const bf16_t* __restrict__ Iv, const float* lbl, int layer, float* __restrict__ st, float* __restrict__ dec,
                                         int gw, int ngw, int wave, int lane) {
    using namespace tile;
    LAS bf16_t* Zt = (LAS bf16_t*)(lds + wave * 16384); LAS bf16_t* Vt = Zt + 64 * TP;
    const int hi = lane >> 5, ql = lane & 31;
    for (int unit = gw; unit < 2048; unit += ngw) {
        const int chunk = unit & 127, h = (unit >> 7) & 3, b = unit >> 9; const size_t tok0 = (size_t)b * SEQ + chunk * 64;
        const float lb = hg_lb(lbl, layer, h * 64 + lane);
        float lf[64]; float bend = 0.f;
#pragma unroll
        for (int t = 0; t < 64; ++t) { lf[t] = hg_logf(bf2f(F[(tok0 + t) * 256 + h * 64 + lane]), lb); bend += lf[t]; }
        dec[unit * 64 + lane] = __expf(bend);
        asm volatile("s_waitcnt lgkmcnt(0)" ::: "memory");
        { float bb = 0.f;
#pragma unroll
          for (int t = 0; t < 64; ++t) { bb += lf[t]; Zt[t * TP + lane] = f2bf((1.f - __expf(lf[t])) * __expf(bend - bb)); } }
        f32x16 acc[2][2] = {};
#pragma unroll
        for (int half = 0; half < 2; ++half) {
            u32x4 vp[4];
#pragma unroll
            for (int i = 0; i < 4; ++i) { const int c = lane + 64 * i, row = c >> 3, c16 = c & 7; vp[i] = *(const u32x4*)(Iv + (tok0 + half * 32 + row) * 256 + h * 64 + c16 * 8); }
            asm volatile("s_waitcnt lgkmcnt(0)" ::: "memory");
#pragma unroll
            for (int i = 0; i < 4; ++i) { const int c = lane + 64 * i, row = c >> 3, c16 = c & 7; *(LAS u32x4*)(Vt + row * TP + c16 * 8) = vp[i]; }
            asm volatile("s_waitcnt lgkmcnt(0)" ::: "memory");
#pragma unroll
            for (int s2 = 0; s2 < 2; ++s2) { const int t0 = half * 32 + 16 * s2;
                const bf16x8 a0 = frag_tr_nat(Zt, t0, 0, lane), a1 = frag_tr_nat(Zt, t0, 32, lane), b0 = frag_tr_nat(Vt, 16 * s2, 0, lane), b1 = frag_tr_nat(Vt, 16 * s2, 32, lane);
                acc[0][0] = MFMA32(a0, b0, acc[0][0]); acc[0][1] = MFMA32(a0, b1, acc[0][1]); acc[1][0] = MFMA32(a1, b0, acc[1][0]); acc[1][1] = MFMA32(a1, b1, acc[1][1]); }
        }
        float* o = st + (size_t)unit * 4096;
#pragma unroll
        for (int kb = 0; kb < 2; ++kb)
#pragma unroll
            for (int vb = 0; vb < 2; ++vb)
#pragma unroll
                for (int r = 0; r < 16; ++r) o[(kb * 32 + crow(r, hi)) * 64 + vb * 32 + ql] = acc[kb][vb][r];
    }
}
__device__ __forceinline__ void hg_scan(float* st, const float* __restrict__ dec, int gtid, int nthr) {
    for (int e = gtid - 65536; e < 65536; e += nthr) { if (e < 0) continue;
        const int bh = e >> 12, kv = e & 4095, k = kv >> 6; float S = 0.f;
        for (int c0 = 0; c0 < 128; c0 += 16) { float lc[16], dc[16];
#pragma unroll
            for (int j = 0; j < 16; ++j) { lc[j] = st[(size_t)(bh * 128 + c0 + j) * 4096 + kv]; dc[j] = dec[(bh * 128 + c0 + j) * 64 + k]; }
#pragma unroll
            for (int j = 0; j < 16; ++j) { st[(size_t)(bh * 128 + c0 + j) * 4096 + kv] = S; S = dc[j] * S + lc[j]; } }
    }
}
__device__ __forceinline__ void hg_out(LAS unsigned char* lds, const bf16_t* __restrict__ F, const bf16_t* __restrict__ Iv, bf16_t* QY, int ldq, const bf16_t* __restrict__ Gt, const float* lbl, int layer,
                                       const float* __restrict__ og, const float* __restrict__ st, int gw, int ngw, int wave, int lane) {
    using namespace tile;
    LAS bf16_t* bA = (LAS bf16_t*)(lds + wave * 16384); LAS bf16_t* Z = bA + 32 * TP;
    const int hi = lane >> 5, ql = lane & 31;
    for (int unit = gw; unit < 4096; unit += ngw) {
        const int I = unit & 1, cu = unit >> 1, chunk = cu & 127, h = (cu >> 7) & 3, b = cu >> 9; const size_t tok0 = (size_t)b * SEQ + chunk * 64;
        const float lb = hg_lb(lbl, layer, h * 64 + lane);
        const float* S = st + (size_t)cu * 4096;
        {   u32x4 zq[12];
#pragma unroll
            for (int i = 0; i < 4; ++i) { const int c = lane + 64 * i, row = c >> 3, c16 = c & 7; zq[i] = *(const u32x4*)(F + (tok0 + row) * 256 + h * 64 + c16 * 8); zq[8 + i] = *(const u32x4*)(QY + (tok0 + 32 * I + row) * ldq + h * 64 + c16 * 8); }
            if (I) {
#pragma unroll
                for (int i = 0; i < 4; ++i) { const int c = lane + 64 * i, row = c >> 3, c16 = c & 7; zq[4 + i] = *(const u32x4*)(F + (tok0 + 32 + row) * 256 + h * 64 + c16 * 8); } }
            asm volatile("s_waitcnt lgkmcnt(0)" ::: "memory");
#pragma unroll
            for (int i = 0; i < 4; ++i) { const int c = lane + 64 * i, row = c >> 3, c16 = c & 7; *(LAS u32x4*)(Z + row * TP + c16 * 8) = zq[i]; *(LAS u32x4*)(bA + row * TP + c16 * 8) = zq[8 + i]; }
            if (I) {
#pragma unroll
                for (int i = 0; i < 4; ++i) { const int c = lane + 64 * i, row = c >> 3, c16 = c & 7; *(LAS u32x4*)(Z + (32 + row) * TP + c16 * 8) = zq[4 + i]; } }
        }
        asm volatile("s_waitcnt lgkmcnt(0)" ::: "memory");
        float bref = 0.f;
        if (I) { float lfp[32];
#pragma unroll
            for (int t = 0; t < 32; ++t) { lfp[t] = hg_logf(bf2f(Z[t * TP + lane]), lb); bref += lfp[t]; }
            float bb = 0.f;
#pragma unroll
            for (int t = 0; t < 32; ++t) { bb += lfp[t]; Z[t * TP + lane] = f2bf((1.f - __expf(lfp[t])) * __expf(bref - bb)); } }
        { LAS bf16_t* Zb = Z + 32 * I * TP; float bb = 0.f;
#pragma unroll
          for (int t = 0; t < 32; ++t) { const float lf = hg_logf(bf2f(Zb[t * TP + lane]), lb); bb += lf; const float eb = __expf(bb);
              bA[t * TP + lane] = f2bf(bf2f(bA[t * TP + lane]) * eb); Zb[t * TP + lane] = f2bf((1.f - __expf(lf)) * __expf(fminf(-bb, 80.f))); } }
        asm volatile("s_waitcnt lgkmcnt(0)" ::: "memory");
        bf16x8 qf[4];
#pragma unroll
        for (int s4 = 0; s4 < 4; ++s4) qf[s4] = frag_row(bA, 0, 16 * s4, lane);
        f32x16 o0 = {}, o1 = {};
        const float es = __expf(bref);
#pragma unroll
        for (int kh = 0; kh < 2; ++kh) {
            f32x4 sv[8];
#pragma unroll
            for (int i = 0; i < 8; ++i) { const int c = lane + 64 * i, row = c >> 4, c4 = c & 15; sv[i] = *(const f32x4*)(S + (32 * kh + row) * 64 + c4 * 4); }
            asm volatile("s_waitcnt lgkmcnt(0)" ::: "memory");
#pragma unroll
            for (int i = 0; i < 8; ++i) { const int c = lane + 64 * i, row = c >> 4, c4 = c & 15; const float sc = shl_(es, 32 * kh + row);
                u32x2 w; w.x = cvtpk(sv[i][0] * sc, sv[i][1] * sc); w.y = cvtpk(sv[i][2] * sc, sv[i][3] * sc); *(LAS u32x2*)(bA + row * TP + c4 * 4) = w; }
            asm volatile("s_waitcnt lgkmcnt(0)" ::: "memory");
#pragma unroll
            for (int s2 = 0; s2 < 2; ++s2) { const bf16x8 q_ = qf[2 * kh + s2]; o0 = MFMA32(frag_tr_nat(bA, 16 * s2, 0, lane), q_, o0); o1 = MFMA32(frag_tr_nat(bA, 16 * s2, 32, lane), q_, o1); }
        }
        for (int J = 0; J <= I; ++J) {
            u32x4 vp[4];
#pragma unroll
            for (int i = 0; i < 4; ++i) { const int c = lane + 64 * i, row = c >> 3, c16 = c & 7; vp[i] = *(const u32x4*)(Iv + (tok0 + 32 * J + row) * 256 + h * 64 + c16 * 8); }
            asm volatile("s_waitcnt lgkmcnt(0)" ::: "memory");
#pragma unroll
            for (int i = 0; i < 4; ++i) { const int c = lane + 64 * i, row = c >> 3, c16 = c & 7; *(LAS u32x4*)(bA + row * TP + c16 * 8) = vp[i]; }
            asm volatile("s_waitcnt lgkmcnt(0)" ::: "memory");
            f32x16 pt = {};
#pragma unroll
            for (int s4 = 0; s4 < 4; ++s4) pt = MFMA32(frag_row(Z, 32 * J, 16 * s4, lane), qf[s4], pt);
            if (J == I) {
#pragma unroll
                for (int r = 0; r < 16; ++r) pt[r] = crow(r, hi) <= ql ? pt[r] : 0.f; }
#pragma unroll
            for (int s2 = 0; s2 < 2; ++s2) { const bf16x8 pf = acc_frag(pt, s2); o0 = MFMA32(frag_tr(bA, 16 * s2, 16 * s2 + 8, 0, lane), pf, o0); o1 = MFMA32(frag_tr(bA, 16 * s2, 16 * s2 + 8, 32, lane), pf, o1); }
        }
        float ss = 0.f;
#pragma unroll
        for (int r = 0; r < 16; ++r) ss += o0[r] * o0[r] + o1[r] * o1[r];
        ss += shx(ss, 32, lane);
        const float rr = rsqrtf(ss * (1.f / 64.f) + RMS_EPS);
        u32x4 gv[4];
#pragma unroll
        for (int i = 0; i < 4; ++i) { const int c = lane + 64 * i, row = c >> 3, c16 = c & 7; gv[i] = *(const u32x4*)(Gt + (tok0 + 32 * I + row) * 256 + h * 64 + c16 * 8); }
        asm volatile("s_waitcnt lgkmcnt(0)" ::: "memory");
#pragma unroll
        for (int r = 0; r < 16; ++r) { bA[ql * TP + crow(r, hi)] = f2bf(o0[r] * rr); bA[ql * TP + 32 + crow(r, hi)] = f2bf(o1[r] * rr); }
        asm volatile("s_waitcnt lgkmcnt(0)" ::: "memory");
#pragma unroll
        for (int i = 0; i < 4; ++i) { const int c = lane + 64 * i, row = c >> 3, c16 = c & 7; const size_t tok = tok0 + 32 * I + row;
            const u32x4 ov = *(const LAS u32x4*)(bA + row * TP + c16 * 8); const unsigned ow[4] = {ov.x, ov.y, ov.z, ov.w}, gw_[4] = {gv[i].x, gv[i].y, gv[i].z, gv[i].w}; float y[8];
#pragma unroll
            for (int j = 0; j < 4; ++j) { const float g0 = __uint_as_float(gw_[j] << 16), g1 = __uint_as_float(gw_[j] & 0xffff0000u);
                y[2 * j] = __uint_as_float(ow[j] << 16) * og[c16 * 8 + 2 * j] * g0 * __builtin_amdgcn_rcpf(1.f + __expf(-g0)); y[2 * j + 1] = __uint_as_float(ow[j] & 0xffff0000u) * og[c16 * 8 + 2 * j + 1] * g1 * __builtin_amdgcn_rcpf(1.f + __expf(-g1)); }
            u32x4 w; w.x = cvtpk(y[0], y[1]); w.y = cvtpk(y[2], y[3]); w.z = cvtpk(y[4], y[5]); w.w = cvtpk(y[6], y[7]);
            *(u32x4*)(QY + tok * ldq + h * 64 + c16 * 8) = w; }
    }
}

#define XB_TMO      128
#define XB_XCNT(j)  (256  + 64 * (j))
#define XB_XSUB(j)  (1280 + 64 * (j))
#define XB_XGEN(j)  (2304 + 64 * (j))
#define XB_TOP      3328
#define XB_TOPGEN   3392
#define XCD_BAR_WORDS 3456
#define XB_SPIN_CAP (1u << 18)

__device__ __forceinline__ unsigned xb_ld(unsigned* p)              { return __hip_atomic_load(p, __ATOMIC_RELAXED, __HIP_MEMORY_SCOPE_AGENT); }
__device__ __forceinline__ unsigned xb_add(unsigned* p, unsigned v) { return __hip_atomic_fetch_add(p, v, __ATOMIC_RELAXED, __HIP_MEMORY_SCOPE_AGENT); }
__device__ __forceinline__ unsigned xb_xcc_id() { return (unsigned)__builtin_amdgcn_s_getreg((3 << 11) | 20) & 0xFu; }
#define XB_SPIN(cond, bar) do { unsigned _sp = 0; while (cond) { __builtin_amdgcn_s_sleep(1); \
    if ((++_sp & 255u) == 0u) { if (xb_ld(&(bar)[XB_TMO])) break; if (_sp > XB_SPIN_CAP) { atomicAdd(&(bar)[XB_TMO], 1u); break; } } } } while (0)

struct XcdBarrier {
    unsigned* bar; unsigned x;
    volatile LAS unsigned* st;
};

__device__ __forceinline__ XcdBarrier xcd_barrier_post(unsigned* bar, volatile LAS unsigned* st) {
    XcdBarrier b; b.bar = bar; b.x = xb_xcc_id(); b.st = st;
    if (threadIdx.x == 0) (void)xb_add(&bar[XB_XCNT(b.x)], 1u);
    return b;
}
__device__ __forceinline__ void xcd_barrier_complete(unsigned* bar, unsigned x, unsigned& nloc, unsigned& nx) {
    const unsigned G = gridDim.x * gridDim.y * gridDim.z;
    unsigned sum, cnt, mine, sp = 0u;
    for (;;) {
        sum = 0u; cnt = 0u; mine = 0u;
#pragma unroll
        for (unsigned j = 0; j < 16; ++j) { const unsigned c = xb_ld(&bar[XB_XCNT(j)]); sum += c; cnt += (c > 0u) ? 1u : 0u; mine = (j == x) ? c : mine; }
        if (sum == G) break;
        __builtin_amdgcn_s_sleep(1);
        if ((++sp & 255u) == 0u) { if (xb_ld(&bar[XB_TMO])) break; if (sp > XB_SPIN_CAP) { atomicAdd(&bar[XB_TMO], 1u); break; } }
    }
    nloc = mine > 0u ? mine : 1u; nx = cnt > 0u ? cnt : 1u;
}

__device__ __forceinline__ void xcd_barrier(const XcdBarrier& b_) {
    XcdBarrier b = b_; { GAS unsigned* bg_ = (GAS unsigned*)b.bar; asm volatile("" : "+s"(bg_), "+s"(b.x)); b.bar = (unsigned*)bg_; }
    asm volatile("s_waitcnt vmcnt(0)" ::: "memory");
    __syncthreads();
    if (threadIdx.x == 0) {
        unsigned* bar = b.bar;
        __builtin_amdgcn_s_waitcnt(0);
        unsigned nloc = b.st[0], nx = b.st[1];
        if (nloc == 0u) { xcd_barrier_complete(bar, b.x, nloc, nx); b.st[0] = nloc; b.st[1] = nx; }
        const unsigned old = xb_add(&bar[XB_XSUB(b.x)], 1u);
        const unsigned gen = old / nloc;
        if (old + 1u == (gen + 1u) * nloc) {
            __builtin_amdgcn_fence(__ATOMIC_RELEASE, "agent");
            asm volatile("s_waitcnt vmcnt(0)" ::: "memory");
            const unsigned og = xb_add(&bar[XB_TOP], 1u);
            const unsigned tg = og / nx;
            if (og + 1u == (tg + 1u) * nx) xb_add(&bar[XB_TOPGEN], 1u);
            else XB_SPIN(xb_ld(&bar[XB_TOPGEN]) == tg, bar);
            __builtin_amdgcn_fence(__ATOMIC_ACQUIRE, "agent");
            xb_add(&bar[XB_XGEN(b.x)], 1u);
            asm volatile("s_waitcnt vmcnt(0)" ::: "memory");
        } else {
            XB_SPIN(xb_ld(&bar[XB_XGEN(b.x)]) == gen, bar);
            __builtin_amdgcn_fence(__ATOMIC_ACQUIRE, "agent");
            asm volatile("s_waitcnt vmcnt(0)" ::: "memory");
        }
    }
    __syncthreads();
}

#define LDS_WAIT() asm volatile("s_waitcnt lgkmcnt(0)" ::: "memory")
constexpr int NWAVES_ = 8;
__device__ __forceinline__ void tr_item(const float* __restrict__ W, int N, int k0, int n0, bf16_t* dst, int ldo, LAS float* scr, int lane, int rs = 1) {
#pragma unroll 8
    for (int i = 0; i < 32; ++i) { const int kk = 2 * i + (lane >> 5); scr[kk * 33 + (lane & 31)] = W[(size_t)(k0 + kk) * N + n0 + (lane & 31)]; }
    LDS_WAIT(); asm volatile("" ::: "memory");
    const int c = lane & 7;
#pragma unroll
    for (int j = 0; j < 4; ++j) { const int n = (lane >> 3) + 8 * j; const LAS float* s = scr + (8 * c) * 33 + n;
        u32x4 o; o.x = pk2(s[0 * 33], s[1 * 33]); o.y = pk2(s[2 * 33], s[3 * 33]); o.z = pk2(s[4 * 33], s[5 * 33]); o.w = pk2(s[6 * 33], s[7 * 33]);
        *(u32x4*)(dst + (size_t)n * rs * ldo + 8 * c) = o; }
    LDS_WAIT(); asm volatile("" ::: "memory");
}
struct LayerIn {
    const float *norm_mix, *w_in, *qg, *kg, *lq1, *lk1, *lq2, *lk2, *subln, *hg_lb, *hg_og, *s5_lre, *s5_lim, *s5_lstep, *s5_bre, *s5_bim, *s5_cre, *s5_cim, *s5_d, *glu_w, *glu_b,
                *pa, *pb, *pc, *pd, *w_out, *norm_ffn, *rgw, *rgb, *rew, *reb, *eg, *eu, *ed;
};
__device__ __forceinline__ void ph_weights(const CAS char* ka, int l, unsigned char* wts, LAS unsigned char* lds, int gw, int ngw, int wave, int lane) {
    LAS float* scr = (LAS float*)(lds + wave * 16384);
#define KIN(i) ((const float*)(*(const GAS float* const CAS*)(ka + 8 * (i))))
    const float* w_in = KIN(3) + (size_t)l * DM * IN_COLS; const float* pa = KIN(23) + (size_t)l * 512 * DM; const float* w_out = KIN(27) + (size_t)l * DM * DM; const float* glu_w = KIN(21) + (size_t)l * 65536;
    constexpr int I_IN = 16 * 240, I_PA = 8 * 32, I_PB = 4 * 32, I_OUT = 16 * 32, I_GLU = 4 * 8, I_EG = 16 * 16 * 12, I_ED = 16 * 6 * 32;
    constexpr int NITEMS = I_IN + I_PA + 3 * I_PB + I_OUT + I_GLU + 2 * I_EG;
    for (int it = gw; it < NITEMS; it += ngw) {
        int r = it;
        if (r < I_IN) { const int kb = r / 240, nb = r % 240, n0 = nb * 32;
            tr_item(w_in, IN_COLS, kb * 64, n0, (bf16_t*)(wts + WT_IN) + (size_t)n0 * DM + kb * 64, DM, scr, lane);
            continue; } r -= I_IN;
        if (r < I_PA) { const int kb = r / 32, nb = r % 32; tr_item(pa, DM, kb * 64, nb * 32, (bf16_t*)(wts + WT_P) + (size_t)nb * 32 * YC_LD + kb * 64, YC_LD, scr, lane); continue; } r -= I_PA;
        if (r < 3 * I_PB) { const int w = r / I_PB, q = r % I_PB, kb = q / 32, nb = q % 32; const float* src = KIN(24 + w) + (size_t)l * 256 * DM;
            tr_item(src, DM, kb * 64, nb * 32, (bf16_t*)(wts + WT_P) + (size_t)nb * 32 * YC_LD + 512 + 256 * w + kb * 64, YC_LD, scr, lane); continue; } r -= 3 * I_PB;
        if (r < I_OUT) { const int kb = r / 32, nb = r % 32; tr_item(w_out, DM, kb * 64, nb * 32, (bf16_t*)(wts + WT_OUT) + (size_t)nb * 32 * DM + kb * 64, DM, scr, lane); continue; } r -= I_OUT;
        if (r < I_GLU) { const int kb = r / 8, nb = r % 8; tr_item(glu_w, 256, kb * 64, nb * 32, (bf16_t*)(wts + WT_GLU) + (size_t)nb * 32 * 256 + kb * 64, 256, scr, lane); continue; } r -= I_GLU;
        if (r < 2 * I_EG) { const int up = r / I_EG, q = r % I_EG, e = q / 192, q2 = q % 192, kb = q2 / 12, nb = q2 % 12, n0 = nb * 32;
            const float* src = KIN(33 + up) + ((size_t)l * NEXP + e) * DM * DEXP;
            tr_item(src, DEXP, kb * 64, n0, (bf16_t*)(wts + WT_E1) + (size_t)(e * 768 + (n0 >> 7) * 256 + up * 128 + (n0 & 127)) * DM + kb * 64, DM, scr, lane); continue; }
    }
}
__device__ __forceinline__ void ph_s5_tables(const float* lre, const float* lim, const float* lstep, const float* bre, const float* bim, float* apow, float* bb, int gtid, int nthr) {
    for (int i = gtid; i < 1024; i += nthr) { const int g = i >> 6;
        const float lr = fminf(lre[i], -1e-4f), li = lim[i], st = __expf(lstep[g]);
        const float mag = __expf(lr * st), ph = li * st; const float rv = ph * 0.15915494309189535f, fr_ = rv - floorf(rv), sn = __sinf(fr_ * 6.283185307179586f), cs = __cosf(fr_ * 6.283185307179586f);
        const float ar = mag * cs, ai = mag * sn;
        const float den = lr * lr + li * li, nr = ar - 1.f, gr = (nr * lr + ai * li) / den, gi = (ai * lr - nr * li) / den;
        float pr = 1.f, pi = 0.f;
        for (int p = 0; p <= 32; ++p) { apow[(i * 33 + p) * 2] = pr; apow[(i * 33 + p) * 2 + 1] = pi; const float t = pr * ar - pi * ai; pi = pr * ai + pi * ar; pr = t; }
        for (int c = 0; c < 16; ++c) { const float br = bre[i * 16 + c], bi = bim[i * 16 + c]; bb[(i * 16 + c) * 2] = gr * br - gi * bi; bb[(i * 16 + c) * 2 + 1] = gr * bi + gi * br; }
    }
}
__device__ __forceinline__ void ph_s5_mats(const float* __restrict__ apow, const float* __restrict__ bb, const float* __restrict__ cre, const float* __restrict__ cim, bf16_t* m1t, bf16_t* m2t, bf16_t* ktab, int gtid, int nthr) {
    for (int it = gtid; it < 16 * 256 * 64; it += nthr) { const int cg = it & 63, r = (it >> 6) & 255, g = it >> 14; float v[8];
        if (r < 128) { const int n = r & 63, im = r >> 6, s_ = cg >> 1, c0 = (cg & 1) * 8; const int gi = g * 64 + n; const float pr = apow[(gi * 33 + 31 - s_) * 2], pi = apow[(gi * 33 + 31 - s_) * 2 + 1];
#pragma unroll
            for (int j = 0; j < 8; ++j) { const float br = bb[(gi * 16 + c0 + j) * 2], bi = bb[(gi * 16 + c0 + j) * 2 + 1]; v[j] = im ? pr * bi + pi * br : pr * br - pi * bi; } }
        else {
#pragma unroll
            for (int j = 0; j < 8; ++j) v[j] = 0.f; }
        u32x4 w; w.x = pk2(v[0], v[1]); w.y = pk2(v[2], v[3]); w.z = pk2(v[4], v[5]); w.w = pk2(v[6], v[7]);
        *(u32x4*)(m1t + ((size_t)(g * 256 + r) * 512 + cg * 8)) = w; }
    for (int it = gtid; it < 16 * 32 * 16 * 2; it += nthr) { const int c0 = (it & 1) * 8, c = (it >> 1) & 15, tau = (it >> 5) & 31, g = it >> 10; float v[8];
#pragma unroll
        for (int j = 0; j < 8; ++j) v[j] = 0.f;
        for (int n = 0; n < 64; ++n) { const int gi = g * 64 + n; const float pr = apow[(gi * 33 + tau) * 2], pi = apow[(gi * 33 + tau) * 2 + 1], cr = cre[(g * 16 + c) * 64 + n], ci = cim[(g * 16 + c) * 64 + n];
            const float wr_ = cr * pr - ci * pi, wi_ = cr * pi + ci * pr;
#pragma unroll
            for (int j = 0; j < 8; ++j) v[j] += wr_ * bb[(gi * 16 + c0 + j) * 2] - wi_ * bb[(gi * 16 + c0 + j) * 2 + 1]; }
        u32x4 w; w.x = pk2(v[0], v[1]); w.y = pk2(v[2], v[3]); w.z = pk2(v[4], v[5]); w.w = pk2(v[6], v[7]);
        *(u32x4*)(ktab + ((size_t)((g * 32 + tau) * 16 + c) * 16 + c0)) = w; }
    for (int it = gtid; it < 16 * 512 * 16; it += nthr) { const int cg = it & 15, r = (it >> 4) & 511, g = it >> 13, t = r >> 4, c = r & 15, nn0 = cg * 8; float v[8];
#pragma unroll
        for (int j = 0; j < 8; ++j) { const int nn = nn0 + j, n = nn & 63, gi = g * 64 + n; const float pr = apow[(gi * 33 + t + 1) * 2], pi = apow[(gi * 33 + t + 1) * 2 + 1], cr = cre[(g * 16 + c) * 64 + n], ci = cim[(g * 16 + c) * 64 + n];
            v[j] = nn < 64 ? cr * pr - ci * pi : -(cr * pi + ci * pr); }
        u32x4 w; w.x = pk2(v[0], v[1]); w.y = pk2(v[2], v[3]); w.z = pk2(v[4], v[5]); w.w = pk2(v[6], v[7]);
        *(u32x4*)(m2t + ((size_t)(g * 512 + r) * S5_LD + 512 + cg * 8)) = w; }
}
__device__ __forceinline__ void ph_s5_expand(const bf16_t* __restrict__ ktab, bf16_t* m2t, int gtid, int nthr) {
    for (int it = gtid; it < 16 * 512 * 64; it += nthr) { const int cg = it & 63, r = (it >> 6) & 511, g = it >> 15, t = r >> 4, c = r & 15, s_ = cg >> 1, c0 = (cg & 1) * 8;
        u32x4 w = {0u, 0u, 0u, 0u}; if (s_ <= t) w = *(const u32x4*)(ktab + ((size_t)((g * 32 + t - s_) * 16 + c) * 16 + c0));
        *(u32x4*)(m2t + ((size_t)(g * 512 + r) * S5_LD + cg * 8)) = w; }
}
__device__ __forceinline__ void ph_s5_scan(const float* __restrict__ apow, const float* __restrict__ xloc, bf16_t* s5u, int gtid, int nthr) {
    for (int i = gtid; i < 4096; i += nthr) { const int n = i & 63, g = (i >> 6) & 15, b = i >> 10; const int gi = g * 64 + n;
        const float ar = apow[(gi * 33 + 32) * 2], ai = apow[(gi * 33 + 32) * 2 + 1]; float xr = 0.f, xi = 0.f;
        for (int k0 = 0; k0 < 256; k0 += 32) { float lr[32], li[32];
#pragma unroll
            for (int j = 0; j < 32; ++j) { const size_t row = (size_t)g * 1024 + b * 256 + k0 + j; lr[j] = xloc[row * 128 + n]; li[j] = xloc[row * 128 + 64 + n]; }
#pragma unroll
            for (int j = 0; j < 32; ++j) { const size_t row = (size_t)g * 1024 + b * 256 + k0 + j; s5u[row * S5_LD + 512 + n] = f2bf(xr); s5u[row * S5_LD + 576 + n] = f2bf(xi);
                const float t = ar * xr - ai * xi + lr[j]; xi = ar * xi + ai * xr + li[j]; xr = t; } }
    }
}
__device__ __forceinline__ void ph_pair_weights(const float* __restrict__ ed  , bf16_t* wp, LAS unsigned char* lds, int gw, int ngw, int wave, int lane) {
    LAS float* scr = (LAS float*)(lds + wave * 16384);
    for (int it = gw; it < NBUCKET * 2 * 6 * 32; it += ngw) { const int nb = it & 31, kb = (it >> 5) % 6, sel = (it / 192) & 1, p_ = it / 384; int e0, e1; pg8::pair_experts(p_, e0, e1); const int e = sel ? e1 : e0;
        tr_item(ed + (size_t)e * DEXP * DM, DM, kb * 64, nb * 32, wp + ((size_t)p_ * 1024 + nb * 32) * 768 + sel * DEXP + kb * 64, 768, scr, lane); }
    asm volatile("s_waitcnt lgkmcnt(0)" ::: "memory"); __syncthreads();
}
__device__ __forceinline__ void ph_rmsnorm(const float* __restrict__ x, const float* __restrict__ gain, bf16_t* __restrict__ out, int gw, int ngw, int lane) {
    for (int m = gw; m < NTOK; m += ngw) {
        const f32x4* xr = (const f32x4*)(x + (size_t)m * DM) + lane;
        f32x4 v[4]; float s = 0.f;
#pragma unroll
        for (int j = 0; j < 4; ++j) { v[j] = xr[64 * j]; s += (v[j].x * v[j].x + v[j].y * v[j].y) + (v[j].z * v[j].z + v[j].w * v[j].w); }
        const float r = rsqrtf(wave_sum(s, lane) * (1.f / DM) + RMS_EPS);
        u32x2* o = (u32x2*)(out + (size_t)m * DM) + lane;
#pragma unroll
        for (int j = 0; j < 4; ++j) { const f32x4 g = ((const f32x4*)gain)[64 * j + lane]; u32x2 w; w.x = pk2(v[j].x * r * g.x, v[j].y * r * g.y); w.y = pk2(v[j].z * r * g.z, v[j].w * r * g.w); o[64 * j] = w; }
    }
}
__device__ __forceinline__ void fix_row(bf16_t* row, const float* gain, const float* cs, const float* sn, float scale, int lane) {
    u32x4 raw = *(const u32x4*)(row + lane * 8);
    float v[8];
    v[0] = __uint_as_float(raw.x << 16); v[1] = __uint_as_float(raw.x & 0xffff0000u); v[2] = __uint_as_float(raw.y << 16); v[3] = __uint_as_float(raw.y & 0xffff0000u);
    v[4] = __uint_as_float(raw.z << 16); v[5] = __uint_as_float(raw.z & 0xffff0000u); v[6] = __uint_as_float(raw.w << 16); v[7] = __uint_as_float(raw.w & 0xffff0000u);
    float ss = 0.f;
#pragma unroll
    for (int i = 0; i < 8; ++i) ss += v[i] * v[i];
    ss += shx(ss, 1, lane); ss += shx(ss, 2, lane); ss += shx(ss, 4, lane);
    const float r = rsqrtf(ss * (1.f / 64.f) + RMS_EPS);
    const int sub = lane & 7;
#pragma unroll
    for (int i = 0; i < 8; ++i) v[i] = v[i] * r * gain[sub * 8 + i];
    float o[8];
#pragma unroll
    for (int i = 0; i < 8; ++i) {
        const float p = shx(v[i], 1, lane);
        float res = v[i];
        if (sub == 0) res = v[i] * cs[i] - p * sn[i];
        else if (sub == 1) res = v[i] * cs[i] + p * sn[i];
        o[i] = res * scale;
    }
    u32x4 w; w.x = pk2(o[0], o[1]); w.y = pk2(o[2], o[3]); w.z = pk2(o[4], o[5]); w.w = pk2(o[6], o[7]);
    *(u32x4*)(row + lane * 8) = w;
}
__device__ __forceinline__ void ph_fixup(bf16_t* Q, int ldq, bf16_t* K, const int* __restrict__ pos, const float* __restrict__ qg, const float* __restrict__ kg, int gw, int ngw, int lane) {
    for (int m = gw; m < NTOK; m += ngw) {
        const double p = (double)pos[m];
        float cs[8], sn[8];
#pragma unroll
        for (int i = 0; i < 8; ++i) {
            constexpr double RF[8] = {0.15915494309189535, 0.03086376340470123, 0.005985185712713705, 0.001160663641240061, 0.00022507907903927653, 4.364795279280289e-05, 8.464330808241401e-06, 1.6414262627950345e-06};
            double rv = p * RF[i];
            rv -= floor(rv);
            const float a = (float)rv * 6.283185307179586f;
            cs[i] = __cosf(a); sn[i] = __sinf(a);
        }
        fix_row(Q + (size_t)m * ldq, qg, cs, sn, QSCALE, lane);
        fix_row(K + (size_t)m * 512, kg, cs, sn, 1.f, lane);
    }
}
__device__ __forceinline__ void ph_combine(const bf16_t* __restrict__ O, bf16_t* __restrict__ YA, int ldy, const float* lq1, const float* lk1, const float* lq2, const float* lk2,
                                           const float* __restrict__ sg, float lambda_init, int gw, int ngw, int lane) {
    const float lam = __expf(wave_sum(lq1[lane] * lk1[lane], lane)) - __expf(wave_sum(lq2[lane] * lk2[lane], lane)) + lambda_init;
    const int h = lane >> 4, dv0 = (lane & 15) * 8;
    for (int m0 = gw * 4; m0 < NTOK; m0 += ngw * 4) {
      u32x4 aa[4], bb_[4];
#pragma unroll
      for (int u = 0; u < 4; ++u) { aa[u] = *(const u32x4*)(O + (size_t)(m0 + u) * 1024 + h * 256 + dv0); bb_[u] = *(const u32x4*)(O + (size_t)(m0 + u) * 1024 + h * 256 + 128 + dv0); }
#pragma unroll
      for (int u = 0; u < 4; ++u) { const int m = m0 + u; const u32x4 a = aa[u], b = bb_[u];
        float d[8]; const unsigned aw[4] = {a.x, a.y, a.z, a.w}, bw[4] = {b.x, b.y, b.z, b.w};
#pragma unroll
        for (int i = 0; i < 4; ++i) { d[2 * i] = __uint_as_float(aw[i] << 16) - lam * __uint_as_float(bw[i] << 16); d[2 * i + 1] = __uint_as_float(aw[i] & 0xffff0000u) - lam * __uint_as_float(bw[i] & 0xffff0000u); }
        float ss = 0.f;
#pragma unroll
        for (int i = 0; i < 8; ++i) ss += d[i] * d[i];
        ss += shx(ss, 1, lane); ss += shx(ss, 2, lane); ss += shx(ss, 4, lane); ss += shx(ss, 8, lane);
        const float r = rsqrtf(ss * (1.f / 128.f) + RMS_EPS) * (1.f - lambda_init);
        u32x4 w; w.x = pk2(d[0] * r * sg[dv0], d[1] * r * sg[dv0 + 1]); w.y = pk2(d[2] * r * sg[dv0 + 2], d[3] * r * sg[dv0 + 3]);
        w.z = pk2(d[4] * r * sg[dv0 + 4], d[5] * r * sg[dv0 + 5]); w.w = pk2(d[6] * r * sg[dv0 + 6], d[7] * r * sg[dv0 + 7]);
        *(u32x4*)(YA + (size_t)m * ldy + h * 128 + dv0) = w;
      }
    }
}
__device__ __forceinline__ void ph_router(LAS unsigned char* lds, const float* __restrict__ x1, const float* __restrict__ gain, const float* __restrict__ wg, const float* __restrict__ bg,
                                          const float* __restrict__ we, const float* __restrict__ be, bf16_t* __restrict__ xn2, int* bucket, int* rank, float* tw, unsigned* cnt, int gw, int ngw, int lane) {
    LAS float* Wt = (LAS float*)lds; LAS unsigned* lcnt = (LAS unsigned*)(lds + 20 * 4096); LAS unsigned* lbase = lcnt + 32;
    if ((gw & 7) * 64 + lane < 32) lcnt[(gw & 7) * 64 + lane] = 0u;
    { const int t = (gw & 7) * 64 + lane;
      f32x4 a[2], b[8];
#pragma unroll
      for (int i = 0; i < 2; ++i) a[i] = ((const f32x4*)wg)[t + 512 * i];
#pragma unroll
      for (int i = 0; i < 8; ++i) b[i] = ((const f32x4*)we)[t + 512 * i];
#pragma unroll
      for (int i = 0; i < 2; ++i) { const int e = t + 512 * i; Wt[e] = a[i].x; Wt[1024 + e] = a[i].y; Wt[2048 + e] = a[i].z; Wt[3072 + e] = a[i].w; }
#pragma unroll
      for (int i = 0; i < 8; ++i) { const int x = t + 512 * i, e = x >> 2, q = x & 3; Wt[(4 + 4 * q) * 1024 + e] = b[i].x; Wt[(5 + 4 * q) * 1024 + e] = b[i].y; Wt[(6 + 4 * q) * 1024 + e] = b[i].z; Wt[(7 + 4 * q) * 1024 + e] = b[i].w; } }
    __syncthreads();
    for (int m0 = gw * 2; m0 < NTOK; m0 += ngw * 2) {
        f32x4 v[2][4]; float r[2];
#pragma unroll
        for (int tk = 0; tk < 2; ++tk) { const f32x4* xr = (const f32x4*)(x1 + (size_t)(m0 + tk) * DM) + lane; float s = 0.f;
#pragma unroll
            for (int j = 0; j < 4; ++j) { v[tk][j] = xr[64 * j]; s += (v[tk][j].x * v[tk][j].x + v[tk][j].y * v[tk][j].y) + (v[tk][j].z * v[tk][j].z + v[tk][j].w * v[tk][j].w); }
            r[tk] = s; }
#pragma unroll
        for (int tk = 0; tk < 2; ++tk) r[tk] = rsqrtf(wave_sum_dpp(r[tk]) * (1.f / DM) + RMS_EPS);
#pragma unroll
        for (int j = 0; j < 4; ++j) { const f32x4 g = ((const f32x4*)gain)[64 * j + lane];
#pragma unroll
            for (int tk = 0; tk < 2; ++tk) { v[tk][j] = v[tk][j] * r[tk] * g; u32x2 w; w.x = pk2(v[tk][j].x, v[tk][j].y); w.y = pk2(v[tk][j].z, v[tk][j].w); ((u32x2*)(xn2 + (size_t)(m0 + tk) * DM) + lane)[64 * j] = w; } }
        float lg[2][20];
#pragma unroll
        for (int c = 0; c < 20; ++c) {
            float a0 = 0.f, a1 = 0.f;
#pragma unroll
            for (int j = 0; j < 4; ++j) { const f32x4 w = *(const LAS f32x4*)(Wt + c * 1024 + 256 * j + 4 * lane);
                a0 += (v[0][j].x * w.x + v[0][j].y * w.y) + (v[0][j].z * w.z + v[0][j].w * w.w); a1 += (v[1][j].x * w.x + v[1][j].y * w.y) + (v[1][j].z * w.z + v[1][j].w * w.w); }
            lg[0][c] = wave_sum_dpp(a0); lg[1][c] = wave_sum_dpp(a1);
            if ((c & 3) == 3) asm volatile("" ::: "memory");
        }
#pragma unroll
        for (int tk = 0; tk < 2; ++tk) {
            float gl[4]; int gi = 0;
#pragma unroll
            for (int c = 0; c < 4; ++c) gl[c] = lg[tk][c] + bg[c];
            float gm = gl[0];
#pragma unroll
            for (int c = 1; c < 4; ++c) if (gl[c] > gm) { gm = gl[c]; gi = c; }
            float gs = 0.f;
#pragma unroll
            for (int c = 0; c < 4; ++c) gs += __expf(gl[c] - gm);
            const float gval = 1.f / gs;
            float el[4];
#pragma unroll
            for (int c = 0; c < 4; ++c) { float t = lg[tk][4 + c] + be[c]; t = (gi == 1) ? lg[tk][8 + c] + be[4 + c] : t; t = (gi == 2) ? lg[tk][12 + c] + be[8 + c] : t; t = (gi == 3) ? lg[tk][16 + c] + be[12 + c] : t; el[c] = t; }
            int i0 = 0; float m0_ = el[0];
#pragma unroll
            for (int c = 1; c < 4; ++c) if (el[c] > m0_) { m0_ = el[c]; i0 = c; }
            int i1 = -1; float m1 = -INFINITY;
#pragma unroll
            for (int c = 0; c < 4; ++c) if (c != i0 && el[c] > m1) { m1 = el[c]; i1 = c; }
            const float p1 = __expf(m1 - m0_), w0 = gval / (1.f + p1), w1 = gval * p1 / (1.f + p1);
            const int lo = i0 < i1 ? i0 : i1, hi = i0 < i1 ? i1 : i0; const float wlo = i0 < i1 ? w0 : w1, whi = i0 < i1 ? w1 : w0;
            const int pair = (lo == 0) ? hi - 1 : (lo == 1 ? hi + 1 : 5);
            const int b = gi * 6 + pair, m = m0 + tk;
            if (lane == 0) { bucket[m] = b; tw[2 * m] = wlo; tw[2 * m + 1] = whi; rank[m] = (int)__hip_atomic_fetch_add(lcnt + b, 1u, __ATOMIC_RELAXED, __HIP_MEMORY_SCOPE_WORKGROUP); }
        }
    }
    asm volatile("s_waitcnt vmcnt(0) lgkmcnt(0)" ::: "memory"); __syncthreads();
    { const int t = (gw & 7) * 64 + lane; if (t < NBUCKET) lbase[t] = __hip_atomic_fetch_add(cnt + 64 * t, lcnt[t], __ATOMIC_RELAXED, __HIP_MEMORY_SCOPE_AGENT); }
    __syncthreads();
    for (int m0 = gw * 2; m0 < NTOK; m0 += ngw * 2) if (lane < 2) { const int m = m0 + lane; rank[m] += (int)lbase[bucket[m]]; }
}
__device__ __forceinline__ void ph_sort(const bf16_t* __restrict__ xn2, const int* __restrict__ bucket, const int* __restrict__ rank, const float* __restrict__ tw, const unsigned* __restrict__ cnt,
                                        bf16_t* __restrict__ xs, int* slot_tok, float* slot_w, int gw, int ngw, int lane) {
    int mybase = 0, mycnt = 0;
    { int run = 0; for (int b = 0; b < NBUCKET; ++b) { const int cb = (int)cnt[64 * b]; if (lane == b) { mybase = run; mycnt = cb; } run += (cb + 255) & ~255; } }
    for (int m0 = gw * 4; m0 < NTOK; m0 += ngw * 4) {
        int bk[4], rk_[4]; float w0[4], w1[4]; u32x4 ra[4], rb[4];
#pragma unroll
        for (int u = 0; u < 4; ++u) { bk[u] = bucket[m0 + u]; rk_[u] = rank[m0 + u]; w0[u] = tw[2 * (m0 + u)]; w1[u] = tw[2 * (m0 + u) + 1];
            const u32x4* s = (const u32x4*)(xn2 + (size_t)(m0 + u) * DM) + lane; ra[u] = s[0]; rb[u] = s[64]; }
#pragma unroll
        for (int u = 0; u < 4; ++u) { const int slot = shl_i(mybase, bk[u]) + rk_[u]; u32x4* d = (u32x4*)(xs + (size_t)slot * DM) + lane; d[0] = ra[u]; d[64] = rb[u];
            if (lane == 0) { slot_tok[slot] = m0 + u; slot_w[2 * slot] = w0[u]; slot_w[2 * slot + 1] = w1[u]; } }
    }
    if (gw < NBUCKET) { const int b = gw, bs = shl_i(mybase, b), cb = shl_i(mycnt, b), pe = (cb + 255) & ~255;
        float z = 0.f; asm volatile("" : "+v"(z));
        for (int s = cb + lane; s < pe; s += 64) { slot_tok[bs + s] = -1; slot_w[2 * (bs + s)] = z; slot_w[2 * (bs + s) + 1] = z; } }
}

constexpr int NWAVES = 8, RING_BYTES = 131072, MISC_OFF = RING_BYTES + 320, LDS_BYTES = 147456;
constexpr int PH_PER_LAYER = 14;
enum { PH_WTS = 0, PH_NORM, PH_GEMM_IN, PH_FIX, PH_SCAN, PH_MIX, PH_POST, PH_GATE, PH_BRANCH, PH_OUT, PH_ROUTE, PH_SORT, PH_MOE1, PH_MOE2 };
struct Args { const float* in[36]; float* out; unsigned char* ws; int ph_lo, ph_hi, li, pad; };
__device__ __forceinline__ bool inph(int lo, int hi, int k) { asm volatile("" : "+s"(lo), "+s"(hi)); return lo <= k && k < hi; }
__global__ void __launch_bounds__(NWAVES * 64, 2) fwd(Args args) {
    extern __shared__ __attribute__((aligned(16))) unsigned char lds_raw[];
    LAS unsigned char* lds = (LAS unsigned char*)lds_raw;
    volatile LAS unsigned* MISC = (volatile LAS unsigned*)(lds + MISC_OFF);
    const int tid = threadIdx.x, lane = tid & 63, wave = __builtin_amdgcn_readfirstlane(tid >> 6), G = gridDim.x;
    const int gw = blockIdx.x * NWAVES + wave, ngw = G * NWAVES;
    unsigned char* ws = args.ws; unsigned* ctl = (unsigned*)(ws + WS_CTL);
    for (int u = tid; u < (LDS_BYTES - RING_BYTES) / 4; u += NWAVES * 64) ((LAS unsigned*)(lds + RING_BYTES))[u] = 0u;
    __syncthreads();
    XcdBarrier bar = xcd_barrier_post(ctl + CW_BAR + args.li * XCD_BAR_WORDS, MISC + 8);
    const int lo = args.ph_lo, hi = args.ph_hi;
#define IN_(k) inph(lo, hi, (k))
#define SEAM(k) do { if (IN_(k) && IN_((k) + 1)) xcd_barrier(bar); } while (0)
#define PH_BEGIN GAS unsigned char* W = (GAS unsigned char*)ws; asm volatile("" : "+s"(W)); GAS float* OUTP_ = (GAS float*)args.out; asm volatile("" : "+s"(OUTP_)); float* OUTP = (float*)OUTP_; int LN = threadIdx.x; asm volatile("" : "+v"(LN)); LN &= 63; int GG = gridDim.x; asm volatile("" : "+s"(GG)); int BX = blockIdx.x; asm volatile("" : "+s"(BX)); const int NGW_ = GG * NWAVES; int GW = BX * NWAVES + __builtin_amdgcn_readfirstlane(threadIdx.x >> 6); asm volatile("" : "+s"(GW));
#define INP(i) ({ const CAS char* ka_ = (const CAS char*)__builtin_amdgcn_kernarg_segment_ptr(); asm volatile("" : "+s"(ka_)); (const float*)(*(const GAS float* const CAS*)(ka_ + 8 * (i))); })
    for (int l = 0; l < DEPTH; ++l) {
        const int p0 = l * PH_PER_LAYER;
        if (IN_(p0 + PH_WTS)) { PH_BEGIN; ph_weights(({ const CAS char* ka_ = (const CAS char*)__builtin_amdgcn_kernarg_segment_ptr(); asm volatile("" : "+s"(ka_)); ka_; }), l, (unsigned char*)(W + WS_WTS), lds, GW, NGW_, GW & 7, LN);
            ph_s5_tables(INP(13) + l * 1024, INP(14) + l * 1024, INP(15) + l * 16, INP(16) + l * 16384, INP(17) + l * 16384, (float*)(W + WS_WTS + WT_APOW), (float*)(W + WS_WTS + WT_BB), GW * 64 + LN, NGW_ * 64); }
        SEAM(p0 + PH_WTS);
        if (IN_(p0 + PH_NORM)) { PH_BEGIN; const float* xin = l == 0 ? INP(0) : OUTP; ph_rmsnorm(xin, INP(2) + l * DM, (bf16_t*)(W + WS_XN), GW, NGW_, LN);
            ph_s5_mats((const float*)(W + WS_WTS + WT_APOW), (const float*)(W + WS_WTS + WT_BB), INP(18) + l * 16384, INP(19) + l * 16384, (bf16_t*)(W + WS_WTS + WT_S5A), (bf16_t*)(W + WS_WTS + WT_S5B), (bf16_t*)(W + WS_WTS + WT_KTAB), GW * 64 + LN, NGW_ * 64); }
        SEAM(p0 + PH_NORM);
        if (IN_(p0 + PH_GEMM_IN)) { PH_BEGIN;
            pg8::Gemm g{(const bf16_t*)(W + WS_XN), (const bf16_t*)(W + WS_WTS + WT_IN), DM, DM}; pg8::PlainSched S; S.o.init(NTOK / 256, NMIX / 256, GG, BX); S.lda = DM; S.ldb = DM; S.nt = 16; S.pn0 = 0;
            pg8::EpiInMix E{(unsigned char*)W};
            pg8::gemm_phase<pg8::EpiInMix, pg8::PlainSched, true, true>(lds, g, S, E);
        }
        SEAM(p0 + PH_GEMM_IN);
        if (IN_(p0 + PH_FIX)) { PH_BEGIN; ph_s5_expand((const bf16_t*)(W + WS_WTS + WT_KTAB), (bf16_t*)(W + WS_WTS + WT_S5B), GW * 64 + LN, NGW_ * 64); ph_fixup((bf16_t*)(W + WS_YCAT) + YC_Q, YC_LD, (bf16_t*)(W + WS_K), (const int*)INP(1), INP(4) + l * 64, INP(5) + l * 64, GW, NGW_, LN);
            pg8::Gemm g{(const bf16_t*)(W + WS_S5U), (const bf16_t*)(W + WS_WTS + WT_S5A), S5_LD, 512}; pg8::S5aSched S{GG, BX};
            pg8::EpiS5a E{(float*)(W + WS_S5ST)};
            pg8::gemm_phase<pg8::EpiS5a, pg8::S5aSched, true, true>(lds, g, S, E);
            hg_local(lds, (const bf16_t*)(W + WS_HGF), (const bf16_t*)(W + WS_HGI), INP(11), l, (float*)(W + WS_HGST), (float*)(W + WS_WTS + WT_HGDEC), GW, NGW_, GW & 7, LN);
        }
        SEAM(p0 + PH_FIX);
        if (IN_(p0 + PH_SCAN)) { PH_BEGIN; ph_s5_scan((const float*)(W + WS_WTS + WT_APOW), (const float*)(W + WS_S5ST), (bf16_t*)(W + WS_S5U), GW * 64 + LN, NGW_ * 64);
            hg_scan((float*)(W + WS_HGST), (const float*)(W + WS_WTS + WT_HGDEC), GW * 64 + LN, NGW_ * 64);
            sb_phase(lds, (bf16_t*)(W + WS_YCAT) + YC_SB, YC_LD, (const bf16_t*)(W + WS_SBK), (const bf16_t*)(W + WS_SBV), GW, NGW_, GW & 7, LN);
        }
        SEAM(p0 + PH_SCAN);
        if (IN_(p0 + PH_MIX)) { PH_BEGIN;
            { const attn2::AttnTensors AT{(const attn2::bf16*)(W + WS_YCAT) + YC_Q, (const attn2::bf16*)(W + WS_K), (const attn2::bf16*)(W + WS_V), (attn2::bf16*)(W + WS_O)};
              const attn2::StaticOrder SA(GG, BX); attn2::attn_phase<8>((char*)lds_raw, AT, SA); }
            pg8::Gemm g{(const bf16_t*)(W + WS_S5U), (const bf16_t*)(W + WS_WTS + WT_S5B), S5_LD, S5_LD}; pg8::S5bSched S2{GG, BX};
            pg8::EpiS5b E{(const bf16_t*)(W + WS_S5U), INP(20) + l * 256, (bf16_t*)(W + WS_YG)};
            pg8::gemm_phase<pg8::EpiS5b, pg8::S5bSched, true, true>(lds, g, S2, E);
            hg_out(lds, (const bf16_t*)(W + WS_HGF), (const bf16_t*)(W + WS_HGI), (bf16_t*)(W + WS_YCAT) + YC_HG, YC_LD, (const bf16_t*)(W + WS_HGG), INP(11), l, INP(12) + l * 64, (const float*)(W + WS_HGST), GW, NGW_, GW & 7, LN);
        }
        SEAM(p0 + PH_MIX);
        if (IN_(p0 + PH_POST)) { PH_BEGIN;
            const float lambda_init = l == 0 ? 0.2f : 0.35550906759096926f;
            ph_combine((const bf16_t*)(W + WS_O), (bf16_t*)(W + WS_YCAT) + YC_Q, YC_LD, INP(6) + l * 64, INP(7) + l * 64, INP(8) + l * 64, INP(9) + l * 64, INP(10) + l * 128, lambda_init, GW, NGW_, LN);
            pg8::Gemm g{(const bf16_t*)(W + WS_YG), (const bf16_t*)(W + WS_WTS + WT_GLU), 256, 256}; pg8::PlainSched S; S.o.init(NTOK / 256, 1, GG, BX); S.lda = 256; S.ldb = 256; S.nt = 4; S.pn0 = 0;
            pg8::EpiGlu E{(const bf16_t*)(W + WS_YG), INP(22) + l * 256, (bf16_t*)(W + WS_YCAT)};
            pg8::gemm_phase<pg8::EpiGlu, pg8::PlainSched, true, true>(lds, g, S, E);
        }
        SEAM(p0 + PH_POST);
        if (IN_(p0 + PH_GATE)) { PH_BEGIN;
            pg8::Gemm g{(const bf16_t*)(W + WS_XN), (const bf16_t*)(W + WS_WTS + WT_IN), DM, DM}; pg8::PlainSched S; S.o.init(NTOK / 256, 16, GG, BX); S.lda = DM; S.ldb = DM; S.nt = 16; S.pn0 = NMIX / 256;
            pg8::EpiGateU8 E{(unsigned char*)(W + WS_GATE)};
            pg8::gemm_phase<pg8::EpiGateU8, pg8::PlainSched, true, true>(lds, g, S, E);
        }
        SEAM(p0 + PH_GATE);
        if (IN_(p0 + PH_BRANCH)) { PH_BEGIN;
            pg8::Gemm g{(const bf16_t*)(W + WS_YCAT), (const bf16_t*)(W + WS_WTS + WT_P), YC_LD, YC_LD}; pg8::BranchSched S; S.o.init(NTOK / 256, 4, GG, BX);
            pg8::EpiBranch E{(const unsigned char*)(W + WS_GATE), (bf16_t*)(W + WS_O)};
            pg8::gemm_phase<pg8::EpiBranch, pg8::BranchSched, true, true>(lds, g, S, E);
        }
        SEAM(p0 + PH_BRANCH);
        if (IN_(p0 + PH_OUT)) { PH_BEGIN; const float* xin = l == 0 ? INP(0) : OUTP;
            pg8::Gemm g{(const bf16_t*)(W + WS_O), (const bf16_t*)(W + WS_WTS + WT_OUT), DM, DM}; pg8::PlainSched S; S.o.init(NTOK / 256, 4, GG, BX); S.lda = DM; S.ldb = DM; S.nt = 16; S.pn0 = 0;
            pg8::EpiOutRes E{xin, OUTP};
            pg8::gemm_phase<pg8::EpiOutRes, pg8::PlainSched, true, true>(lds, g, S, E);
        }
        SEAM(p0 + PH_OUT);
        if (IN_(p0 + PH_ROUTE)) { PH_BEGIN;
            ph_pair_weights(INP(35) + (size_t)l * NEXP * DEXP * DM, (bf16_t*)(W + WS_O), lds, GW, NGW_, GW & 7, LN);
            ph_router(lds, OUTP, INP(28) + l * DM, INP(29) + l * DM * 4, INP(30) + l * 4, INP(31) + l * DM * 16, INP(32) + l * 16, (bf16_t*)(W + WS_XN), (int*)(W + WS_SMALL + SM_BUCKET), (int*)(W + WS_SMALL + SM_RANK),
                      (float*)(W + WS_SMALL + SM_TW), (unsigned*)(W + WS_CTL) + CW_CNT + CNT_LSTRIDE * l, GW, NGW_, LN); }
        SEAM(p0 + PH_ROUTE);
        if (IN_(p0 + PH_SORT)) { PH_BEGIN;
            ph_sort((const bf16_t*)(W + WS_XN), (const int*)(W + WS_SMALL + SM_BUCKET), (const int*)(W + WS_SMALL + SM_RANK), (const float*)(W + WS_SMALL + SM_TW), (const unsigned*)(W + WS_CTL) + CW_CNT + CNT_LSTRIDE * l,
                    (bf16_t*)(W + WS_XS), (int*)(W + WS_SMALL + SM_SLOTTOK), (float*)(W + WS_SMALL + SM_SLOTW), GW, NGW_, LN); }
        SEAM(p0 + PH_SORT);
        if (IN_(p0 + PH_MOE1)) { PH_BEGIN;
            pg8::Gemm g{(const bf16_t*)(W + WS_XS), (const bf16_t*)(W + WS_WTS + WT_E1), DM, DM}; LAS int* tbl = (LAS int*)(lds + MISC_OFF + 256); pg8::moe_table(tbl, (const unsigned*)(W + WS_CTL) + CW_CNT + CNT_LSTRIDE * l); pg8::MoeSched<1> S{tbl, GG, BX};
            pg8::EpiMoe1 E{(bf16_t*)(W + WS_HID), (const float*)(W + WS_SMALL + SM_SLOTW)};
            pg8::gemm_phase<pg8::EpiMoe1, pg8::MoeSched<1>, true, true>(lds, g, S, E);
        }
        SEAM(p0 + PH_MOE1);
        if (IN_(p0 + PH_MOE2)) { PH_BEGIN;
            pg8::Gemm g{(const bf16_t*)(W + WS_HID), (const bf16_t*)(W + WS_O), 768, 768};        LAS int* tbl = (LAS int*)(lds + MISC_OFF + 256); pg8::moe_table(tbl, (const unsigned*)(W + WS_CTL) + CW_CNT + CNT_LSTRIDE * l); pg8::MoeSched<2> S{tbl, GG, BX};
            pg8::EpiMoe2 E{OUTP, (const int*)(W + WS_SMALL + SM_SLOTTOK), (float*)(W + WS_SMALL + SM_DUMMY)};
            pg8::gemm_phase<pg8::EpiMoe2, pg8::MoeSched<2>, true, true>(lds, g, S, E);
        }
        SEAM(p0 + PH_MOE2);
    }
#undef IN_
#undef SEAM
}

extern "C" void kernel_launch(void* const* d_in, const int* in_sizes, int n_in, void* d_out, int out_size, void* d_ws, size_t ws_size, hipStream_t stream) {
    static int grid = 0;
    if (grid == 0) {
        if (n_in != 36 || out_size != NTOK * DM || ws_size < WS_END) { fprintf(stderr, "kernel_launch: unexpected shapes (n_in %d out %d ws %zu)\n", n_in, out_size, ws_size); grid = -1; return; }
        int dev = 0, cus = 0, per_cu = 0;
        if (hipGetDevice(&dev) != hipSuccess || hipDeviceGetAttribute(&cus, hipDeviceAttributeMultiprocessorCount, dev) != hipSuccess) { grid = -1; return; }
        if (hipFuncSetAttribute((const void*)fwd, hipFuncAttributeMaxDynamicSharedMemorySize, LDS_BYTES) != hipSuccess) { fprintf(stderr, "kernel_launch: hipFuncSetAttribute failed\n"); grid = -1; return; }
        if (hipOccupancyMaxActiveBlocksPerMultiprocessor(&per_cu, (const void*)fwd, NWAVES * 64, LDS_BYTES) != hipSuccess || per_cu < 1) { fprintf(stderr, "kernel_launch: occupancy query says %d\n", per_cu); }
        (void)hipGetLastError();
        grid = cus;
    }
    if (grid < 0) return;
    unsigned char* ws = (unsigned char*)d_ws;
    const float* const* in = (const float* const*)d_in;
    (void)hipMemsetAsync(ws + WS_CTL, 0, 1 * MiB, stream);
    bf16_t *OB = (bf16_t*)(ws + WS_O), *YC = (bf16_t*)(ws + WS_YCAT), *K = (bf16_t*)(ws + WS_K), *V = (bf16_t*)(ws + WS_V);
    bf16_t *SBK = (bf16_t*)(ws + WS_SBK), *SBV = (bf16_t*)(ws + WS_SBV), *HGF = (bf16_t*)(ws + WS_HGF), *HGI = (bf16_t*)(ws + WS_HGI), *HGG = (bf16_t*)(ws + WS_HGG);
    bf16_t *S5U = (bf16_t*)(ws + WS_S5U), *YG = (bf16_t*)(ws + WS_YG);
    Args a{};
    for (int i = 0; i < 36; ++i) a.in[i] = (const float*)d_in[i];
    a.out = (float*)d_out; a.ws = ws;
    a.ph_lo = 0; a.ph_hi = DEPTH * PH_PER_LAYER; a.li = 0;
    hipLaunchKernelGGL(fwd, dim3(grid), dim3(NWAVES * 64), LDS_BYTES, stream, a);
}
```

```cpp
#include <hip/hip_runtime.h>
#include <cstdio>
#include <cstdint>
#include <cmath>

typedef unsigned short bf16_t;
typedef float f32x4 __attribute__((ext_vector_type(4)));
typedef unsigned u32x4 __attribute__((ext_vector_type(4)));
typedef unsigned u32x2 __attribute__((ext_vector_type(2)));
#define GAS __attribute__((address_space(1)))
#define LAS __attribute__((address_space(3)))
#define CAS __attribute__((address_space(4)))

constexpr int NB = 4, SEQ = 8192, NTOK = NB * SEQ, DM = 1024, DEPTH = 2, IN_COLS = 7680;
constexpr int C_GATE = 3584;
constexpr int NMIX = 3584;
constexpr float RMS_EPS = 1e-6f;
constexpr float QSCALE = 0.125f * 1.4426950408889634f;
constexpr int NEXP = 16, DEXP = 384, NBUCKET = 24, MPAD = NTOK + NBUCKET * 256;
constexpr int YC_LD = 1280, YC_Q = 0, YC_SB = 512, YC_HG = 768, YC_YD = 1024;

constexpr size_t MiB = 1u << 20;
constexpr size_t WS_CTL = 0;
constexpr size_t WS_SMALL = 1 * MiB;
constexpr size_t WS_XN = 2 * MiB;
constexpr size_t WS_O = 66 * MiB;
constexpr size_t WS_YCAT = 130 * MiB;
constexpr size_t WS_K = 210 * MiB;
constexpr size_t WS_V = 242 * MiB;
constexpr size_t WS_SBK = 274 * MiB, WS_SBV = 290 * MiB, WS_HGF = 306 * MiB, WS_HGI = 322 * MiB;
constexpr size_t WS_GATE = 210 * MiB;
constexpr size_t WS_HGG = 338 * MiB, WS_S5U = 354 * MiB  , WS_YG = 374 * MiB;
constexpr size_t WS_HGST = 390 * MiB, WS_S5ST = 422 * MiB  , WS_WTS = 432 * MiB, WS_END = 512 * MiB;
constexpr size_t WS_XS = 130 * MiB;
constexpr size_t WS_HID = 210 * MiB;
constexpr size_t WT_IN = 0, WT_P = 15 * MiB, WT_OUT = 18 * MiB, WT_GLU = 20 * MiB, WT_E1 = 21 * MiB, WT_E2 = 45 * MiB, WT_S5A = 57 * MiB  , WT_S5B = 61 * MiB  ;
constexpr size_t WT_KTAB = 75 * MiB  ;
constexpr size_t WT_APOW = 72 * MiB  , WT_BB = 73 * MiB  , WT_HGDEC = 74 * MiB  ;
constexpr int S5_LD = 640;
constexpr size_t SM_BUCKET = 0;
constexpr size_t SM_RANK = 131072;
constexpr size_t SM_TW = 262144;
constexpr size_t SM_SLOTTOK = 524288;
constexpr size_t SM_SLOTW = 524288 + 163840;
constexpr size_t SM_DUMMY = 1040384;
constexpr int CW_CNT = 8192, CNT_LSTRIDE = 2048;
constexpr int CW_BAR = 4096;

__device__ __forceinline__ float bf2f(bf16_t v) { return __uint_as_float((unsigned)v << 16); }
__device__ __forceinline__ bf16_t f2bf(float f) { unsigned u = __float_as_uint(f); return (bf16_t)((u + 0x7fffu + ((u >> 16) & 1u)) >> 16); }
__device__ __forceinline__ unsigned pk2(float lo, float hi) { return (unsigned)f2bf(lo) | ((unsigned)f2bf(hi) << 16); }
__device__ __forceinline__ float shx(float v, int m, int lane) { return __int_as_float(__builtin_amdgcn_ds_bpermute((lane ^ m) << 2, __float_as_int(v))); }
__device__ __forceinline__ float shl_(float v, int src) { return __int_as_float(__builtin_amdgcn_ds_bpermute(src << 2, __float_as_int(v))); }
__device__ __forceinline__ int shl_i(int v, int src) { return __builtin_amdgcn_ds_bpermute(src << 2, v); }
__device__ __forceinline__ float wave_sum_dpp(float v) {
    v += __int_as_float(__builtin_amdgcn_update_dpp(0, __float_as_int(v), 0xb1, 0xf, 0xf, true));
    v += __int_as_float(__builtin_amdgcn_update_dpp(0, __float_as_int(v), 0x4e, 0xf, 0xf, true));
    v += __int_as_float(__builtin_amdgcn_update_dpp(0, __float_as_int(v), 0x114, 0xf, 0xf, true));
    v += __int_as_float(__builtin_amdgcn_update_dpp(0, __float_as_int(v), 0x118, 0xf, 0xf, true));
    v += __int_as_float(__builtin_amdgcn_update_dpp(0, __float_as_int(v), 0x142, 0xa, 0xf, true));
    v += __int_as_float(__builtin_amdgcn_update_dpp(0, __float_as_int(v), 0x143, 0xc, 0xf, true));
    return __int_as_float(__builtin_amdgcn_readlane(__float_as_int(v), 63));
}
__device__ __forceinline__ float wave_sum(float v, int lane) {
#pragma unroll
    for (int o = 1; o < 64; o <<= 1) v += shx(v, o, lane);
    return v;
}
__device__ __forceinline__ float sigmoidf_(float x) { return 1.f / (1.f + __expf(-x)); }
__device__ __forceinline__ float softplusf_(float x) { return fmaxf(x, 0.f) + log1pf(__expf(-fabsf(x))); }

namespace pg8 {
#define PG8_LAS __attribute__((address_space(3)))
typedef short bf16x8 __attribute__((ext_vector_type(8)));
constexpr int BM = 256, BK = 64, HALF = 128, HTB = HALF * BK * 2  , STAGE_BYTES = 8 * HTB, NXCD = 8, WGM = 8;

__host__ __device__ __forceinline__ int lds_byte(int r, int c) { const int st = (r >> 4) * 2 + (c >> 5), rr = r & 15, cc = c & 31, ob = rr * 64 + cc * 2; return st * 1024 + (ob ^ (((ob >> 9) & 1) << 5)); }
__host__ __device__ __forceinline__ void stage_rc(int b, int& R, int& C) { const int st = b / 1024, sb = b % 1024, swz = sb ^ (((sb >> 9) & 1) << 5); R = (st >> 1) * 16 + swz / 64; C = (st & 1) * 32 + (swz % 64) / 2; }
__host__ __device__ __forceinline__ int perm32(int rho) { const int n = rho >> 4, i = rho & 15; return 8 * (i >> 2) + 4 * n + (i & 3); }

struct Unit { unsigned aoff, boff; int nt, pm, pn, aux; };
struct Gemm { const bf16_t* A; const bf16_t* Bt; int lda, ldb; };

struct TileOrder {
    int nM, nN, nwg, G, c;
    __device__ __forceinline__ void init(int nM_, int nN_, int G_, int c_) { nM = nM_; nN = nN_; nwg = nM * nN; G = G_; c = c_; }
    __device__ __forceinline__ bool tile(int i, int& pm, int& pn) const {
        const int L = i * G + c; if (L >= nwg) return false;
        int wgid = L; { const int q = nwg / NXCD, r = nwg % NXCD, xcd = wgid % NXCD, off = wgid / NXCD; wgid = (xcd < r ? xcd * (q + 1) : r * (q + 1) + (xcd - r) * q) + off; }
        const int nig = WGM * nN, gid = wgid / nig, fm = gid * WGM, gsz = (nM - fm) < WGM ? (nM - fm) : WGM;
        pm = fm + ((wgid % nig) % gsz); pn = (wgid % nig) / gsz; return true;
    }
};
struct PlainSched {
    TileOrder o; int lda, ldb, nt, pn0;
    __device__ __forceinline__ bool next(int i, Unit& u) const { int pm, pn; if (!o.tile(i, pm, pn)) return false;
        u.aoff = (unsigned)pm * 256u * lda * 2u; u.boff = (unsigned)(pn0 + pn) * 256u * ldb * 2u; u.nt = nt; u.pm = pm; u.pn = pn; u.aux = 0; return true; }
    __device__ __forceinline__ void a_ready(const Unit&) const {}
    __device__ __forceinline__ void done(const Unit&) const {}
};
struct BranchSched {
    TileOrder o;
    __device__ __forceinline__ bool next(int i, Unit& u) const { int pm, pn; if (!o.tile(i, pm, pn)) return false;
        u.aoff = (unsigned)pm * 256u * YC_LD * 2u; u.boff = (unsigned)pn * 256u * YC_LD * 2u; u.nt = 20; u.pm = pm; u.pn = pn; u.aux = 0; return true; }
    __device__ __forceinline__ void a_ready(const Unit&) const {}
    __device__ __forceinline__ void done(const Unit&) const {}
};
__device__ __forceinline__ void pair_experts(int b, int& e0, int& e1) { const int g = b / 6, p = b % 6; const int lo = p < 3 ? 0 : (p < 5 ? 1 : 2), hi = p < 3 ? p + 1 : (p < 5 ? p - 1 : 3); e0 = g * 4 + lo; e1 = g * 4 + hi; }
constexpr int MOE_TBL_TOT = MPAD / 256;
__device__ __forceinline__ void moe_table(PG8_LAS int* tbl, const unsigned* cnt) {
    int t = threadIdx.x; asm volatile("" : "+v"(t));
    if (t <= MOE_TBL_TOT) { int tot = 0, bsel = NBUCKET - 1, found = 0;
#pragma nounroll
        for (int b = 0; b < NBUCKET; ++b) { const int tb = (int)((__hip_atomic_load(cnt + 64 * b, __ATOMIC_RELAXED, __HIP_MEMORY_SCOPE_AGENT) + 255u) >> 8); if (!found && t < tot + tb) { bsel = b; found = 1; } tot += tb; }
        tbl[t] = t == MOE_TBL_TOT ? tot : bsel; }
    __syncthreads();
}
template <int PHASE> struct MoeSched {
    const PG8_LAS int* tbl; int G, c;
    __device__ __forceinline__ bool next(int i, Unit& u) const {
        constexpr int NT = PHASE == 1 ? 6 : 4;
        const int L = i * G + c, pm = L / NT, pn = L % NT;
        if (pm >= __builtin_amdgcn_readfirstlane(tbl[MOE_TBL_TOT])) return false;
        const int bsel = __builtin_amdgcn_readfirstlane(tbl[pm]);
        int e0, e1; pair_experts(bsel, e0, e1);
        u.pm = pm; u.pn = pn; u.aux = 0;
        if (PHASE == 1) { const int sel = pn / 3, jt = pn % 3, e = sel ? e1 : e0;
            u.aoff = (unsigned)pm * 256u * DM * 2u; u.boff = (unsigned)(e * 3 + jt) * 256u * DM * 2u; u.nt = 16; }
        else { u.aoff = (unsigned)pm * 256u * 768u * 2u; u.boff = ((unsigned)bsel * 1024u + (unsigned)pn * 256u) * 768u * 2u; u.nt = 12; }
        return true;
    }
    __device__ __forceinline__ void a_ready(const Unit&) const {}
    __device__ __forceinline__ void done(const Unit&) const {}
};

__device__ __forceinline__ unsigned cvt_pk_bf16(float lo, float hi) { unsigned r; asm volatile("v_cvt_pk_bf16_f32 %0, %1, %2" : "=v"(r) : "v"(lo), "v"(hi)); return r; }
__device__ __forceinline__ u32x4 pack8(const f32x4 a, const f32x4 b) { u32x4 w; w.x = cvt_pk_bf16(a[0], a[1]); w.y = cvt_pk_bf16(a[2], a[3]); w.z = cvt_pk_bf16(b[0], b[1]); w.w = cvt_pk_bf16(b[2], b[3]); return w; }
__device__ __forceinline__ float fsig(float x) { return __builtin_amdgcn_rcpf(1.f + __builtin_amdgcn_exp2f(-1.4426950408889634f * x)); }
#define PG8_EPI_LOOP for (int ai = 0; ai < 2; ++ai) _Pragma("unroll") for (int m = 0; m < 4; ++m) _Pragma("unroll") for (int bj = 0; bj < 3; ++bj) if (bj == 2) { asm volatile("" ::: "memory"); } else

struct EpiInMix {
    static constexpr bool PERM = true, AFTER_DRAIN = false, MID = false; unsigned char* ws;
    __device__ __forceinline__ void operator()(const f32x4 (&acc)[2][2][4][2], const Unit& u, int wr, int wc, int fr, int fq) const {
        const int pn = u.pn; bf16_t* base; int ld;
        if (pn < 2) { base = (bf16_t*)(ws + WS_YCAT) + YC_Q + pn * 256; ld = YC_LD; }
        else if (pn < 4) { base = (bf16_t*)(ws + WS_K) + (pn - 2) * 256; ld = 512; }
        else if (pn < 6) { base = (bf16_t*)(ws + WS_V) + (pn - 4) * 256; ld = 512; }
        else if (pn == 6) { base = (bf16_t*)(ws + WS_YCAT) + YC_SB; ld = YC_LD; }
        else if (pn == 7) { base = (bf16_t*)(ws + WS_SBK); ld = 256; }
        else if (pn == 8) { base = (bf16_t*)(ws + WS_SBV); ld = 256; }
        else if (pn == 9) { base = (bf16_t*)(ws + WS_HGF); ld = 256; }
        else if (pn == 10) { base = (bf16_t*)(ws + WS_HGI); ld = 256; }
        else if (pn == 11) { base = (bf16_t*)(ws + WS_YCAT) + YC_HG; ld = YC_LD; }
        else if (pn == 12) { base = (bf16_t*)(ws + WS_HGG); ld = 256; }
        else { base = (bf16_t*)(ws + WS_S5U); ld = 16; }
        const int row0 = u.pm * BM + wr * 64 + fr, col0 = wc * 32 + 8 * fq;
#pragma unroll
        PG8_EPI_LOOP { const int row = row0 + ai * HALF + m * 16, col = col0 + bj * HALF; const u32x4 w = pack8(acc[ai][bj][m][0], acc[ai][bj][m][1]);
            if (pn == 13) *(u32x4*)(base + ((size_t)(col >> 4) * 1024 + (row >> 5)) * S5_LD + (row & 31) * 16 + (col & 15)) = w;
            else *(u32x4*)(base + (size_t)row * ld + col) = w; }
    }
};
struct EpiGateU8 {
    static constexpr bool PERM = true, AFTER_DRAIN = false, MID = false; unsigned char* G;
    __device__ __forceinline__ void operator()(const f32x4 (&acc)[2][2][4][2], const Unit& u, int wr, int wc, int fr, int fq) const {
        const int row0 = u.pm * BM + wr * 64 + fr, col0 = (u.pn & 3) * BM + wc * 32 + 8 * fq; unsigned char* Gp = G + (size_t)(u.pn >> 2) * ((size_t)NTOK * 1024);
#pragma unroll
        PG8_EPI_LOOP { const f32x4 a = acc[ai][bj][m][0], b = acc[ai][bj][m][1]; unsigned q[8];
#pragma unroll
            for (int i = 0; i < 4; ++i) { q[i] = (unsigned)(fsig(a[i]) * 255.f + 0.5f); q[4 + i] = (unsigned)(fsig(b[i]) * 255.f + 0.5f); }
            u32x2 w; w.x = q[0] | (q[1] << 8) | (q[2] << 16) | (q[3] << 24); w.y = q[4] | (q[5] << 8) | (q[6] << 16) | (q[7] << 24);
            *(u32x2*)(Gp + (size_t)(row0 + ai * HALF + m * 16) * 1024 + col0 + bj * HALF) = w; }
    }
};
struct EpiBranch {
    static constexpr bool PERM = true, AFTER_DRAIN = false, MID = true; const unsigned char* G; bf16_t* Mg;
    static constexpr size_t PLANE = (size_t)NTOK * 1024;
    __device__ __forceinline__ void gl2(u32x2 (&g)[4], const unsigned char* gp0, int k) const {
        const unsigned char* gp = gp0 + (size_t)((k >> 2) * HALF + (k & 3) * 16) * 1024;
        g[0] = *(const u32x2*)gp; g[1] = *(const u32x2*)(gp + PLANE); g[2] = *(const u32x2*)(gp + HALF); g[3] = *(const u32x2*)(gp + PLANE + HALF);
    }
    __device__ __forceinline__ void mid(f32x4 (&acc)[2][2][4][2], const Unit& u, int t, int, int, int, int) const {
        int tid = threadIdx.x; asm volatile("" : "+v"(tid));
        const int wid = __builtin_amdgcn_readfirstlane(tid >> 6), wr = wid >> 2, wc = wid & 3, fr = tid & 15, fq = (tid & 63) >> 4;
        const int row0 = u.pm * BM + wr * 64 + fr, col0 = u.pn * BM + wc * 32 + 8 * fq;
        const unsigned char* gp0 = G + (size_t)((t - 8) >> 2) * PLANE + (size_t)row0 * 1024 + col0;
        u32x2 gc[4], gn[4]; gl2(gc, gp0, 0);
#pragma unroll
        for (int k = 0; k < 8; ++k) { const int ai = k >> 2, m = k & 3;
            if (k < 7) gl2(gn, gp0, k + 1);
#pragma unroll
            for (int bj = 0; bj < 2; ++bj)
#pragma unroll
                for (int i = 0; i < 4; ++i) { acc[ai][bj][m][0][i] *= fmaxf((float)((gc[2 * bj].x >> (8 * i)) & 255u), 0.5f) * __builtin_amdgcn_rcpf(fmaxf((float)((gc[2 * bj + 1].x >> (8 * i)) & 255u), 0.5f));
                                              acc[ai][bj][m][1][i] *= fmaxf((float)((gc[2 * bj].y >> (8 * i)) & 255u), 0.5f) * __builtin_amdgcn_rcpf(fmaxf((float)((gc[2 * bj + 1].y >> (8 * i)) & 255u), 0.5f)); }
            asm volatile("" ::: "memory");
#pragma unroll
            for (int q = 0; q < 4; ++q) gc[q] = gn[q]; }
    }
    __device__ __forceinline__ void gl1(u32x2 (&g)[2], const unsigned char* gp0, int k) const { const unsigned char* gp = gp0 + (size_t)((k >> 2) * HALF + (k & 3) * 16) * 1024; g[0] = *(const u32x2*)gp; g[1] = *(const u32x2*)(gp + HALF); }
    __device__ __forceinline__ void operator()(const f32x4 (&acc)[2][2][4][2], const Unit& u, int, int, int, int) const {
        int tid = threadIdx.x; asm volatile("" : "+v"(tid));
        const int wid = __builtin_amdgcn_readfirstlane(tid >> 6), wr = wid >> 2, wc = wid & 3, fr = tid & 15, fq = (tid & 63) >> 4;
        const int row0 = u.pm * BM + wr * 64 + fr, col0 = u.pn * BM + wc * 32 + 8 * fq;
        const unsigned char* gp0 = G + 3 * PLANE + (size_t)row0 * 1024 + col0;
        u32x2 gc[2], gn[2]; gl1(gc, gp0, 0);
#pragma unroll
        for (int k = 0; k < 8; ++k) { const int ai = k >> 2, m = k & 3, row = row0 + ai * HALF + m * 16;
            if (k < 7) gl1(gn, gp0, k + 1);
#pragma unroll
            for (int bj = 0; bj < 2; ++bj) { f32x4 a = acc[ai][bj][m][0], b = acc[ai][bj][m][1];
#pragma unroll
                for (int i = 0; i < 4; ++i) { a[i] *= fmaxf((float)((gc[bj].x >> (8 * i)) & 255u), 0.5f) * (1.f / 255.f); b[i] *= fmaxf((float)((gc[bj].y >> (8 * i)) & 255u), 0.5f) * (1.f / 255.f); }
                *(u32x4*)(Mg + (size_t)row * DM + col0 + bj * HALF) = pack8(a, b); }
            asm volatile("" ::: "memory");
            gc[0] = gn[0]; gc[1] = gn[1]; }
    }
};
struct EpiOutRes {
    static constexpr bool PERM = true, AFTER_DRAIN = false, MID = false; const float* xi; float* xo;
    __device__ __forceinline__ void ld(f32x4 (&r)[4], size_t off) const { r[0] = *(const f32x4*)(xi + off); r[1] = *(const f32x4*)(xi + off + 4); r[2] = *(const f32x4*)(xi + off + HALF); r[3] = *(const f32x4*)(xi + off + HALF + 4); }
    __device__ __forceinline__ void operator()(const f32x4 (&acc)[2][2][4][2], const Unit& u, int wr, int wc, int fr, int fq) const {
        const int row0 = u.pm * BM + wr * 64 + fr, col0 = u.pn * BM + wc * 32 + 8 * fq;
        f32x4 rc[4], rn[4]; ld(rc, (size_t)row0 * DM + col0);
#pragma unroll
        for (int k = 0; k < 8; ++k) { const int ai = k >> 2, m = k & 3; const size_t off = (size_t)(row0 + ai * HALF + m * 16) * DM + col0;
            if (k < 7) ld(rn, (size_t)(row0 + ((k + 1) >> 2) * HALF + ((k + 1) & 3) * 16) * DM + col0);
            *(f32x4*)(xo + off) = rc[0] + acc[ai][0][m][0]; *(f32x4*)(xo + off + 4) = rc[1] + acc[ai][0][m][1]; *(f32x4*)(xo + off + HALF) = rc[2] + acc[ai][1][m][0]; *(f32x4*)(xo + off + HALF + 4) = rc[3] + acc[ai][1][m][1];
            asm volatile("" ::: "memory");
#pragma unroll
            for (int q = 0; q < 4; ++q) rc[q] = rn[q]; }
    }
};
struct EpiGlu {
    static constexpr bool PERM = true, AFTER_DRAIN = false, MID = false; const bf16_t* yg; const float* bias; bf16_t* yc;
    __device__ __forceinline__ void operator()(const f32x4 (&acc)[2][2][4][2], const Unit& u, int wr, int wc, int fr, int fq) const {
        const int row0 = u.pm * BM + wr * 64 + fr, col0 = wc * 32 + 8 * fq;
#pragma unroll
        PG8_EPI_LOOP { const int row = row0 + ai * HALF + m * 16, col = col0 + bj * HALF;
            const u32x4 p = *(const u32x4*)(yg + (size_t)row * 256 + col); const f32x4 b0 = *(const f32x4*)(bias + col), b1 = *(const f32x4*)(bias + col + 4);
            f32x4 a = acc[ai][bj][m][0] + b0, b = acc[ai][bj][m][1] + b1;
            const float y[8] = {__uint_as_float(p.x << 16), __uint_as_float(p.x & 0xffff0000u), __uint_as_float(p.y << 16), __uint_as_float(p.y & 0xffff0000u),
                                __uint_as_float(p.z << 16), __uint_as_float(p.z & 0xffff0000u), __uint_as_float(p.w << 16), __uint_as_float(p.w & 0xffff0000u)};
#pragma unroll
            for (int i = 0; i < 4; ++i) { a[i] = y[i] * fsig(a[i]); b[i] = y[4 + i] * fsig(b[i]); }
            *(u32x4*)(yc + (size_t)row * YC_LD + YC_YD + col) = pack8(a, b); }
    }
};
struct S5aSched {
    int G, c;
    __device__ __forceinline__ bool next(int i, Unit& u) const { const int L = i * G + c; if (L >= 64) return false; const int g = L >> 2, pm = L & 3;
        u.aoff = ((unsigned)(g * 1024 + pm * 256) * S5_LD) * 2u; u.boff = (unsigned)g * 256u * 512u * 2u; u.nt = 8; u.pm = g * 4 + pm; u.pn = 0; u.aux = 0; return true; }
    __device__ __forceinline__ void a_ready(const Unit&) const {}
    __device__ __forceinline__ void done(const Unit&) const {}
};
struct S5bSched {
    int G, c;
    __device__ __forceinline__ bool next(int i, Unit& u) const { const int L = i * G + c; if (L >= 128) return false; const int g = L >> 3, pm = (L >> 1) & 3, pn = L & 1;
        u.aoff = ((unsigned)(g * 1024 + pm * 256) * S5_LD) * 2u; u.boff = ((unsigned)(g * 512 + pn * 256) * S5_LD) * 2u; u.nt = 10; u.pm = g * 4 + pm; u.pn = pn; u.aux = g; return true; }
    __device__ __forceinline__ void a_ready(const Unit&) const {}
    __device__ __forceinline__ void done(const Unit&) const {}
};
struct EpiS5a {
    static constexpr bool PERM = true, AFTER_DRAIN = false, MID = false; float* st;
    __device__ __forceinline__ void operator()(const f32x4 (&acc)[2][2][4][2], const Unit& u, int wr, int wc, int fr, int fq) const {
        const int row0 = u.pm * BM + wr * 64 + fr, col0 = wc * 32 + 8 * fq;
#pragma unroll
        for (int ai = 0; ai < 2; ++ai)
#pragma unroll
            for (int m = 0; m < 4; ++m) { float* p = st + (size_t)(row0 + ai * HALF + m * 16) * 128 + col0; *(f32x4*)p = acc[ai][0][m][0]; *(f32x4*)(p + 4) = acc[ai][0][m][1]; }
    }
};
struct EpiS5b {
    static constexpr bool PERM = true, AFTER_DRAIN = false, MID = false; const bf16_t* s5u; const float* dsk; bf16_t* yg;
    __device__ __forceinline__ void operator()(const f32x4 (&acc)[2][2][4][2], const Unit& u, int wr, int wc, int fr, int fq) const {
        const int g = u.aux, row0 = u.pm * BM + wr * 64 + fr  , col0 = u.pn * BM + wc * 32 + 8 * fq, c0 = col0 & 15;
        const f32x4 d0 = *(const f32x4*)(dsk + g * 16 + c0), d1 = *(const f32x4*)(dsk + g * 16 + c0 + 4);
#pragma unroll
        PG8_EPI_LOOP { const int row = row0 + ai * HALF + m * 16, col = col0 + bj * HALF, chunk = row - g * 1024, t = col >> 4;
            const u32x4 p = *(const u32x4*)(s5u + (size_t)row * S5_LD + col);
            const float uu[8] = {__uint_as_float(p.x << 16), __uint_as_float(p.x & 0xffff0000u), __uint_as_float(p.y << 16), __uint_as_float(p.y & 0xffff0000u),
                                 __uint_as_float(p.z << 16), __uint_as_float(p.z & 0xffff0000u), __uint_as_float(p.w << 16), __uint_as_float(p.w & 0xffff0000u)};
            f32x4 a = acc[ai][bj][m][0], b = acc[ai][bj][m][1];
#pragma unroll
            for (int i = 0; i < 4; ++i) { float y = a[i] + d0[i] * uu[i]; float z = 0.7978845608028654f * (y + 0.044715f * y * y * y); a[i] = y * fsig(2.f * z);
                y = b[i] + d1[i] * uu[4 + i]; z = 0.7978845608028654f * (y + 0.044715f * y * y * y); b[i] = y * fsig(2.f * z); }
            *(u32x4*)(yg + (size_t)(chunk * 32 + t) * 256 + g * 16 + c0) = pack8(a, b); }
    }
};
struct EpiMoe1 {
    static constexpr bool PERM = true, AFTER_DRAIN = false, MID = false; bf16_t* hid; const float* slot_w;
    __device__ __forceinline__ void operator()(const f32x4 (&acc)[2][2][4][2], const Unit& u, int wr, int wc, int fr, int fq) const {
        const int row0 = u.pm * BM + wr * 64 + fr, sel = u.pn / 3, col0 = sel * DEXP + (u.pn % 3) * 128 + wc * 32 + 8 * fq;
#pragma unroll
        for (int ai = 0; ai < 2; ++ai)
#pragma unroll
            for (int m = 0; m < 4; ++m) { const int row = row0 + ai * HALF + m * 16; const float w = slot_w[2 * row + sel]; f32x4 a, b;
#pragma unroll
                for (int i = 0; i < 4; ++i) { const float g0 = acc[ai][0][m][0][i], g1 = acc[ai][0][m][1][i]; a[i] = g0 * fsig(g0) * acc[ai][1][m][0][i] * w; b[i] = g1 * fsig(g1) * acc[ai][1][m][1][i] * w; }
                *(u32x4*)(hid + (size_t)row * 768 + col0) = pack8(a, b); asm volatile("" ::: "memory"); }
    }
};
struct EpiMoe2 {
    static constexpr bool PERM = true, AFTER_DRAIN = false, MID = false; float* x; const int* slot_tok; float* dummy;
    __device__ __forceinline__ void operator()(const f32x4 (&acc)[2][2][4][2], const Unit& u, int wr, int wc, int fr, int fq) const {
        const int row0 = u.pm * BM + wr * 64 + fr, col0 = u.pn * BM + wc * 32 + 8 * fq;
        int tk[8];
#pragma unroll
        for (int k = 0; k < 8; ++k) tk[k] = slot_tok[row0 + (k >> 2) * HALF + (k & 3) * 16];
        f32x4 rc[4], rn[4]; float* pc = (tk[0] >= 0 ? x + (size_t)tk[0] * DM : dummy) + col0;
        rc[0] = *(const f32x4*)pc; rc[1] = *(const f32x4*)(pc + 4); rc[2] = *(const f32x4*)(pc + HALF); rc[3] = *(const f32x4*)(pc + HALF + 4);
#pragma unroll
        for (int k = 0; k < 8; ++k) { const int ai = k >> 2, m = k & 3; float* pn = pc;
            if (k < 7) { pn = (tk[k + 1] >= 0 ? x + (size_t)tk[k + 1] * DM : dummy) + col0; rn[0] = *(const f32x4*)pn; rn[1] = *(const f32x4*)(pn + 4); rn[2] = *(const f32x4*)(pn + HALF); rn[3] = *(const f32x4*)(pn + HALF + 4); }
            *(f32x4*)pc = rc[0] + acc[ai][0][m][0]; *(f32x4*)(pc + 4) = rc[1] + acc[ai][0][m][1]; *(f32x4*)(pc + HALF) = rc[2] + acc[ai][1][m][0]; *(f32x4*)(pc + HALF + 4) = rc[3] + acc[ai][1][m][1];
            asm volatile("" ::: "memory");
            pc = pn;
#pragma unroll
            for (int q = 0; q < 4; ++q) rc[q] = rn[q]; }
    }
};

template <class Epi, class Sched, bool ALIGN_EPI = false, bool SP2 = false>
__device__ __forceinline__ void gemm_phase(PG8_LAS unsigned char* lds, const Gemm g, const Sched& S, const Epi& E) {
    int tid_ = threadIdx.x; asm volatile("" : "+v"(tid_));
    const int tid = tid_, wid = __builtin_amdgcn_readfirstlane(tid >> 6), lane = tid & 63, wr = wid >> 2, wc = wid & 3, fr = lane & 15, fq = lane >> 4;
    unsigned voffA[2], voffB[2];
#pragma unroll
    for (int i = 0; i < 2; ++i) { int R, C; stage_rc(tid * 16 + i * 8192, R, C); const int Rb = Epi::PERM ? ((R & ~31) + perm32(R & 31)) : R;
        voffA[i] = (unsigned)(R * g.lda + C) * 2u; voffB[i] = (unsigned)(Rb * g.ldb + C) * 2u; }
    const size_t kstep = (size_t)(BK * 2);
    const size_t hstepA = (size_t)HALF * g.lda * 2, hstepB = (size_t)HALF * g.ldb * 2;
    const unsigned ldsw = (unsigned)wid * 1024u;
    const int aoff = lds_byte(wr * 64 + fr, fq * 8), boff = lds_byte(wc * 32 + fr, fq * 8);
#define PG8_SA(b, h) (((b) * 2 + (h)) * HTB)
#define PG8_SB(b, h) ((4 + (b) * 2 + (h)) * HTB)
#define PG8_STAGE(bufoff, gbase, voff) do { _Pragma("unroll") for (int _i = 0; _i < 2; ++_i) \
        __builtin_amdgcn_global_load_lds((const unsigned*)((const char*)(gbase) + (voff)[_i]), (PG8_LAS unsigned*)(lds + (bufoff) + ldsw + _i * 8192), 16, 0, 0); } while (0)
#define PG8_LDA(dst, b, h) do { _Pragma("unroll") for (int m = 0; m < 4; ++m) _Pragma("unroll") for (int k = 0; k < 2; ++k) dst[m][k] = *(const PG8_LAS bf16x8*)(lds + PG8_SA(b, h) + aoff + m * 2048 + k * 1024); } while (0)
#define PG8_LDB(dst, b, h) do { _Pragma("unroll") for (int n = 0; n < 2; ++n) _Pragma("unroll") for (int k = 0; k < 2; ++k) dst[n][k] = *(const PG8_LAS bf16x8*)(lds + PG8_SB(b, h) + boff + n * 2048 + k * 1024); } while (0)
#define PG8_MMA(ai, bj, At, Bt) do { __builtin_amdgcn_s_setprio(1); _Pragma("unroll") for (int m = 0; m < 4; ++m) _Pragma("unroll") for (int n = 0; n < 2; ++n) _Pragma("unroll") for (int k = 0; k < 2; ++k) \
        acc[ai][bj][m][n] = __builtin_amdgcn_mfma_f32_16x16x32_bf16(Bt[n][k], At[m][k], acc[ai][bj][m][n], 0, 0, 0); __builtin_amdgcn_s_setprio(0); } while (0)
#define PG8_WAIT_V(n) asm volatile("s_waitcnt vmcnt(" #n ")" ::: "memory")
#define PG8_WAIT_L(n) asm volatile("s_waitcnt lgkmcnt(" #n ")" ::: "memory")
#define PG8_BAR __builtin_amdgcn_s_barrier()
#define PG8_SCHED __builtin_amdgcn_sched_barrier(0)
    Unit cur; int ui = 0;
    if (!S.next(0, cur)) return;
    f32x4 acc[2][2][4][2];
#pragma unroll
    for (int a = 0; a < 2; ++a)
#pragma unroll
        for (int b = 0; b < 2; ++b)
#pragma unroll
            for (int m = 0; m < 4; ++m)
#pragma unroll
                for (int n = 0; n < 2; ++n) acc[a][b][m][n] = (f32x4){0.f, 0.f, 0.f, 0.f};
    bf16x8 At[4][2], B0[2][2], B1[2][2];
    const char* cA = (const char*)g.A + cur.aoff; const char* cB = (const char*)g.Bt + cur.boff;
    S.a_ready(cur);
    if constexpr (SP2) {
        PG8_STAGE(PG8_SB(0, 0), cB, voffB); PG8_STAGE(PG8_SB(0, 1), cB + hstepB, voffB); PG8_STAGE(PG8_SA(0, 0), cA, voffA); PG8_STAGE(PG8_SA(0, 1), cA + hstepA, voffA);
        if (wr == 1) PG8_BAR;
        PG8_WAIT_V(2); PG8_BAR;
        PG8_STAGE(PG8_SB(1, 0), cB + kstep, voffB); PG8_STAGE(PG8_SA(1, 0), cA + kstep, voffA); PG8_STAGE(PG8_SB(1, 1), cB + hstepB + kstep, voffB);
        PG8_WAIT_V(6); PG8_BAR;
    } else {
        PG8_STAGE(PG8_SB(0, 0), cB, voffB); PG8_STAGE(PG8_SA(0, 0), cA, voffA); PG8_STAGE(PG8_SB(0, 1), cB + hstepB, voffB); PG8_STAGE(PG8_SA(0, 1), cA + hstepA, voffA);
        if (wr == 1) PG8_BAR;
        PG8_WAIT_V(4); PG8_BAR;
        PG8_STAGE(PG8_SB(1, 0), cB + kstep, voffB); PG8_STAGE(PG8_SA(1, 0), cA + kstep, voffA); PG8_STAGE(PG8_SB(1, 1), cB + hstepB + kstep, voffB);
        PG8_WAIT_V(6); PG8_BAR;
    }
    for (;;) {
        Unit nxt; const bool has_next = S.next(ui + 1, nxt);
        const char* nA = has_next ? (const char*)g.A + nxt.aoff : cA; const char* nB = has_next ? (const char*)g.Bt + nxt.boff : cB;
        const int nt = cur.nt;
        for (int t = 0; t < nt; t += 2) {
            const bool last = (t == nt - 2);
            const char* a1 = cA + (size_t)(t + 1) * kstep;
            const char* a2 = last ? nA : cA + (size_t)(t + 2) * kstep; const char* b2 = last ? nB : cB + (size_t)(t + 2) * kstep;
            const char* a3 = a2 + kstep; const char* b3 = b2 + kstep;
            if (last && has_next) S.a_ready(nxt);
            if constexpr (Epi::MID) { if (t == 8 || t == 12 || t == 16) E.mid(acc, cur, t, wr, wc, fr, fq); }
            if constexpr (SP2) {
            PG8_LDB(B0, 0, 0); PG8_LDB(B1, 0, 1); PG8_SCHED; PG8_LDA(At, 0, 0); PG8_STAGE(PG8_SA(1, 1), a1 + hstepA, voffA);
            PG8_WAIT_V(8); PG8_WAIT_L(0); PG8_BAR; PG8_MMA(0, 0, At, B0); PG8_MMA(0, 1, At, B1); PG8_BAR; PG8_SCHED;
            PG8_LDA(At, 0, 1); PG8_STAGE(PG8_SB(0, 0), b2, voffB); PG8_STAGE(PG8_SB(0, 1), b2 + hstepB, voffB); PG8_STAGE(PG8_SA(0, 0), a2, voffA);
            PG8_WAIT_V(8); PG8_WAIT_L(0); PG8_BAR; PG8_MMA(1, 0, At, B0); PG8_MMA(1, 1, At, B1); PG8_BAR; PG8_SCHED;
            PG8_LDB(B0, 1, 0); PG8_LDB(B1, 1, 1); PG8_SCHED; PG8_LDA(At, 1, 0); PG8_STAGE(PG8_SA(0, 1), a2 + hstepA, voffA);
            PG8_WAIT_V(8); PG8_WAIT_L(0); PG8_BAR; PG8_MMA(0, 0, At, B0); PG8_MMA(0, 1, At, B1); PG8_BAR; PG8_SCHED;
            PG8_LDA(At, 1, 1); PG8_STAGE(PG8_SB(1, 0), b3, voffB); PG8_STAGE(PG8_SB(1, 1), b3 + hstepB, voffB); PG8_STAGE(PG8_SA(1, 0), a3, voffA);
            PG8_WAIT_V(8); PG8_WAIT_L(0); PG8_BAR; PG8_MMA(1, 0, At, B0); PG8_MMA(1, 1, At, B1); PG8_BAR; PG8_SCHED;
            } else {
            PG8_LDB(B0, 0, 0); PG8_SCHED; PG8_LDA(At, 0, 0); PG8_STAGE(PG8_SA(1, 1), a1 + hstepA, voffA);
            PG8_WAIT_L(8); PG8_BAR; PG8_WAIT_L(0); PG8_MMA(0, 0, At, B0); PG8_BAR; PG8_SCHED;
            PG8_LDB(B1, 0, 1); PG8_STAGE(PG8_SB(0, 0), b2, voffB);
            PG8_BAR; PG8_WAIT_L(0); PG8_MMA(0, 1, At, B1); PG8_BAR;
            PG8_LDA(At, 0, 1); PG8_STAGE(PG8_SA(0, 0), a2, voffA);
            PG8_BAR; PG8_WAIT_L(0); PG8_MMA(1, 0, At, B0); PG8_BAR; PG8_SCHED;
            PG8_STAGE(PG8_SB(0, 1), b2 + hstepB, voffB);
            PG8_WAIT_V(6); PG8_BAR; PG8_MMA(1, 1, At, B1); PG8_BAR;
            PG8_LDB(B0, 1, 0); PG8_SCHED; PG8_LDA(At, 1, 0); PG8_STAGE(PG8_SA(0, 1), a2 + hstepA, voffA);
            PG8_WAIT_L(8); PG8_BAR; PG8_WAIT_L(0); PG8_MMA(0, 0, At, B0); PG8_BAR; PG8_SCHED;
            PG8_LDB(B1, 1, 1); PG8_STAGE(PG8_SB(1, 0), b3, voffB);
            PG8_BAR; PG8_WAIT_L(0); PG8_MMA(0, 1, At, B1); PG8_BAR;
            PG8_LDA(At, 1, 1); PG8_STAGE(PG8_SA(1, 0), a3, voffA);
            PG8_BAR; PG8_WAIT_L(0); PG8_MMA(1, 0, At, B0); PG8_BAR; PG8_SCHED;
            PG8_STAGE(PG8_SB(1, 1), b3 + hstepB, voffB);
            PG8_WAIT_V(6); PG8_BAR; PG8_MMA(1, 1, At, B1); PG8_BAR;
            }
        }
        if constexpr (ALIGN_EPI) { if (wr == 0) PG8_BAR; }
        if constexpr (!Epi::AFTER_DRAIN) { E(acc, cur, wr, wc, fr, fq); S.done(cur); }
        if (!has_next) break;
#pragma unroll
        for (int a = 0; a < 2; ++a)
#pragma unroll
            for (int b = 0; b < 2; ++b)
#pragma unroll
                for (int m = 0; m < 4; ++m)
#pragma unroll
                    for (int n = 0; n < 2; ++n) acc[a][b][m][n] = (f32x4){0.f, 0.f, 0.f, 0.f};
        cA = nA; cB = nB; ++ui; (void)S.next(ui, cur);
        if constexpr (ALIGN_EPI) { if (wr == 1) PG8_BAR; }
    }
    PG8_WAIT_V(0);
    if constexpr (!ALIGN_EPI) { if (wr == 0) PG8_BAR; }
    PG8_BAR;
    if constexpr (Epi::AFTER_DRAIN) { E.fused(acc, cur, wr, wc, fr, fq, lds, wid, lane); S.done(cur); }
#undef PG8_SA
#undef PG8_SB
#undef PG8_STAGE
#undef PG8_LDA
#undef PG8_LDB
#undef PG8_MMA
#undef PG8_WAIT_V
#undef PG8_WAIT_L
#undef PG8_BAR
#undef PG8_SCHED
}
}

#include <hip/hip_bf16.h>
#include <cmath>
namespace attn_body {
using bf16=__hip_bfloat16;
using bf16x8=__attribute__((ext_vector_type(8)))short;
using s16x4=__attribute__((ext_vector_type(4)))short;
using f32x16=__attribute__((ext_vector_type(16)))float;
using u32x4=__attribute__((ext_vector_type(4)))unsigned;
constexpr int BATCH=4,NHEAD=16,SEQ=8192,D=64;
constexpr int QP=1280,KP=512,VP=512,OP=1024;
constexpr int NW=8,QBLK=32,QB=QBLK*NW,KVBLK=64,NQB=SEQ/QB;
constexpr int ATTN_UNIT_ROWS=QB;
__device__ __forceinline__ int crow(int r,int hi){return (r&3)+8*(r>>2)+4*hi;}
#define SBAR() __builtin_amdgcn_sched_barrier(0)
__device__ __forceinline__ void cmask(f32x16&p0,f32x16&p1,int jb,int qrel,int hi){
  const float NEG=-INFINITY; int kb=64*jb+4*hi;
  #pragma unroll
  for(int r=0;r<16;++r){int kv=kb+(r&3)+8*(r>>2); if(kv>qrel)p0[r]=NEG; if(kv+32>qrel)p1[r]=NEG;}
}

constexpr int NSLOT=3, SLOTB=8192;
constexpr int LDS_K=0, LDS_V=NSLOT*SLOTB, LDS_WS=2*NSLOT*SLOTB, LDS_OST=LDS_WS+NW*64*4, LDS_BYTES=LDS_OST+NW*4096;
constexpr float C2=0.125f*1.4426950408889634f;
__device__ __forceinline__ void glds16(const void*gsrc,unsigned lds_dst){unsigned keep;
  asm volatile("s_mov_b32 %0, m0\n\ts_mov_b32 m0, %2\n\ts_nop 0\n\tglobal_load_lds_dwordx4 %1, off\n\ts_mov_b32 m0, %0":"=&s"(keep):"v"(gsrc),"s"(lds_dst):"memory");}
__device__ __forceinline__ float max3f(float a,float b,float c){float r;asm("v_max3_f32 %0, %1, %2, %3":"=v"(r):"v"(a),"v"(b),"v"(c));return r;}
__device__ __forceinline__ float max2f(float a,float b){float r;asm("v_max_f32_e32 %0, %1, %2":"=v"(r):"v"(a),"v"(b));return r;}
__device__ __forceinline__ float fadd_s(float a,float b){float r;asm("v_add_f32_e32 %0, %1, %2":"=v"(r):"v"(a),"v"(b));return r;}
__device__ __forceinline__ float fsub_s(float a,float b){float r;asm("v_sub_f32_e32 %0, %1, %2":"=v"(r):"v"(a),"v"(b));return r;}
typedef float f32x2_t __attribute__((ext_vector_type(2))); typedef __bf16 bf16x2_t __attribute__((ext_vector_type(2)));
__device__ __forceinline__ unsigned cvtpk_s(float lo,float hi){f32x2_t v={lo,hi};bf16x2_t b=__builtin_convertvector(v,bf16x2_t);return __builtin_bit_cast(unsigned,b);}
#define WAIT_BAR(N) asm volatile("s_waitcnt vmcnt(" #N ") lgkmcnt(0)\n\ts_barrier":::"memory")

__device__ __forceinline__ float rowmax(const f32x16&p0,const f32x16&p1){
  float a=max3f(p0[0],p0[1],p1[0]),b=max3f(p0[2],p0[3],p1[1]);a=max3f(a,p1[2],p1[3]);
  #pragma unroll
  for(int r=4;r<16;r+=4){a=max3f(a,p0[r],p0[r+1]);b=max3f(b,p0[r+2],p0[r+3]);a=max3f(a,p1[r],p1[r+1]);b=max3f(b,p1[r+2],p1[r+3]);}
  const float m=max2f(a,b);
  auto rr=__builtin_amdgcn_permlane32_swap(__float_as_uint(m),__float_as_uint(m),false,false);
  return max2f(__uint_as_float(rr[0]),__uint_as_float(rr[1]));
}

#undef SBAR
#undef WAIT_BAR
}

namespace attn2 {
using attn_body::bf16; using attn_body::bf16x8; using attn_body::s16x4; using attn_body::f32x16; using attn_body::u32x4; using attn_body::crow; using attn_body::cmask; using attn_body::glds16; using attn_body::rowmax; using attn_body::cvtpk_s;
constexpr int SEQ = 8192, QP = 1280, KP = 512, VP = 512, OP = 1024, NW = 8, QBLK = 32, QB = 256, KVBLK = 64, NSLOT = 3, NVSLOT = 4, KSLOT = 8192, VSLOT = 16384;
constexpr int LDS_K = 0, LDS_V = NSLOT * KSLOT, LDS_WS = LDS_V + NVSLOT * VSLOT, LDS_OST = LDS_WS + NW * 64 * 4, LDS_BYTES = LDS_OST + NW * 4096;
typedef __attribute__((address_space(3))) const char* lds_cptr; typedef short v4i16_t __attribute__((ext_vector_type(4)));
__device__ __forceinline__ s16x4 vtr(lds_cptr p) { return __builtin_bit_cast(s16x4, __builtin_amdgcn_ds_read_tr16_b64_v4i16((__attribute__((address_space(3))) v4i16_t*)p)); }
template <int THRL> __device__ __forceinline__ void attn_unit(int b, int hc, int qb, const bf16* Q, const bf16* __restrict__ K, const bf16* __restrict__ V, bf16* O, char* shm) {
    int tid_ = threadIdx.x; asm volatile("" : "+v"(tid_)); const int tid = tid_, lane = tid & 63, r32 = lane & 31, hi = lane >> 5; const int wid = __builtin_amdgcn_readfirstlane(tid >> 6);
    const int qcol = hc * 64, kcol = hc * 64, vcol = (hc >> 1) * 128, ocol = hc * 128;
    const long rowbase = (long)b * SEQ; const int q0 = qb * QB;
    const bf16* Qw = Q + (rowbase + q0 + wid * QBLK) * QP + qcol;
    const bf16 *Kh = K + rowbase * KP + kcol, *Vh = V + rowbase * VP + vcol;
    const unsigned lds0 = (unsigned)(uintptr_t)shm;
    float* wsf = (float*)(shm + LDS_WS) + wid * 64;
    const bf16* ksrc = Kh + (long)lane * KP + wid * 8;
    const bf16* vsrc = Vh + (long)(16 * (wid & 3) + (lane >> 2)) * VP + (wid >> 2) * 32 + (lane & 3) * 8;
    const unsigned kdst = lds0 + LDS_K + wid * 1024, vdst = lds0 + LDS_V + wid * 1024;
    const lds_cptr shm3 = (lds_cptr)shm; const lds_cptr vp0 = shm3 + LDS_V + ((lane >> 4) & 1) * 32 + (lane & 3) * 8 + (4 * hi + ((lane & 15) >> 2)) * 64;
    const int NT = (q0 + QB) / KVBLK;
#define A2_DMAK(t, sl) glds16(ksrc + (long)(t) * KVBLK * KP, (unsigned)__builtin_amdgcn_readfirstlane(kdst + (sl) * KSLOT))
#define A2_DMAV(t, sl) do { glds16(vsrc + (long)(t) * KVBLK * VP, (unsigned)__builtin_amdgcn_readfirstlane(vdst + (sl) * VSLOT)); glds16(vsrc + (long)(t) * KVBLK * VP + 64, (unsigned)__builtin_amdgcn_readfirstlane(vdst + (sl) * VSLOT + 8192)); } while (0)
    A2_DMAK(0, 0); A2_DMAV(0, 0); A2_DMAK(1, 1); A2_DMAV(1, 1);
    bf16x8 qr[4];
#pragma unroll
    for (int d0 = 0; d0 < 4; ++d0) qr[d0] = *reinterpret_cast<const bf16x8*>(&Qw[(long)r32 * QP + d0 * 16 + hi * 8]);
    float mhat = 0.f, l_reg = 0.f; f32x16 o[4]; o[0] = f32x16{}; o[1] = f32x16{}; o[2] = f32x16{}; o[3] = f32x16{};
    const int qrel = wid * QBLK + r32;
    u32x4 pw[4] = {};
    int slot = 0, slot2 = 2;
#define A2_PV(sl) do { const lds_cptr vp_ = vp0 + (sl) * VSLOT; _Pragma("unroll") for (int ks = 0; ks < 4; ++ks) { const bf16x8 pa = __builtin_bit_cast(bf16x8, pw[ks]); \
        _Pragma("unroll") for (int d0 = 0; d0 < 4; ++d0) { const s16x4 lo = vtr(vp_ + d0 * 4096 + ks * 1024), h4 = vtr(vp_ + d0 * 4096 + ks * 1024 + 512); \
            o[d0] = __builtin_amdgcn_mfma_f32_32x32x16_bf16(pa, (bf16x8){lo[0], lo[1], lo[2], lo[3], h4[0], h4[1], h4[2], h4[3]}, o[d0], 0, 0, 0); } } } while (0)
#define A2_VRD(i_) do { const int d0_ = (i_) & 3, ks_ = (i_) >> 2; vlo[(i_) % 3] = vtr(vp_ + d0_ * 4096 + ks_ * 1024); vhi[(i_) % 3] = vtr(vp_ + d0_ * 4096 + ks_ * 1024 + 512); } while (0)
typedef float f32x2a __attribute__((ext_vector_type(2)));
#define A2_PE2(P, e_) do { f32x2a d_ = (f32x2a){P[e_], P[(e_) + 1]} - mhat2; P[e_] = __builtin_amdgcn_exp2f(d_.x); P[(e_) + 1] = __builtin_amdgcn_exp2f(d_.y); } while (0)
#define A2_GAP(i_) do { if ((i_) + 2 < 16) A2_VRD((i_) + 2); \
        o[(i_) & 3] = __builtin_amdgcn_mfma_f32_32x32x16_bf16(__builtin_bit_cast(bf16x8, pw[(i_) >> 2]), (bf16x8){vlo[(i_) % 3][0], vlo[(i_) % 3][1], vlo[(i_) % 3][2], vlo[(i_) % 3][3], vhi[(i_) % 3][0], vhi[(i_) % 3][1], vhi[(i_) % 3][2], vhi[(i_) % 3][3]}, o[(i_) & 3], 0, 0, 0); \
        if ((i_) < 8) { A2_PE2(p0, 2 * (i_)); asm volatile("" : "+v"(p0)); } else { A2_PE2(p1, 2 * (i_) - 16); asm volatile("" : "+v"(p1)); } \
        __builtin_amdgcn_sched_barrier(0); } while (0)
#define A2_STEP(MASKED) do { \
          \
        if (t + 1 < NT) asm volatile("s_waitcnt vmcnt(5) lgkmcnt(0)\n\ts_barrier" ::: "memory"); \
        else asm volatile("s_waitcnt vmcnt(2) lgkmcnt(0)\n\ts_barrier" ::: "memory"); \
        if (t + 2 < NT) { A2_DMAK(t + 2, slot2); A2_DMAV(t + 2, (vslotp + 3) & 3); } \
        __builtin_amdgcn_sched_barrier(0); \
        f32x16 p0 = f32x16{}, p1 = f32x16{}; \
        const char* kb = shm + LDS_K + slot * KSLOT + hi * 1024 + r32 * 16; \
        const lds_cptr vp_ = vp0 + (t == 0 ? 0 : vslotp) * VSLOT; s16x4 vlo[3], vhi[3]; \
        _Pragma("unroll") for (int d0 = 0; d0 < 4; ++d0) { const bf16x8 b0 = *reinterpret_cast<const bf16x8*>(kb + d0 * 2048), b1 = *reinterpret_cast<const bf16x8*>(kb + d0 * 2048 + 512); \
            p0 = __builtin_amdgcn_mfma_f32_32x32x16_bf16(b0, qr[d0], p0, 0, 0, 0); p1 = __builtin_amdgcn_mfma_f32_32x32x16_bf16(b1, qr[d0], p1, 0, 0, 0); } \
        A2_VRD(0); A2_VRD(1); \
        if (MASKED) cmask(p0, p1, t - (NT - 4), qrel, hi); \
        asm volatile("s_nop 15\n\ts_nop 7" : "+v"(p0), "+v"(p1));        \
        const float rm = rowmax(p0, p1) - mhat; \
        resc = __any(rm > (float)THRL); \
        const float dl = resc ? __builtin_fmaxf(rm, 0.f) : 0.f; mhat += dl; \
        fsc = __builtin_amdgcn_exp2f(-dl); const f32x2a mhat2 = {mhat, mhat}; \
        __builtin_amdgcn_sched_barrier(0); \
        A2_GAP(0); A2_GAP(1); A2_GAP(2); A2_GAP(3); A2_GAP(4); A2_GAP(5); A2_GAP(6); A2_GAP(7); A2_GAP(8); A2_GAP(9); A2_GAP(10); A2_GAP(11); A2_GAP(12); A2_GAP(13); A2_GAP(14); A2_GAP(15); \
        f32x2a s2_ = {0.f, 0.f}; \
        _Pragma("unroll") for (int r = 0; r < 16; r += 2) { s2_ += (f32x2a){p0[r], p0[r + 1]}; s2_ += (f32x2a){p1[r], p1[r + 1]}; }        \
        l_reg = l_reg * fsc + (s2_.x + s2_.y); \
        pw[0] = (u32x4){cvtpk_s(p0[0], p0[1]), cvtpk_s(p0[2], p0[3]), cvtpk_s(p0[4], p0[5]), cvtpk_s(p0[6], p0[7])}; pw[1] = (u32x4){cvtpk_s(p0[8], p0[9]), cvtpk_s(p0[10], p0[11]), cvtpk_s(p0[12], p0[13]), cvtpk_s(p0[14], p0[15])}; \
        pw[2] = (u32x4){cvtpk_s(p1[0], p1[1]), cvtpk_s(p1[2], p1[3]), cvtpk_s(p1[4], p1[5]), cvtpk_s(p1[6], p1[7])}; pw[3] = (u32x4){cvtpk_s(p1[8], p1[9]), cvtpk_s(p1[10], p1[11]), cvtpk_s(p1[12], p1[13]), cvtpk_s(p1[14], p1[15])}; \
        if (resc) { if (hi == 0) wsf[r32] = fsc;                   \
            asm volatile("s_waitcnt lgkmcnt(0)" ::: "memory"); \
            _Pragma("unroll") for (int r = 0; r < 16; ++r) { const float fr = wsf[crow(r, hi)]; \
                _Pragma("unroll") for (int d = 0; d < 4; ++d) o[d][r] *= fr; } } \
        slot2 = slot; slot = slot == NSLOT - 1 ? 0 : slot + 1; vslotp = (vslotp + 1) & 3;        \
    } while (0)
    bool resc = false; float fsc = 1.f; int vslotp = 3;
    int t = 0;
    if (wid >= 4) __builtin_amdgcn_s_setprio(1);
    for (; t < NT - 4; ++t) A2_STEP(false);
    for (; t < NT; ++t) A2_STEP(true);
    __builtin_amdgcn_s_setprio(0);
#undef A2_STEP
#undef A2_GAP
#undef A2_PE2
#undef A2_VRD
    asm volatile("s_waitcnt vmcnt(0) lgkmcnt(0)\n\ts_barrier" ::: "memory");
    A2_PV(vslotp);
#undef A2_PV
#undef A2_DMAK
#undef A2_DMAV
    { auto rr = __builtin_amdgcn_permlane32_swap(__float_as_uint(l_reg), __float_as_uint(l_reg), false, false); l_reg = __uint_as_float(rr[0]) + __uint_as_float(rr[1]); }
    if (hi == 0) wsf[32 + r32] = l_reg; asm volatile("s_waitcnt lgkmcnt(0)" ::: "memory");
    float rli[16];
#pragma unroll
    for (int r = 0; r < 16; ++r) rli[r] = __builtin_amdgcn_rcpf(wsf[32 + crow(r, hi)]);
    bf16* Ow = O + (rowbase + q0 + wid * QBLK) * OP + ocol;
    bf16* stg = (bf16*)(shm + LDS_OST) + wid * 2048;
#pragma unroll
    for (int pass = 0; pass < 2; ++pass) {
#pragma unroll
        for (int r = 0; r < 16; ++r) { const int orow = crow(r, hi);
#pragma unroll
            for (int d0 = 0; d0 < 2; ++d0) stg[orow * 64 + d0 * 32 + r32] = __float2bfloat16(o[2 * pass + d0][r] * rli[r]); }
        asm volatile("s_waitcnt lgkmcnt(0)" ::: "memory");
#pragma unroll
        for (int i = 0; i < 4; ++i) { const int row = i * 8 + (lane >> 3), ch = lane & 7; const u32x4 v = *(const u32x4*)(stg + row * 64 + ch * 8); *(u32x4*)(Ow + (long)row * OP + pass * 64 + ch * 8) = v; }
        asm volatile("s_waitcnt lgkmcnt(0)" ::: "memory");
    }
    asm volatile("s_waitcnt lgkmcnt(0)\n\ts_barrier" ::: "memory");
}
struct AttnTensors { const bf16* Q; const bf16* K; const bf16* V; bf16* O; };
struct AttnUnit { int bh; int qb; };
struct StaticOrder {
    int vcu, G;
    __device__ __forceinline__ explicit StaticOrder(int grid, int block) : vcu((grid % 8 == 0) ? (block % 8) * (grid / 8) + block / 8 : block), G(grid) {}
    __device__ __forceinline__ bool next(int i, AttnUnit& u) const { const int oct = vcu + (i >> 2) * G; if (oct >= 256) return false; const int s = oct & 7, ii = i & 3; u.bh = oct >> 3; u.qb = (ii == 0) ? s : (ii == 1) ? 15 - s : (ii == 2) ? 16 + s : 31 - s; return true; }
};
template <int THRL = 8> __device__ __forceinline__ void attn_phase(char* lds, const AttnTensors& T, const StaticOrder& S) {
    AttnUnit u;
    for (int i = 0; S.next(i, u); ++i) attn_unit<THRL>(u.bh >> 3, u.bh & 7, u.qb, T.Q, T.K, T.V, T.O, lds);
}
}

namespace tile {
typedef short bf16x8 __attribute__((ext_vector_type(8)));
typedef short s16x4 __attribute__((ext_vector_type(4)));
typedef float f32x16 __attribute__((ext_vector_type(16)));
constexpr int TP = 72;
__device__ __forceinline__ int crow(int r, int hi) { return (r & 3) + 8 * (r >> 2) + 4 * hi; }
__device__ __forceinline__ bf16x8 frag_row(const LAS bf16_t* T, int r0, int k0, int lane) { return *(const LAS bf16x8*)(T + (r0 + (lane & 31)) * TP + k0 + 8 * (lane >> 5)); }
__device__ __forceinline__ bf16x8 frag_tr(const LAS bf16_t* T, int ra, int rb, int c0, int lane) {
    const int hi = lane >> 5, g16 = (lane >> 4) & 1, q = (lane & 15) >> 2, p = lane & 3;
    const LAS bf16_t* a0 = T + (ra + 4 * hi + q) * TP + c0 + 16 * g16 + 4 * p; const LAS bf16_t* a1 = T + (rb + 4 * hi + q) * TP + c0 + 16 * g16 + 4 * p;
    const s16x4 lo = __builtin_bit_cast(s16x4, __builtin_amdgcn_ds_read_tr16_b64_v4i16((LAS s16x4*)a0)), hi4 = __builtin_bit_cast(s16x4, __builtin_amdgcn_ds_read_tr16_b64_v4i16((LAS s16x4*)a1));
    return (bf16x8){lo[0], lo[1], lo[2], lo[3], hi4[0], hi4[1], hi4[2], hi4[3]};
}
__device__ __forceinline__ bf16x8 frag_tr_nat(const LAS bf16_t* T, int k0, int c0, int lane) {
    const int hi = lane >> 5, g16 = (lane >> 4) & 1, q = (lane & 15) >> 2, p = lane & 3;
    const LAS bf16_t* a0 = T + (k0 + 8 * hi + q) * TP + c0 + 16 * g16 + 4 * p;
    const s16x4 lo = __builtin_bit_cast(s16x4, __builtin_amdgcn_ds_read_tr16_b64_v4i16((LAS s16x4*)a0)), hi4 = __builtin_bit_cast(s16x4, __builtin_amdgcn_ds_read_tr16_b64_v4i16((LAS s16x4*)(a0 + 4 * TP)));
    return (bf16x8){lo[0], lo[1], lo[2], lo[3], hi4[0], hi4[1], hi4[2], hi4[3]};
}
__device__ __forceinline__ unsigned cvtpk(float lo, float hi) { typedef float f2 __attribute__((ext_vector_type(2))); typedef __bf16 b2 __attribute__((ext_vector_type(2))); f2 v = {lo, hi}; return __builtin_bit_cast(unsigned, __builtin_convertvector(v, b2)); }
__device__ __forceinline__ bf16x8 acc_frag(const f32x16& x, int s_) { u32x4 w; w.x = cvtpk(x[8 * s_], x[8 * s_ + 1]); w.y = cvtpk(x[8 * s_ + 2], x[8 * s_ + 3]); w.z = cvtpk(x[8 * s_ + 4], x[8 * s_ + 5]); w.w = cvtpk(x[8 * s_ + 6], x[8 * s_ + 7]); return __builtin_bit_cast(bf16x8, w); }
#define MFMA32(a, b, c) __builtin_amdgcn_mfma_f32_32x32x16_bf16((a), (b), (c), 0, 0, 0)
}

__device__ __forceinline__ void sb_phase(LAS unsigned char* lds, bf16_t* QO, int ldq, const bf16_t* __restrict__ Kb, const bf16_t* __restrict__ Vb, int gw, int ngw, int wave, int lane) {
    using namespace tile;
    LAS bf16_t* Kt = (LAS bf16_t*)(lds + wave * 16384); LAS bf16_t* Vt = Kt + 32 * TP; LAS bf16_t* Ot = Vt + 32 * TP;
    const int hi = lane >> 5, ql = lane & 31;
    bf16x8 uf[2];
#pragma unroll
    for (int s_ = 0; s_ < 2; ++s_)
#pragma unroll
        for (int j = 0; j < 8; ++j) uf[s_][j] = (16 * s_ + 8 * (j >> 2) + 4 * hi + (j & 3)) > ql ? (short)0x3F80 : (short)0;
    for (int unit = gw; unit < NTOK * 4 / 32; unit += ngw) {
        const int qb = unit & 255, h = (unit >> 8) & 3, b = unit >> 10, q0 = qb * 32; const size_t rb = (size_t)b * SEQ;
        bf16x8 qf[4];
#pragma unroll
        for (int s_ = 0; s_ < 4; ++s_) qf[s_] = *(const bf16x8*)(QO + (rb + q0 + ql) * ldq + h * 64 + 16 * s_ + 8 * hi);
        f32x16 o0 = {}, o1 = {}; float carry = 0.f;
        u32x4 kp[4], vp[4];
#define SB_LOAD(k0_) do { _Pragma("unroll") for (int i = 0; i < 4; ++i) { const int c = lane + 64 * i, row = c >> 3, c16 = c & 7; \
            kp[i] = *(const u32x4*)(Kb + (rb + (k0_) + row) * 256 + h * 64 + c16 * 8); vp[i] = *(const u32x4*)(Vb + (rb + (k0_) + row) * 256 + h * 64 + c16 * 8); } } while (0)
#define SB_STORE() do { _Pragma("unroll") for (int i = 0; i < 4; ++i) { const int c = lane + 64 * i, row = c >> 3, c16 = c & 7; *(LAS u32x4*)(Kt + row * TP + c16 * 8) = kp[i]; *(LAS u32x4*)(Vt + row * TP + c16 * 8) = vp[i]; } } while (0)
        SB_LOAD(q0);
        for (int k0 = q0; k0 >= 0; k0 -= 32) {
            asm volatile("s_waitcnt lgkmcnt(0)" ::: "memory");
            SB_STORE();
            if (k0 >= 32) SB_LOAD(k0 - 32);
            asm volatile("s_waitcnt lgkmcnt(0)" ::: "memory");
            f32x16 p = {};
#pragma unroll
            for (int s_ = 0; s_ < 4; ++s_) p = MFMA32(frag_row(Kt, 0, 16 * s_, lane), qf[s_], p);
            f32x16 lk, z;
            const bool diag = (k0 == q0);
#pragma unroll
            for (int r = 0; r < 16; ++r) { z[r] = p[r] * 0.125f; const bool valid = !diag || crow(r, hi) < ql; const float az = fabsf(z[r]);
                const float sp = fmaxf(z[r], 0.f) + __logf(1.f + __expf(-az)); lk[r] = valid ? -sp : 0.f; }
            f32x16 lo_;
#pragma unroll
            for (int r = 0; r < 16; ++r) { const float hb = __uint_as_float(__float_as_uint(lk[r]) & 0xffff0000u); lo_[r] = lk[r] - hb; p[r] = hb; }
            f32x16 cs = {};
#pragma unroll
            for (int s_ = 0; s_ < 2; ++s_) { cs = MFMA32(uf[s_], acc_frag(p, s_), cs); cs = MFMA32(uf[s_], acc_frag(lo_, s_), cs); }
            const float tot = shl_(cs[0] + lk[0], ql);
            f32x16 w;
#pragma unroll
            for (int r = 0; r < 16; ++r) { const bool valid = !diag || crow(r, hi) < ql; w[r] = valid ? __expf(z[r] + lk[r] + cs[r] + carry) : 0.f; }
            carry += tot;
#pragma unroll
            for (int s_ = 0; s_ < 2; ++s_) { const bf16x8 wf = acc_frag(w, s_);
                o0 = MFMA32(frag_tr(Vt, 16 * s_, 16 * s_ + 8, 0, lane), wf, o0); o1 = MFMA32(frag_tr(Vt, 16 * s_, 16 * s_ + 8, 32, lane), wf, o1); }
            if (__all(carry < -104.f)) break;
        }
#undef SB_LOAD
#undef SB_STORE
        asm volatile("s_waitcnt lgkmcnt(0)" ::: "memory");
#pragma unroll
        for (int r = 0; r < 16; ++r) { Ot[ql * TP + crow(r, hi)] = f2bf(o0[r]); Ot[ql * TP + 32 + crow(r, hi)] = f2bf(o1[r]); }
        asm volatile("s_waitcnt lgkmcnt(0)" ::: "memory");
#pragma unroll
        for (int i = 0; i < 4; ++i) { const int c = lane + 64 * i, row = c >> 3, c16 = c & 7; *(u32x4*)(QO + (rb + q0 + row) * ldq + h * 64 + c16 * 8) = *(const LAS u32x4*)(Ot + row * TP + c16 * 8); }
    }
}

__device__ __forceinline__ float hg_lb(const float* lbl, int layer, int c) { if (layer == 0) return 0.f; const float a0 = lbl[c], a1 = lbl[256 + c]; return 1.f / (1.f + __expf(a0 - a1)); }
__device__ __forceinline__ float hg_logf(float z, float lb) {
    if (lb == 0.f) return -(fmaxf(-z, 0.f) + __logf(1.f + __expf(-fabsf(z))));
    return __logf(lb + (1.f - lb) * __builtin_amdgcn_rcpf(1.f + __expf(-z)));
}
__device__ __forceinline__ void hg_local(LAS unsigned char* lds, const bf16_t* __restrict__ F, const bf16_t* __restrict__ Iv, const float* lbl, int layer, float* __restrict__ st, float* __restrict__ dec,
                                         int gw, int ngw, int wave, int lane) {
    using namespace tile;
    LAS bf16_t* Zt = (LAS bf16_t*)(lds + wave * 16384); LAS bf16_t* Vt = Zt + 64 * TP;
    const int hi = lane >> 5, ql = lane & 31;
    for (int unit = gw; unit < 2048; unit += ngw) {
        const int chunk = unit & 127, h = (unit >> 7) & 3, b = unit >> 9; const size_t tok0 = (size_t)b * SEQ + chunk * 64;
        const float lb = hg_lb(lbl, layer, h * 64 + lane);
        float lf[64]; float bend = 0.f;
#pragma unroll
        for (int t = 0; t < 64; ++t) { lf[t] = hg_logf(bf2f(F[(tok0 + t) * 256 + h * 64 + lane]), lb); bend += lf[t]; }
        dec[unit * 64 + lane] = __expf(bend);
        asm volatile("s_waitcnt lgkmcnt(0)" ::: "memory");
        { float bb = 0.f;
#pragma unroll
          for (int t = 0; t < 64; ++t) { bb += lf[t]; Zt[t * TP + lane] = f2bf((1.f - __expf(lf[t])) * __expf(bend - bb)); } }
        f32x16 acc[2][2] = {};
#pragma unroll
        for (int half = 0; half < 2; ++half) {
            u32x4 vp[4];
#pragma unroll
            for (int i = 0; i < 4; ++i) { const int c = lane + 64 * i, row = c >> 3, c16 = c & 7; vp[i] = *(const u32x4*)(Iv + (tok0 + half * 32 + row) * 256 + h * 64 + c16 * 8); }
            asm volatile("s_waitcnt lgkmcnt(0)" ::: "memory");
#pragma unroll
            for (int i = 0; i < 4; ++i) { const int c = lane + 64 * i, row = c >> 3, c16 = c & 7; *(LAS u32x4*)(Vt + row * TP + c16 * 8) = vp[i]; }
            asm volatile("s_waitcnt lgkmcnt(0)" ::: "memory");
#pragma unroll
            for (int s2 = 0; s2 < 2; ++s2) { const int t0 = half * 32 + 16 * s2;
                const bf16x8 a0 = frag_tr_nat(Zt, t0, 0, lane), a1 = frag_tr_nat(Zt, t0, 32, lane), b0 = frag_tr_nat(Vt, 16 * s2, 0, lane), b1 = frag_tr_nat(Vt, 16 * s2, 32, lane);
                acc[0][0] = MFMA32(a0, b0, acc[0][0]); acc[0][1] = MFMA32(a0, b1, acc[0][1]); acc[1][0] = MFMA32(a1, b0, acc[1][0]); acc[1][1] = MFMA32(a1, b1, acc[1][1]); }
        }
        float* o = st + (size_t)unit * 4096;
#pragma unroll
        for (int kb = 0; kb < 2; ++kb)
#pragma unroll
            for (int vb = 0; vb < 2; ++vb)
#pragma unroll
                for (int r = 0; r < 16; ++r) o[(kb * 32 + crow(r, hi)) * 64 + vb * 32 + ql] = acc[kb][vb][r];
    }
}
__device__ __forceinline__ void hg_scan(float* st, const float* __restrict__ dec, int gtid, int nthr) {
    for (int e = gtid - 65536; e < 65536; e += nthr) { if (e < 0) continue;
        const int bh = e >> 12, kv = e & 4095, k = kv >> 6; float S = 0.f;
        for (int c0 = 0; c0 < 128; c0 += 16) { float lc[16], dc[16];
#pragma unroll
            for (int j = 0; j < 16; ++j) { lc[j] = st[(size_t)(bh * 128 + c0 + j) * 4096 + kv]; dc[j] = dec[(bh * 128 + c0 + j) * 64 + k]; }
#pragma unroll
            for (int j = 0; j < 16; ++j) { st[(size_t)(bh * 128 + c0 + j) * 4096 + kv] = S; S = dc[j] * S + lc[j]; } }
    }
}
__device__ __forceinline__ void hg_out(LAS unsigned char* lds, const bf16_t* __restrict__ F, const bf16_t* __restrict__ Iv, bf16_t* QY, int ldq, const bf16_t* __restrict__ Gt, const float* lbl, int layer,
                                       const float* __restrict__ og, const float* __restrict__ st, int gw, int ngw, int wave, int lane) {
    using namespace tile;
    LAS bf16_t* bA = (LAS bf16_t*)(lds + wave * 16384); LAS bf16_t* Z = bA + 32 * TP;
    const int hi = lane >> 5, ql = lane & 31;
    for (int unit = gw; unit < 4096; unit += ngw) {
        const int I = unit & 1, cu = unit >> 1, chunk = cu & 127, h = (cu >> 7) & 3, b = cu >> 9; const size_t tok0 = (size_t)b * SEQ + chunk * 64;
        const float lb = hg_lb(lbl, layer, h * 64 + lane);
        const float* S = st + (size_t)cu * 4096;
        {   u32x4 zq[12];
#pragma unroll
            for (int i = 0; i < 4; ++i) { const int c = lane + 64 * i, row = c >> 3, c16 = c & 7; zq[i] = *(const u32x4*)(F + (tok0 + row) * 256 + h * 64 + c16 * 8); zq[8 + i] = *(const u32x4*)(QY + (tok0 + 32 * I + row) * ldq + h * 64 + c16 * 8); }
            if (I) {
#pragma unroll
                for (int i = 0; i < 4; ++i) { const int c = lane + 64 * i, row = c >> 3, c16 = c & 7; zq[4 + i] = *(const u32x4*)(F + (tok0 + 32 + row) * 256 + h * 64 + c16 * 8); } }
            asm volatile("s_waitcnt lgkmcnt(0)" ::: "memory");
#pragma unroll
            for (int i = 0; i < 4; ++i) { const int c = lane + 64 * i, row = c >> 3, c16 = c & 7; *(LAS u32x4*)(Z + row * TP + c16 * 8) = zq[i]; *(LAS u32x4*)(bA + row * TP + c16 * 8) = zq[8 + i]; }
            if (I) {
#pragma unroll
                for (int i = 0; i < 4; ++i) { const int c = lane + 64 * i, row = c >> 3, c16 = c & 7; *(LAS u32x4*)(Z + (32 + row) * TP + c16 * 8) = zq[4 + i]; } }
        }
        asm volatile("s_waitcnt lgkmcnt(0)" ::: "memory");
        float bref = 0.f;
        if (I) { float lfp[32];
#pragma unroll
            for (int t = 0; t < 32; ++t) { lfp[t] = hg_logf(bf2f(Z[t * TP + lane]), lb); bref += lfp[t]; }
            float bb = 0.f;
#pragma unroll
            for (int t = 0; t < 32; ++t) { bb += lfp[t]; Z[t * TP + lane] = f2bf((1.f - __expf(lfp[t])) * __expf(bref - bb)); } }
        { LAS bf16_t* Zb = Z + 32 * I * TP; float bb = 0.f;
#pragma unroll
          for (int t = 0; t < 32; ++t) { const float lf = hg_logf(bf2f(Zb[t * TP + lane]), lb); bb += lf; const float eb = __expf(bb);
              bA[t * TP + lane] = f2bf(bf2f(bA[t * TP + lane]) * eb); Zb[t * TP + lane] = f2bf((1.f - __expf(lf)) * __expf(fminf(-bb, 80.f))); } }
        asm volatile("s_waitcnt lgkmcnt(0)" ::: "memory");
        bf16x8 qf[4];
#pragma unroll
        for (int s4 = 0; s4 < 4; ++s4) qf[s4] = frag_row(bA, 0, 16 * s4, lane);
        f32x16 o0 = {}, o1 = {};
        const float es = __expf(bref);
#pragma unroll
        for (int kh = 0; kh < 2; ++kh) {
            f32x4 sv[8];
#pragma unroll
            for (int i = 0; i < 8; ++i) { const int c = lane + 64 * i, row = c >> 4, c4 = c & 15; sv[i] = *(const f32x4*)(S + (32 * kh + row) * 64 + c4 * 4); }
            asm volatile("s_waitcnt lgkmcnt(0)" ::: "memory");
#pragma unroll
            for (int i = 0; i < 8; ++i) { const int c = lane + 64 * i, row = c >> 4, c4 = c & 15; const float sc = shl_(es, 32 * kh + row);
                u32x2 w; w.x = cvtpk(sv[i][0] * sc, sv[i][1] * sc); w.y = cvtpk(sv[i][2] * sc, sv[i][3] * sc); *(LAS u32x2*)(bA + row * TP + c4 * 4) = w; }
            asm volatile("s_waitcnt lgkmcnt(0)" ::: "memory");
#pragma unroll
            for (int s2 = 0; s2 < 2; ++s2) { const bf16x8 q_ = qf[2 * kh + s2]; o0 = MFMA32(frag_tr_nat(bA, 16 * s2, 0, lane), q_, o0); o1 = MFMA32(frag_tr_nat(bA, 16 * s2, 32, lane), q_, o1); }
        }
        for (int J = 0; J <= I; ++J) {
            u32x4 vp[4];
#pragma unroll
            for (int i = 0; i < 4; ++i) { const int c = lane + 64 * i, row = c >> 3, c16 = c & 7; vp[i] = *(const u32x4*)(Iv + (tok0 + 32 * J + row) * 256 + h * 64 + c16 * 8); }
            asm volatile("s_waitcnt lgkmcnt(0)" ::: "memory");
#pragma unroll
            for (int i = 0; i < 4; ++i) { const int c = lane + 64 * i, row = c >> 3, c16 = c & 7; *(LAS u32x4*)(bA + row * TP + c16 * 8) = vp[i]; }
            asm volatile("s_waitcnt lgkmcnt(0)" ::: "memory");
            f32x16 pt = {};
#pragma unroll
            for (int s4 = 0; s4 < 4; ++s4) pt = MFMA32(frag_row(Z, 32 * J, 16 * s4, lane), qf[s4], pt);
            if (J == I) {
#pragma unroll
                for (int r = 0; r < 16; ++r) pt[r] = crow(r, hi) <= ql ? pt[r] : 0.f; }
#pragma unroll
            for (int s2 = 0; s2 < 2; ++s2) { const bf16x8 pf = acc_frag(pt, s2); o0 = MFMA32(frag_tr(bA, 16 * s2, 16 * s2 + 8, 0, lane), pf, o0); o1 = MFMA32(frag_tr(bA, 16 * s2, 16 * s2 + 8, 32, lane), pf, o1); }
        }
        float ss = 0.f;
#pragma unroll
        for (int r = 0; r < 16; ++r) ss += o0[r] * o0[r] + o1[r] * o1[r];
        ss += shx(ss, 32, lane);
        const float rr = rsqrtf(ss * (1.f / 64.f) + RMS_EPS);
        u32x4 gv[4];
#pragma unroll
        for (int i = 0; i < 4; ++i) { const int c = lane + 64 * i, row = c >> 3, c16 = c & 7; gv[i] = *(const u32x4*)(Gt + (tok0 + 32 * I + row) * 256 + h * 64 + c16 * 8); }
        asm volatile("s_waitcnt lgkmcnt(0)" ::: "memory");
#pragma unroll
        for (int r = 0; r < 16; ++r) { bA[ql * TP + crow(r, hi)] = f2bf(o0[r] * rr); bA[ql * TP + 32 + crow(r, hi)] = f2bf(o1[r] * rr); }
        asm volatile("s_waitcnt lgkmcnt(0)" ::: "memory");
#pragma unroll
        for (int i = 0; i < 4; ++i) { const int c = lane + 64 * i, row = c >> 3, c16 = c & 7; const size_t tok = tok0 + 32 * I + row;
            const u32x4 ov = *(const LAS u32x4*)(bA + row * TP + c16 * 8); const unsigned ow[4] = {ov.x, ov.y, ov.z, ov.w}, gw_[4] = {gv[i].x, gv[i].y, gv[i].z, gv[i].w}; float y[8];
#pragma unroll
            for (int j = 0; j < 4; ++j) { const float g0 = __uint_as_float(gw_[j] << 16), g1 = __uint_as_float(gw_[j] & 0xffff0000u);
                y[2 * j] = __uint_as_float(ow[j] << 16) * og[c16 * 8 + 2 * j] * g0 * __builtin_amdgcn_rcpf(1.f + __expf(-g0)); y[2 * j + 1] = __uint_as_float(ow[j] & 0xffff0000u) * og[c16 * 8 + 2 * j + 1] * g1 * __builtin_amdgcn_rcpf(1.f + __expf(-g1)); }
            u32x4 w; w.x = cvtpk(y[0], y[1]); w.y = cvtpk(y[2], y[3]); w.z = cvtpk(y[4], y[5]); w.w = cvtpk(y[6], y[7]);
            *(u32x4*)(QY + tok * ldq + h * 64 + c16 * 8) = w; }
    }
}

#define XB_TMO      128
#define XB_XCNT(j)  (256  + 64 * (j))
#define XB_XSUB(j)  (1280 + 64 * (j))
#define XB_XGEN(j)  (2304 + 64 * (j))
#define XB_TOP      3328
#define XB_TOPGEN   3392
#define XCD_BAR_WORDS 3456
#define XB_SPIN_CAP (1u << 18)

__device__ __forceinline__ unsigned xb_ld(unsigned* p)              { return __hip_atomic_load(p, __ATOMIC_RELAXED, __HIP_MEMORY_SCOPE_AGENT); }
__device__ __forceinline__ unsigned xb_add(unsigned* p, unsigned v) { return __hip_atomic_fetch_add(p, v, __ATOMIC_RELAXED, __HIP_MEMORY_SCOPE_AGENT); }
__device__ __forceinline__ unsigned xb_xcc_id() { return (unsigned)__builtin_amdgcn_s_getreg((3 << 11) | 20) & 0xFu; }
#define XB_SPIN(cond, bar) do { unsigned _sp = 0; while (cond) { __builtin_amdgcn_s_sleep(1); \
    if ((++_sp & 255u) == 0u) { if (xb_ld(&(bar)[XB_TMO])) break; if (_sp > XB_SPIN_CAP) { atomicAdd(&(bar)[XB_TMO], 1u); break; } } } } while (0)

struct XcdBarrier {
    unsigned* bar; unsigned x;
    volatile LAS unsigned* st;
};

__device__ __forceinline__ XcdBarrier xcd_barrier_post(unsigned* bar, volatile LAS unsigned* st) {
    XcdBarrier b; b.bar = bar; b.x = xb_xcc_id(); b.st = st;
    if (threadIdx.x == 0) (void)xb_add(&bar[XB_XCNT(b.x)], 1u);
    return b;
}
__device__ __forceinline__ void xcd_barrier_complete(unsigned* bar, unsigned x, unsigned& nloc, unsigned& nx) {
    const unsigned G = gridDim.x * gridDim.y * gridDim.z;
    unsigned sum, cnt, mine, sp = 0u;
    for (;;) {
        sum = 0u; cnt = 0u; mine = 0u;
#pragma unroll
        for (unsigned j = 0; j < 16; ++j) { const unsigned c = xb_ld(&bar[XB_XCNT(j)]); sum += c; cnt += (c > 0u) ? 1u : 0u; mine = (j == x) ? c : mine; }
        if (sum == G) break;
        __builtin_amdgcn_s_sleep(1);
        if ((++sp & 255u) == 0u) { if (xb_ld(&bar[XB_TMO])) break; if (sp > XB_SPIN_CAP) { atomicAdd(&bar[XB_TMO], 1u); break; } }
    }
    nloc = mine > 0u ? mine : 1u; nx = cnt > 0u ? cnt : 1u;
}

__device__ __forceinline__ void xcd_barrier(const XcdBarrier& b_) {
    XcdBarrier b = b_; { GAS unsigned* bg_ = (GAS unsigned*)b.bar; asm volatile("" : "+s"(bg_), "+s"(b.x)); b.bar = (unsigned*)bg_; }
    asm volatile("s_waitcnt vmcnt(0)" ::: "memory");
    __syncthreads();
    if (threadIdx.x == 0) {
        unsigned* bar = b.bar;
        __builtin_amdgcn_s_waitcnt(0);
        unsigned nloc = b.st[0], nx = b.st[1];
        if (nloc == 0u) { xcd_barrier_complete(bar, b.x, nloc, nx); b.st[0] = nloc; b.st[1] = nx; }
        const unsigned old = xb_add(&bar[XB_XSUB(b.x)], 1u);
        const unsigned gen = old / nloc;
        if (old + 1u == (gen + 1u) * nloc) {
            __builtin_amdgcn_fence(__ATOMIC_RELEASE, "agent");
            asm volatile("s_waitcnt vmcnt(0)" ::: "memory");
            const unsigned og = xb_add(&bar[XB_TOP], 1u);
            const unsigned tg = og / nx;
            if (og + 1u == (tg + 1u) * nx) xb_add(&bar[XB_TOPGEN], 1u);
            else XB_SPIN(xb_ld(&bar[XB_TOPGEN]) == tg, bar);
            __builtin_amdgcn_fence(__ATOMIC_ACQUIRE, "agent");
            xb_add(&bar[XB_XGEN(b.x)], 1u);
            asm volatile("s_waitcnt vmcnt(0)" ::: "memory");
        } else {
            XB_SPIN(xb_ld(&bar[XB_XGEN(b.x)]) == gen, bar);
            __builtin_amdgcn_fence(__ATOMIC_ACQUIRE, "agent");
            asm volatile("s_waitcnt vmcnt(0)" ::: "memory");
        }
    }
    __syncthreads();
}

#define LDS_WAIT() asm volatile("s_waitcnt lgkmcnt(0)" ::: "memory")
constexpr int NWAVES_ = 8;
__device__ __forceinline__ void tr_item(const float* __restrict__ W, int N, int k0, int n0, bf16_t* dst, int ldo, LAS float* scr, int lane, int rs = 1) {
#pragma unroll 8
    for (int i = 0; i < 32; ++i) { const int kk = 2 * i + (lane >> 5); scr[kk * 33 + (lane & 31)] = W[(size_t)(k0 + kk) * N + n0 + (lane & 31)]; }
    LDS_WAIT(); asm volatile("" ::: "memory");
    const int c = lane & 7;
#pragma unroll
    for (int j = 0; j < 4; ++j) { const int n = (lane >> 3) + 8 * j; const LAS float* s = scr + (8 * c) * 33 + n;
        u32x4 o; o.x = pk2(s[0 * 33], s[1 * 33]); o.y = pk2(s[2 * 33], s[3 * 33]); o.z = pk2(s[4 * 33], s[5 * 33]); o.w = pk2(s[6 * 33], s[7 * 33]);
        *(u32x4*)(dst + (size_t)n * rs * ldo + 8 * c) = o; }
    LDS_WAIT(); asm volatile("" ::: "memory");
}
struct LayerIn {
    const float *norm_mix, *w_in, *qg, *kg, *lq1, *lk1, *lq2, *lk2, *subln, *hg_lb, *hg_og, *s5_lre, *s5_lim, *s5_lstep, *s5_bre, *s5_bim, *s5_cre, *s5_cim, *s5_d, *glu_w, *glu_b,
                *pa, *pb, *pc, *pd, *w_out, *norm_ffn, *rgw, *rgb, *rew, *reb, *eg, *eu, *ed;
};
__device__ __forceinline__ void ph_weights(const CAS char* ka, int l, unsigned char* wts, LAS unsigned char* lds, int gw, int ngw, int wave, int lane) {
    LAS float* scr = (LAS float*)(lds + wave * 16384);
#define KIN(i) ((const float*)(*(const GAS float* const CAS*)(ka + 8 * (i))))
    const float* w_in = KIN(3) + (size_t)l * DM * IN_COLS; const float* pa = KIN(23) + (size_t)l * 512 * DM; const float* w_out = KIN(27) + (size_t)l * DM * DM; const float* glu_w = KIN(21) + (size_t)l * 65536;
    constexpr int I_IN = 16 * 240, I_PA = 8 * 32, I_PB = 4 * 32, I_OUT = 16 * 32, I_GLU = 4 * 8, I_EG = 16 * 16 * 12, I_ED = 16 * 6 * 32;
    constexpr int NITEMS = I_IN + I_PA + 3 * I_PB + I_OUT + I_GLU + 2 * I_EG;
    for (int it = gw; it < NITEMS; it += ngw) {
        int r = it;
        if (r < I_IN) { const int kb = r / 240, nb = r % 240, n0 = nb * 32;
            tr_item(w_in, IN_COLS, kb * 64, n0, (bf16_t*)(wts + WT_IN) + (size_t)n0 * DM + kb * 64, DM, scr, lane);
            continue; } r -= I_IN;
        if (r < I_PA) { const int kb = r / 32, nb = r % 32; tr_item(pa, DM, kb * 64, nb * 32, (bf16_t*)(wts + WT_P) + (size_t)nb * 32 * YC_LD + kb * 64, YC_LD, scr, lane); continue; } r -= I_PA;
        if (r < 3 * I_PB) { const int w = r / I_PB, q = r % I_PB, kb = q / 32, nb = q % 32; const float* src = KIN(24 + w) + (size_t)l * 256 * DM;
            tr_item(src, DM, kb * 64, nb * 32, (bf16_t*)(wts + WT_P) + (size_t)nb * 32 * YC_LD + 512 + 256 * w + kb * 64, YC_LD, scr, lane); continue; } r -= 3 * I_PB;
        if (r < I_OUT) { const int kb = r / 32, nb = r % 32; tr_item(w_out, DM, kb * 64, nb * 32, (bf16_t*)(wts + WT_OUT) + (size_t)nb * 32 * DM + kb * 64, DM, scr, lane); continue; } r -= I_OUT;
        if (r < I_GLU) { const int kb = r / 8, nb = r % 8; tr_item(glu_w, 256, kb * 64, nb * 32, (bf16_t*)(wts + WT_GLU) + (size_t)nb * 32 * 256 + kb * 64, 256, scr, lane); continue; } r -= I_GLU;
        if (r < 2 * I_EG) { const int up = r / I_EG, q = r % I_EG, e = q / 192, q2 = q % 192, kb = q2 / 12, nb = q2 % 12, n0 = nb * 32;
            const float* src = KIN(33 + up) + ((size_t)l * NEXP + e) * DM * DEXP;
            tr_item(src, DEXP, kb * 64, n0, (bf16_t*)(wts + WT_E1) + (size_t)(e * 768 + (n0 >> 7) * 256 + up * 128 + (n0 & 127)) * DM + kb * 64, DM, scr, lane); continue; }
    }
}
__device__ __forceinline__ void ph_s5_tables(const float* lre, const float* lim, const float* lstep, const float* bre, const float* bim, float* apow, float* bb, int gtid, int nthr) {
    for (int i = gtid; i < 1024; i += nthr) { const int g = i >> 6;
        const float lr = fminf(lre[i], -1e-4f), li = lim[i], st = __expf(lstep[g]);
        const float mag = __expf(lr * st), ph = li * st; const float rv = ph * 0.15915494309189535f, fr_ = rv - floorf(rv), sn = __sinf(fr_ * 6.283185307179586f), cs = __cosf(fr_ * 6.283185307179586f);
        const float ar = mag * cs, ai = mag * sn;
        const float den = lr * lr + li * li, nr = ar - 1.f, gr = (nr * lr + ai * li) / den, gi = (ai * lr - nr * li) / den;
        float pr = 1.f, pi = 0.f;
        for (int p = 0; p <= 32; ++p) { apow[(i * 33 + p) * 2] = pr; apow[(i * 33 + p) * 2 + 1] = pi; const float t = pr * ar - pi * ai; pi = pr * ai + pi * ar; pr = t; }
        for (int c = 0; c < 16; ++c) { const float br = bre[i * 16 + c], bi = bim[i * 16 + c]; bb[(i * 16 + c) * 2] = gr * br - gi * bi; bb[(i * 16 + c) * 2 + 1] = gr * bi + gi * br; }
    }
}
__device__ __forceinline__ void ph_s5_mats(const float* __restrict__ apow, const float* __restrict__ bb, const float* __restrict__ cre, const float* __restrict__ cim, bf16_t* m1t, bf16_t* m2t, bf16_t* ktab, int gtid, int nthr) {
    for (int it = gtid; it < 16 * 256 * 64; it += nthr) { const int cg = it & 63, r = (it >> 6) & 255, g = it >> 14; float v[8];
        if (r < 128) { const int n = r & 63, im = r >> 6, s_ = cg >> 1, c0 = (cg & 1) * 8; const int gi = g * 64 + n; const float pr = apow[(gi * 33 + 31 - s_) * 2], pi = apow[(gi * 33 + 31 - s_) * 2 + 1];
#pragma unroll
            for (int j = 0; j < 8; ++j) { const float br = bb[(gi * 16 + c0 + j) * 2], bi = bb[(gi * 16 + c0 + j) * 2 + 1]; v[j] = im ? pr * bi + pi * br : pr * br - pi * bi; } }
        else {
#pragma unroll
            for (int j = 0; j < 8; ++j) v[j] = 0.f; }
        u32x4 w; w.x = pk2(v[0], v[1]); w.y = pk2(v[2], v[3]); w.z = pk2(v[4], v[5]); w.w = pk2(v[6], v[7]);
        *(u32x4*)(m1t + ((size_t)(g * 256 + r) * 512 + cg * 8)) = w; }
    for (int it = gtid; it < 16 * 32 * 16 * 2; it += nthr) { const int c0 = (it & 1) * 8, c = (it >> 1) & 15, tau = (it >> 5) & 31, g = it >> 10; float v[8];
#pragma unroll
        for (int j = 0; j < 8; ++j) v[j] = 0.f;
        for (int n = 0; n < 64; ++n) { const int gi = g * 64 + n; const float pr = apow[(gi * 33 + tau) * 2], pi = apow[(gi * 33 + tau) * 2 + 1], cr = cre[(g * 16 + c) * 64 + n], ci = cim[(g * 16 + c) * 64 + n];
            const float wr_ = cr * pr - ci * pi, wi_ = cr * pi + ci * pr;
#pragma unroll
            for (int j = 0; j < 8; ++j) v[j] += wr_ * bb[(gi * 16 + c0 + j) * 2] - wi_ * bb[(gi * 16 + c0 + j) * 2 + 1]; }
        u32x4 w; w.x = pk2(v[0], v[1]); w.y = pk2(v[2], v[3]); w.z = pk2(v[4], v[5]); w.w = pk2(v[6], v[7]);
        *(u32x4*)(ktab + ((size_t)((g * 32 + tau) * 16 + c) * 16 + c0)) = w; }
    for (int it = gtid; it < 16 * 512 * 16; it += nthr) { const int cg = it & 15, r = (it >> 4) & 511, g = it >> 13, t = r >> 4, c = r & 15, nn0 = cg * 8; float v[8];
#pragma unroll
        for (int j = 0; j < 8; ++j) { const int nn = nn0 + j, n = nn & 63, gi = g * 64 + n; const float pr = apow[(gi * 33 + t + 1) * 2], pi = apow[(gi * 33 + t + 1) * 2 + 1], cr = cre[(g * 16 + c) * 64 + n], ci = cim[(g * 16 + c) * 64 + n];
            v[j] = nn < 64 ? cr * pr - ci * pi : -(cr * pi + ci * pr); }
        u32x4 w; w.x = pk2(v[0], v[1]); w.y = pk2(v[2], v[3]); w.z = pk2(v[4], v[5]); w.w = pk2(v[6], v[7]);
        *(u32x4*)(m2t + ((size_t)(g * 512 + r) * S5_LD + 512 + cg * 8)) = w; }
}
__device__ __forceinline__ void ph_s5_expand(const bf16_t* __restrict__ ktab, bf16_t* m2t, int gtid, int nthr) {
    for (int it = gtid; it < 16 * 512 * 64; it += nthr) { const int cg = it & 63, r = (it >> 6) & 511, g = it >> 15, t = r >> 4, c = r & 15, s_ = cg >> 1, c0 = (cg & 1) * 8;
        u32x4 w = {0u, 0u, 0u, 0u}; if (s_ <= t) w = *(const u32x4*)(ktab + ((size_t)((g * 32 + t - s_) * 16 + c) * 16 + c0));
        *(u32x4*)(m2t + ((size_t)(g * 512 + r) * S5_LD + cg * 8)) = w; }
}
__device__ __forceinline__ void ph_s5_scan(const float* __restrict__ apow, const float* __restrict__ xloc, bf16_t* s5u, int gtid, int nthr) {
    for (int i = gtid; i < 4096; i += nthr) { const int n = i & 63, g = (i >> 6) & 15, b = i >> 10; const int gi = g * 64 + n;
        const float ar = apow[(gi * 33 + 32) * 2], ai = apow[(gi * 33 + 32) * 2 + 1]; float xr = 0.f, xi = 0.f;
        for (int k0 = 0; k0 < 256; k0 += 32) { float lr[32], li[32];
#pragma unroll
            for (int j = 0; j < 32; ++j) { const size_t row = (size_t)g * 1024 + b * 256 + k0 + j; lr[j] = xloc[row * 128 + n]; li[j] = xloc[row * 128 + 64 + n]; }
#pragma unroll
            for (int j = 0; j < 32; ++j) { const size_t row = (size_t)g * 1024 + b * 256 + k0 + j; s5u[row * S5_LD + 512 + n] = f2bf(xr); s5u[row * S5_LD + 576 + n] = f2bf(xi);
                const float t = ar * xr - ai * xi + lr[j]; xi = ar * xi + ai * xr + li[j]; xr = t; } }
    }
}
__device__ __forceinline__ void ph_pair_weights(const float* __restrict__ ed  , bf16_t* wp, LAS unsigned char* lds, int gw, int ngw, int wave, int lane) {
    LAS float* scr = (LAS float*)(lds + wave * 16384);
    for (int it = gw; it < NBUCKET * 2 * 6 * 32; it += ngw) { const int nb = it & 31, kb = (it >> 5) % 6, sel = (it / 192) & 1, p_ = it / 384; int e0, e1; pg8::pair_experts(p_, e0, e1); const int e = sel ? e1 : e0;
        tr_item(ed + (size_t)e * DEXP * DM, DM, kb * 64, nb * 32, wp + ((size_t)p_ * 1024 + nb * 32) * 768 + sel * DEXP + kb * 64, 768, scr, lane); }
    asm volatile("s_waitcnt lgkmcnt(0)" ::: "memory"); __syncthreads();
}
__device__ __forceinline__ void ph_rmsnorm(const float* __restrict__ x, const float* __restrict__ gain, bf16_t* __restrict__ out, int gw, int ngw, int lane) {
    for (int m = gw; m < NTOK; m += ngw) {
        const f32x4* xr = (const f32x4*)(x + (size_t)m * DM) + lane;
        f32x4 v[4]; float s = 0.f;
#pragma unroll
        for (int j = 0; j < 4; ++j) { v[j] = xr[64 * j]; s += (v[j].x * v[j].x + v[j].y * v[j].y) + (v[j].z * v[j].z + v[j].w * v[j].w); }
        const float r = rsqrtf(wave_sum(s, lane) * (1.f / DM) + RMS_EPS);
        u32x2* o = (u32x2*)(out + (size_t)m * DM) + lane;
#pragma unroll
        for (int j = 0; j < 4; ++j) { const f32x4 g = ((const f32x4*)gain)[64 * j + lane]; u32x2 w; w.x = pk2(v[j].x * r * g.x, v[j].y * r * g.y); w.y = pk2(v[j].z * r * g.z, v[j].w * r * g.w); o[64 * j] = w; }
    }
}
__device__ __forceinline__ void fix_row(bf16_t* row, const float* gain, const float* cs, const float* sn, float scale, int lane) {
    u32x4 raw = *(const u32x4*)(row + lane * 8);
    float v[8];
    v[0] = __uint_as_float(raw.x << 16); v[1] = __uint_as_float(raw.x & 0xffff0000u); v[2] = __uint_as_float(raw.y << 16); v[3] = __uint_as_float(raw.y & 0xffff0000u);
    v[4] = __uint_as_float(raw.z << 16); v[5] = __uint_as_float(raw.z & 0xffff0000u); v[6] = __uint_as_float(raw.w << 16); v[7] = __uint_as_float(raw.w & 0xffff0000u);
    float ss = 0.f;
#pragma unroll
    for (int i = 0; i < 8; ++i) ss += v[i] * v[i];
    ss += shx(ss, 1, lane); ss += shx(ss, 2, lane); ss += shx(ss, 4, lane);
    const float r = rsqrtf(ss * (1.f / 64.f) + RMS_EPS);
    const int sub = lane & 7;
#pragma unroll
    for (int i = 0; i < 8; ++i) v[i] = v[i] * r * gain[sub * 8 + i];
    float o[8];
#pragma unroll
    for (int i = 0; i < 8; ++i) {
        const float p = shx(v[i], 1, lane);
        float res = v[i];
        if (sub == 0) res = v[i] * cs[i] - p * sn[i];
        else if (sub == 1) res = v[i] * cs[i] + p * sn[i];
        o[i] = res * scale;
    }
    u32x4 w; w.x = pk2(o[0], o[1]); w.y = pk2(o[2], o[3]); w.z = pk2(o[4], o[5]); w.w = pk2(o[6], o[7]);
    *(u32x4*)(row + lane * 8) = w;
}
__device__ __forceinline__ void ph_fixup(bf16_t* Q, int ldq, bf16_t* K, const int* __restrict__ pos, const float* __restrict__ qg, const float* __restrict__ kg, int gw, int ngw, int lane) {
    for (int m = gw; m < NTOK; m += ngw) {
        const double p = (double)pos[m];
        float cs[8], sn[8];
#pragma unroll
        for (int i = 0; i < 8; ++i) {
            constexpr double RF[8] = {0.15915494309189535, 0.03086376340470123, 0.005985185712713705, 0.001160663641240061, 0.00022507907903927653, 4.364795279280289e-05, 8.464330808241401e-06, 1.6414262627950345e-06};
            double rv = p * RF[i];
            rv -= floor(rv);
            const float a = (float)rv * 6.283185307179586f;
            cs[i] = __cosf(a); sn[i] = __sinf(a);
        }
        fix_row(Q + (size_t)m * ldq, qg, cs, sn, QSCALE, lane);
        fix_row(K + (size_t)m * 512, kg, cs, sn, 1.f, lane);
    }
}
__device__ __forceinline__ void ph_combine(const bf16_t* __restrict__ O, bf16_t* __restrict__ YA, int ldy, const float* lq1, const float* lk1, const float* lq2, const float* lk2,
                                           const float* __restrict__ sg, float lambda_init, int gw, int ngw, int lane) {
    const float lam = __expf(wave_sum(lq1[lane] * lk1[lane], lane)) - __expf(wave_sum(lq2[lane] * lk2[lane], lane)) + lambda_init;
    const int h = lane >> 4, dv0 = (lane & 15) * 8;
    for (int m0 = gw * 4; m0 < NTOK; m0 += ngw * 4) {
      u32x4 aa[4], bb_[4];
#pragma unroll
      for (int u = 0; u < 4; ++u) { aa[u] = *(const u32x4*)(O + (size_t)(m0 + u) * 1024 + h * 256 + dv0); bb_[u] = *(const u32x4*)(O + (size_t)(m0 + u) * 1024 + h * 256 + 128 + dv0); }
#pragma unroll
      for (int u = 0; u < 4; ++u) { const int m = m0 + u; const u32x4 a = aa[u], b = bb_[u];
        float d[8]; const unsigned aw[4] = {a.x, a.y, a.z, a.w}, bw[4] = {b.x, b.y, b.z, b.w};
#pragma unroll
        for (int i = 0; i < 4; ++i) { d[2 * i] = __uint_as_float(aw[i] << 16) - lam * __uint_as_float(bw[i] << 16); d[2 * i + 1] = __uint_as_float(aw[i] & 0xffff0000u) - lam * __uint_as_float(bw[i] & 0xffff0000u); }
        float ss = 0.f;
#pragma unroll
        for (int i = 0; i < 8; ++i) ss += d[i] * d[i];
        ss += shx(ss, 1, lane); ss += shx(ss, 2, lane); ss += shx(ss, 4, lane); ss += shx(ss, 8, lane);
        const float r = rsqrtf(ss * (1.f / 128.f) + RMS_EPS) * (1.f - lambda_init);
        u32x4 w; w.x = pk2(d[0] * r * sg[dv0], d[1] * r * sg[dv0 + 1]); w.y = pk2(d[2] * r * sg[dv0 + 2], d[3] * r * sg[dv0 + 3]);
        w.z = pk2(d[4] * r * sg[dv0 + 4], d[5] * r * sg[dv0 + 5]); w.w = pk2(d[6] * r * sg[dv0 + 6], d[7] * r * sg[dv0 + 7]);
        *(u32x4*)(YA + (size_t)m * ldy + h * 128 + dv0) = w;
      }
    }
}
__device__ __forceinline__ void ph_router(LAS unsigned char* lds, const float* __restrict__ x1, const float* __restrict__ gain, const float* __restrict__ wg, const float* __restrict__ bg,
                                          const float* __restrict__ we, const float* __restrict__ be, bf16_t* __restrict__ xn2, int* bucket, int* rank, float* tw, unsigned* cnt, int gw, int ngw, int lane) {
    LAS float* Wt = (LAS float*)lds; LAS unsigned* lcnt = (LAS unsigned*)(lds + 20 * 4096); LAS unsigned* lbase = lcnt + 32;
    if ((gw & 7) * 64 + lane < 32) lcnt[(gw & 7) * 64 + lane] = 0u;
    { const int t = (gw & 7) * 64 + lane;
      f32x4 a[2], b[8];
#pragma unroll
      for (int i = 0; i < 2; ++i) a[i] = ((const f32x4*)wg)[t + 512 * i];
#pragma unroll
      for (int i = 0; i < 8; ++i) b[i] = ((const f32x4*)we)[t + 512 * i];
#pragma unroll
      for (int i = 0; i < 2; ++i) { const int e = t + 512 * i; Wt[e] = a[i].x; Wt[1024 + e] = a[i].y; Wt[2048 + e] = a[i].z; Wt[3072 + e] = a[i].w; }
#pragma unroll
      for (int i = 0; i < 8; ++i) { const int x = t + 512 * i, e = x >> 2, q = x & 3; Wt[(4 + 4 * q) * 1024 + e] = b[i].x; Wt[(5 + 4 * q) * 1024 + e] = b[i].y; Wt[(6 + 4 * q) * 1024 + e] = b[i].z; Wt[(7 + 4 * q) * 1024 + e] = b[i].w; } }
    __syncthreads();
    typedef float f32x2f __attribute__((ext_vector_type(2)));
    f32x4 v[2][4], nv[2][4], gq[4];
#pragma unroll
    for (int j = 0; j < 4; ++j) gq[j] = ((const f32x4*)gain)[64 * j + lane];
#pragma unroll
    for (int tk = 0; tk < 2; ++tk)
#pragma unroll
        for (int j = 0; j < 4; ++j) v[tk][j] = ((const f32x4*)(x1 + (size_t)(gw * 2 + tk) * DM) + lane)[64 * j];
    for (int m0 = gw * 2; m0 < NTOK; m0 += ngw * 2) {
        float r[2];
#pragma unroll
        for (int tk = 0; tk < 2; ++tk) { float s = 0.f;
#pragma unroll
            for (int j = 0; j < 4; ++j) s += (v[tk][j].x * v[tk][j].x + v[tk][j].y * v[tk][j].y) + (v[tk][j].z * v[tk][j].z + v[tk][j].w * v[tk][j].w);
            r[tk] = s; }
#pragma unroll
        for (int tk = 0; tk < 2; ++tk) r[tk] = rsqrtf(wave_sum_dpp(r[tk]) * (1.f / DM) + RMS_EPS);
#pragma unroll
        for (int j = 0; j < 4; ++j) {
#pragma unroll
            for (int tk = 0; tk < 2; ++tk) { v[tk][j] = v[tk][j] * r[tk] * gq[j]; u32x2 w; w.x = pk2(v[tk][j].x, v[tk][j].y); w.y = pk2(v[tk][j].z, v[tk][j].w); ((u32x2*)(xn2 + (size_t)(m0 + tk) * DM) + lane)[64 * j] = w; } }
        asm volatile("" ::: "memory");
        { const int mn = (m0 + ngw * 2 < NTOK) ? m0 + ngw * 2 : m0;
#pragma unroll
          for (int tk = 0; tk < 2; ++tk)
#pragma unroll
              for (int j = 0; j < 4; ++j) nv[tk][j] = ((const f32x4*)(x1 + (size_t)(mn + tk) * DM) + lane)[64 * j]; }
        asm volatile("" ::: "memory");
        float lg[2][20];
        { f32x4 wq[2][4];
#pragma unroll
          for (int j = 0; j < 4; ++j) wq[0][j] = *(const LAS f32x4*)(Wt + 256 * j + 4 * lane);
#pragma unroll
          for (int c = 0; c < 20; ++c) {
              if (c < 19) {
#pragma unroll
                  for (int j = 0; j < 4; ++j) wq[(c + 1) & 1][j] = *(const LAS f32x4*)(Wt + (c + 1) * 1024 + 256 * j + 4 * lane); }
              f32x2f a0 = {0.f, 0.f}, a1 = {0.f, 0.f};
#pragma unroll
              for (int j = 0; j < 4; ++j) { const f32x4 w = wq[c & 1][j];
                  a0 = __builtin_elementwise_fma(v[0][j].xy, w.xy, a0); a0 = __builtin_elementwise_fma(v[0][j].zw, w.zw, a0);
                  a1 = __builtin_elementwise_fma(v[1][j].xy, w.xy, a1); a1 = __builtin_elementwise_fma(v[1][j].zw, w.zw, a1); }
              lg[0][c] = a0.x + a0.y; lg[1][c] = a1.x + a1.y;
              asm volatile("" ::: "memory");
          }
        }
#pragma unroll
        for (int c = 0; c < 20; ++c) { lg[0][c] = wave_sum_dpp(lg[0][c]); lg[1][c] = wave_sum_dpp(lg[1][c]); }
#pragma unroll
        for (int tk = 0; tk < 2; ++tk) {
            float gl[4]; int gi = 0;
#pragma unroll
            for (int c = 0; c < 4; ++c) gl[c] = lg[tk][c] + bg[c];
            float gm = gl[0];
#pragma unroll
            for (int c = 1; c < 4; ++c) if (gl[c] > gm) { gm = gl[c]; gi = c; }
            float gs = 0.f;
#pragma unroll
            for (int c = 0; c < 4; ++c) gs += __expf(gl[c] - gm);
            const float gval = 1.f / gs;
            float el[4];
#pragma unroll
            for (int c = 0; c < 4; ++c) { float t = lg[tk][4 + c] + be[c]; t = (gi == 1) ? lg[tk][8 + c] + be[4 + c] : t; t = (gi == 2) ? lg[tk][12 + c] + be[8 + c] : t; t = (gi == 3) ? lg[tk][16 + c] + be[12 + c] : t; el[c] = t; }
            int i0 = 0; float m0_ = el[0];
#pragma unroll
            for (int c = 1; c < 4; ++c) if (el[c] > m0_) { m0_ = el[c]; i0 = c; }
            int i1 = -1; float m1 = -INFINITY;
#pragma unroll
            for (int c = 0; c < 4; ++c) if (c != i0 && el[c] > m1) { m1 = el[c]; i1 = c; }
            const float p1 = __expf(m1 - m0_), w0 = gval / (1.f + p1), w1 = gval * p1 / (1.f + p1);
            const int lo = i0 < i1 ? i0 : i1, hi = i0 < i1 ? i1 : i0; const float wlo = i0 < i1 ? w0 : w1, whi = i0 < i1 ? w1 : w0;
            const int pair = (lo == 0) ? hi - 1 : (lo == 1 ? hi + 1 : 5);
            const int b = gi * 6 + pair, m = m0 + tk;
            if (lane == 0) { bucket[m] = b; tw[2 * m] = wlo; tw[2 * m + 1] = whi; rank[m] = (int)__hip_atomic_fetch_add(lcnt + b, 1u, __ATOMIC_RELAXED, __HIP_MEMORY_SCOPE_WORKGROUP); }
        }
#pragma unroll
        for (int tk = 0; tk < 2; ++tk)
#pragma unroll
            for (int j = 0; j < 4; ++j) v[tk][j] = nv[tk][j];
    }
    asm volatile("s_waitcnt vmcnt(0) lgkmcnt(0)" ::: "memory"); __syncthreads();
    { const int t = (gw & 7) * 64 + lane; if (t < NBUCKET) lbase[t] = __hip_atomic_fetch_add(cnt + 64 * t, lcnt[t], __ATOMIC_RELAXED, __HIP_MEMORY_SCOPE_AGENT); }
    __syncthreads();
    for (int m0 = gw * 2; m0 < NTOK; m0 += ngw * 2) if (lane < 2) { const int m = m0 + lane; rank[m] += (int)lbase[bucket[m]]; }
}
__device__ __forceinline__ void ph_sort(const bf16_t* __restrict__ xn2, const int* __restrict__ bucket, const int* __restrict__ rank, const float* __restrict__ tw, const unsigned* __restrict__ cnt,
                                        bf16_t* __restrict__ xs, int* slot_tok, float* slot_w, int gw, int ngw, int lane) {
    int mybase = 0, mycnt = 0;
    { int run = 0; for (int b = 0; b < NBUCKET; ++b) { const int cb = (int)cnt[64 * b]; if (lane == b) { mybase = run; mycnt = cb; } run += (cb + 255) & ~255; } }
    for (int m0 = gw * 4; m0 < NTOK; m0 += ngw * 4) {
        int bk[4], rk_[4]; float w0[4], w1[4]; u32x4 ra[4], rb[4];
#pragma unroll
        for (int u = 0; u < 4; ++u) { bk[u] = bucket[m0 + u]; rk_[u] = rank[m0 + u]; w0[u] = tw[2 * (m0 + u)]; w1[u] = tw[2 * (m0 + u) + 1];
            const u32x4* s = (const u32x4*)(xn2 + (size_t)(m0 + u) * DM) + lane; ra[u] = s[0]; rb[u] = s[64]; }
#pragma unroll
        for (int u = 0; u < 4; ++u) { const int slot = shl_i(mybase, bk[u]) + rk_[u]; u32x4* d = (u32x4*)(xs + (size_t)slot * DM) + lane; d[0] = ra[u]; d[64] = rb[u];
            if (lane == 0) { slot_tok[slot] = m0 + u; slot_w[2 * slot] = w0[u]; slot_w[2 * slot + 1] = w1[u]; } }
    }
    if (gw < NBUCKET) { const int b = gw, bs = shl_i(mybase, b), cb = shl_i(mycnt, b), pe = (cb + 255) & ~255;
        float z = 0.f; asm volatile("" : "+v"(z));
        for (int s = cb + lane; s < pe; s += 64) { slot_tok[bs + s] = -1; slot_w[2 * (bs + s)] = z; slot_w[2 * (bs + s) + 1] = z; } }
}

constexpr int NWAVES = 8, RING_BYTES = 131072, MISC_OFF = RING_BYTES + 320, LDS_BYTES = 147456;
constexpr int PH_PER_LAYER = 14;
enum { PH_WTS = 0, PH_NORM, PH_GEMM_IN, PH_FIX, PH_SCAN, PH_MIX, PH_POST, PH_GATE, PH_BRANCH, PH_OUT, PH_ROUTE, PH_SORT, PH_MOE1, PH_MOE2 };
struct Args { const float* in[36]; float* out; unsigned char* ws; int ph_lo, ph_hi, li, pad; };
__device__ __forceinline__ bool inph(int lo, int hi, int k) { asm volatile("" : "+s"(lo), "+s"(hi)); return lo <= k && k < hi; }
__global__ void __launch_bounds__(NWAVES * 64, 2) fwd(Args args) {
    extern __shared__ __attribute__((aligned(16))) unsigned char lds_raw[];
    LAS unsigned char* lds = (LAS unsigned char*)lds_raw;
    volatile LAS unsigned* MISC = (volatile LAS unsigned*)(lds + MISC_OFF);
    const int tid = threadIdx.x, lane = tid & 63, wave = __builtin_amdgcn_readfirstlane(tid >> 6), G = gridDim.x;
    const int gw = blockIdx.x * NWAVES + wave, ngw = G * NWAVES;
    unsigned char* ws = args.ws; unsigned* ctl = (unsigned*)(ws + WS_CTL);
    for (int u = tid; u < (LDS_BYTES - RING_BYTES) / 4; u += NWAVES * 64) ((LAS unsigned*)(lds + RING_BYTES))[u] = 0u;
    __syncthreads();
    XcdBarrier bar = xcd_barrier_post(ctl + CW_BAR + args.li * XCD_BAR_WORDS, MISC + 8);
    const int lo = args.ph_lo, hi = args.ph_hi;
#define IN_(k) inph(lo, hi, (k))
#define SEAM(k) do { if (IN_(k) && IN_((k) + 1)) xcd_barrier(bar); } while (0)
#define PH_BEGIN GAS unsigned char* W = (GAS unsigned char*)ws; asm volatile("" : "+s"(W)); GAS float* OUTP_ = (GAS float*)args.out; asm volatile("" : "+s"(OUTP_)); float* OUTP = (float*)OUTP_; int LN = threadIdx.x; asm volatile("" : "+v"(LN)); LN &= 63; int GG = gridDim.x; asm volatile("" : "+s"(GG)); int BX = blockIdx.x; asm volatile("" : "+s"(BX)); const int NGW_ = GG * NWAVES; int GW = BX * NWAVES + __builtin_amdgcn_readfirstlane(threadIdx.x >> 6); asm volatile("" : "+s"(GW));
#define INP(i) ({ const CAS char* ka_ = (const CAS char*)__builtin_amdgcn_kernarg_segment_ptr(); asm volatile("" : "+s"(ka_)); (const float*)(*(const GAS float* const CAS*)(ka_ + 8 * (i))); })
    for (int l = 0; l < DEPTH; ++l) {
        const int p0 = l * PH_PER_LAYER;
        if (IN_(p0 + PH_WTS)) { PH_BEGIN; ph_weights(({ const CAS char* ka_ = (const CAS char*)__builtin_amdgcn_kernarg_segment_ptr(); asm volatile("" : "+s"(ka_)); ka_; }), l, (unsigned char*)(W + WS_WTS), lds, GW, NGW_, GW & 7, LN);
            ph_s5_tables(INP(13) + l * 1024, INP(14) + l * 1024, INP(15) + l * 16, INP(16) + l * 16384, INP(17) + l * 16384, (float*)(W + WS_WTS + WT_APOW), (float*)(W + WS_WTS + WT_BB), GW * 64 + LN, NGW_ * 64); }
        SEAM(p0 + PH_WTS);
        if (IN_(p0 + PH_NORM)) { PH_BEGIN; const float* xin = l == 0 ? INP(0) : OUTP; ph_rmsnorm(xin, INP(2) + l * DM, (bf16_t*)(W + WS_XN), GW, NGW_, LN);
            ph_s5_mats((const float*)(W + WS_WTS + WT_APOW), (const float*)(W + WS_WTS + WT_BB), INP(18) + l * 16384, INP(19) + l * 16384, (bf16_t*)(W + WS_WTS + WT_S5A), (bf16_t*)(W + WS_WTS + WT_S5B), (bf16_t*)(W + WS_WTS + WT_KTAB), GW * 64 + LN, NGW_ * 64); }
        SEAM(p0 + PH_NORM);
        if (IN_(p0 + PH_GEMM_IN)) { PH_BEGIN;
            pg8::Gemm g{(const bf16_t*)(W + WS_XN), (const bf16_t*)(W + WS_WTS + WT_IN), DM, DM}; pg8::PlainSched S; S.o.init(NTOK / 256, NMIX / 256, GG, BX); S.lda = DM; S.ldb = DM; S.nt = 16; S.pn0 = 0;
            pg8::EpiInMix E{(unsigned char*)W};
            pg8::gemm_phase<pg8::EpiInMix, pg8::PlainSched, true, true>(lds, g, S, E);
        }
        SEAM(p0 + PH_GEMM_IN);
        if (IN_(p0 + PH_FIX)) { PH_BEGIN; ph_s5_expand((const bf16_t*)(W + WS_WTS + WT_KTAB), (bf16_t*)(W + WS_WTS + WT_S5B), GW * 64 + LN, NGW_ * 64); ph_fixup((bf16_t*)(W + WS_YCAT) + YC_Q, YC_LD, (bf16_t*)(W + WS_K), (const int*)INP(1), INP(4) + l * 64, INP(5) + l * 64, GW, NGW_, LN);
            pg8::Gemm g{(const bf16_t*)(W + WS_S5U), (const bf16_t*)(W + WS_WTS + WT_S5A), S5_LD, 512}; pg8::S5aSched S{GG, BX};
            pg8::EpiS5a E{(float*)(W + WS_S5ST)};
            pg8::gemm_phase<pg8::EpiS5a, pg8::S5aSched, true, true>(lds, g, S, E);
            hg_local(lds, (const bf16_t*)(W + WS_HGF), (const bf16_t*)(W + WS_HGI), INP(11), l, (float*)(W + WS_HGST), (float*)(W + WS_WTS + WT_HGDEC), GW, NGW_, GW & 7, LN);
        }
        SEAM(p0 + PH_FIX);
        if (IN_(p0 + PH_SCAN)) { PH_BEGIN; ph_s5_scan((const float*)(W + WS_WTS + WT_APOW), (const float*)(W + WS_S5ST), (bf16_t*)(W + WS_S5U), GW * 64 + LN, NGW_ * 64);
            hg_scan((float*)(W + WS_HGST), (const float*)(W + WS_WTS + WT_HGDEC), GW * 64 + LN, NGW_ * 64);
            sb_phase(lds, (bf16_t*)(W + WS_YCAT) + YC_SB, YC_LD, (const bf16_t*)(W + WS_SBK), (const bf16_t*)(W + WS_SBV), GW, NGW_, GW & 7, LN);
        }
        SEAM(p0 + PH_SCAN);
        if (IN_(p0 + PH_MIX)) { PH_BEGIN;
            { const attn2::AttnTensors AT{(const attn2::bf16*)(W + WS_YCAT) + YC_Q, (const attn2::bf16*)(W + WS_K), (const attn2::bf16*)(W + WS_V), (attn2::bf16*)(W + WS_O)};
              const attn2::StaticOrder SA(GG, BX); attn2::attn_phase<8>((char*)lds_raw, AT, SA); }
            pg8::Gemm g{(const bf16_t*)(W + WS_S5U), (const bf16_t*)(W + WS_WTS + WT_S5B), S5_LD, S5_LD}; pg8::S5bSched S2{GG, BX};
            pg8::EpiS5b E{(const bf16_t*)(W + WS_S5U), INP(20) + l * 256, (bf16_t*)(W + WS_YG)};
            pg8::gemm_phase<pg8::EpiS5b, pg8::S5bSched, true, true>(lds, g, S2, E);
            hg_out(lds, (const bf16_t*)(W + WS_HGF), (const bf16_t*)(W + WS_HGI), (bf16_t*)(W + WS_YCAT) + YC_HG, YC_LD, (const bf16_t*)(W + WS_HGG), INP(11), l, INP(12) + l * 64, (const float*)(W + WS_HGST), GW, NGW_, GW & 7, LN);
        }
        SEAM(p0 + PH_MIX);
        if (IN_(p0 + PH_POST)) { PH_BEGIN;
            const float lambda_init = l == 0 ? 0.2f : 0.35550906759096926f;
            ph_combine((const bf16_t*)(W + WS_O), (bf16_t*)(W + WS_YCAT) + YC_Q, YC_LD, INP(6) + l * 64, INP(7) + l * 64, INP(8) + l * 64, INP(9) + l * 64, INP(10) + l * 128, lambda_init, GW, NGW_, LN);
            pg8::Gemm g{(const bf16_t*)(W + WS_YG), (const bf16_t*)(W + WS_WTS + WT_GLU), 256, 256}; pg8::PlainSched S; S.o.init(NTOK / 256, 1, GG, BX); S.lda = 256; S.ldb = 256; S.nt = 4; S.pn0 = 0;
            pg8::EpiGlu E{(const bf16_t*)(W + WS_YG), INP(22) + l * 256, (bf16_t*)(W + WS_YCAT)};
            pg8::gemm_phase<pg8::EpiGlu, pg8::PlainSched, true, true>(lds, g, S, E);
        }
        SEAM(p0 + PH_POST);
        if (IN_(p0 + PH_GATE)) { PH_BEGIN;
            pg8::Gemm g{(const bf16_t*)(W + WS_XN), (const bf16_t*)(W + WS_WTS + WT_IN), DM, DM}; pg8::PlainSched S; S.o.init(NTOK / 256, 16, GG, BX); S.lda = DM; S.ldb = DM; S.nt = 16; S.pn0 = NMIX / 256;
            pg8::EpiGateU8 E{(unsigned char*)(W + WS_GATE)};
            pg8::gemm_phase<pg8::EpiGateU8, pg8::PlainSched, true, true>(lds, g, S, E);
        }
        SEAM(p0 + PH_GATE);
        if (IN_(p0 + PH_BRANCH)) { PH_BEGIN;
            pg8::Gemm g{(const bf16_t*)(W + WS_YCAT), (const bf16_t*)(W + WS_WTS + WT_P), YC_LD, YC_LD}; pg8::BranchSched S; S.o.init(NTOK / 256, 4, GG, BX);
            pg8::EpiBranch E{(const unsigned char*)(W + WS_GATE), (bf16_t*)(W + WS_O)};
            pg8::gemm_phase<pg8::EpiBranch, pg8::BranchSched, true, true>(lds, g, S, E);
        }
        SEAM(p0 + PH_BRANCH);
        if (IN_(p0 + PH_OUT)) { PH_BEGIN; const float* xin = l == 0 ? INP(0) : OUTP;
            pg8::Gemm g{(const bf16_t*)(W + WS_O), (const bf16_t*)(W + WS_WTS + WT_OUT), DM, DM}; pg8::PlainSched S; S.o.init(NTOK / 256, 4, GG, BX); S.lda = DM; S.ldb = DM; S.nt = 16; S.pn0 = 0;
            pg8::EpiOutRes E{xin, OUTP};
            pg8::gemm_phase<pg8::EpiOutRes, pg8::PlainSched, true, true>(lds, g, S, E);
        }
        SEAM(p0 + PH_OUT);
        if (IN_(p0 + PH_ROUTE)) { PH_BEGIN;
            ph_pair_weights(INP(35) + (size_t)l * NEXP * DEXP * DM, (bf16_t*)(W + WS_O), lds, GW, NGW_, GW & 7, LN);
            ph_router(lds, OUTP, INP(28) + l * DM, INP(29) + l * DM * 4, INP(30) + l * 4, INP(31) + l * DM * 16, INP(32) + l * 16, (bf16_t*)(W + WS_XN), (int*)(W + WS_SMALL + SM_BUCKET), (int*)(W + WS_SMALL + SM_RANK),
                      (float*)(W + WS_SMALL + SM_TW), (unsigned*)(W + WS_CTL) + CW_CNT + CNT_LSTRIDE * l, GW, NGW_, LN); }
        SEAM(p0 + PH_ROUTE);
        if (IN_(p0 + PH_SORT)) { PH_BEGIN;
            ph_sort((const bf16_t*)(W + WS_XN), (const int*)(W + WS_SMALL + SM_BUCKET), (const int*)(W + WS_SMALL + SM_RANK), (const float*)(W + WS_SMALL + SM_TW), (const unsigned*)(W + WS_CTL) + CW_CNT + CNT_LSTRIDE * l,
                    (bf16_t*)(W + WS_XS), (int*)(W + WS_SMALL + SM_SLOTTOK), (float*)(W + WS_SMALL + SM_SLOTW), GW, NGW_, LN); }
        SEAM(p0 + PH_SORT);
        if (IN_(p0 + PH_MOE1)) { PH_BEGIN;
            pg8::Gemm g{(const bf16_t*)(W + WS_XS), (const bf16_t*)(W + WS_WTS + WT_E1), DM, DM}; LAS int* tbl = (LAS int*)(lds + MISC_OFF + 256); pg8::moe_table(tbl, (const unsigned*)(W + WS_CTL) + CW_CNT + CNT_LSTRIDE * l); pg8::MoeSched<1> S{tbl, GG, BX};
            pg8::EpiMoe1 E{(bf16_t*)(W + WS_HID), (const float*)(W + WS_SMALL + SM_SLOTW)};
            pg8::gemm_phase<pg8::EpiMoe1, pg8::MoeSched<1>, true, true>(lds, g, S, E);
        }
        SEAM(p0 + PH_MOE1);
        if (IN_(p0 + PH_MOE2)) { PH_BEGIN;
            pg8::Gemm g{(const bf16_t*)(W + WS_HID), (const bf16_t*)(W + WS_O), 768, 768};        LAS int* tbl = (LAS int*)(lds + MISC_OFF + 256); pg8::moe_table(tbl, (const unsigned*)(W + WS_CTL) + CW_CNT + CNT_LSTRIDE * l); pg8::MoeSched<2> S{tbl, GG, BX};
            pg8::EpiMoe2 E{OUTP, (const int*)(W + WS_SMALL + SM_SLOTTOK), (float*)(W + WS_SMALL + SM_DUMMY)};
            pg8::gemm_phase<pg8::EpiMoe2, pg8::MoeSched<2>, true, true>(lds, g, S, E);
        }
        SEAM(p0 + PH_MOE2);
    }
#undef IN_
#undef SEAM
}

extern "C" void kernel_launch(void* const* d_in, const int* in_sizes, int n_in, void* d_out, int out_size, void* d_ws, size_t ws_size, hipStream_t stream) {
    static int grid = 0;
    if (grid == 0) {
        if (n_in != 36 || out_size != NTOK * DM || ws_size < WS_END) { fprintf(stderr, "kernel_launch: unexpected shapes (n_in %d out %d ws %zu)\n", n_in, out_size, ws_size); grid = -1; return; }
        int dev = 0, cus = 0, per_cu = 0;
        if (hipGetDevice(&dev) != hipSuccess || hipDeviceGetAttribute(&cus, hipDeviceAttributeMultiprocessorCount, dev) != hipSuccess) { grid = -1; return; }
        if (hipFuncSetAttribute((const void*)fwd, hipFuncAttributeMaxDynamicSharedMemorySize, LDS_BYTES) != hipSuccess) { fprintf(stderr, "kernel_launch: hipFuncSetAttribute failed\n"); grid = -1; return; }
        if (hipOccupancyMaxActiveBlocksPerMultiprocessor(&per_cu, (const void*)fwd, NWAVES * 64, LDS_BYTES) != hipSuccess || per_cu < 1) { fprintf(stderr, "kernel_launch: occupancy query says %d\n", per_cu); }
        (void)hipGetLastError();
        grid = cus;
    }
    if (grid < 0) return;
    unsigned char* ws = (unsigned char*)d_ws;
    const float* const* in = (const float* const*)d_in;
    (void)hipMemsetAsync(ws + WS_CTL, 0, 1 * MiB, stream);
    bf16_t *OB = (bf16_t*)(ws + WS_O), *YC = (bf16_t*)(ws + WS_YCAT), *K = (bf16_t*)(ws + WS_K), *V = (bf16_t*)(ws + WS_V);
    bf16_t *SBK = (bf16_t*)(ws + WS_SBK), *SBV = (bf16_t*)(ws + WS_SBV), *HGF = (bf16_t*)(ws + WS_HGF), *HGI = (bf16_t*)(ws + WS_HGI), *HGG = (bf16_t*)(ws + WS_HGG);
    bf16_t *S5U = (bf16_t*)(ws + WS_S5U), *YG = (bf16_t*)(ws + WS_YG);
    Args a{};
    for (int i = 0; i < 36; ++i) a.in[i] = (const float*)d_in[i];
    a.out = (float*)d_out; a.ws = ws;
    a.ph_lo = 0; a.ph_hi = DEPTH * PH_PER_LAYER; a.li = 0;
    hipLaunchKernelGGL(fwd, dim3(grid), dim3(NWAVES * 64), LDS_BYTES, stream, a);
}
```
